# Optimizing an MI355X kernel written in HIP

```python
import jax
import jax.numpy as jnp
from jax import lax
import numpy as np

D_MODEL = 4096
BATCH = 8
SEQ = 2048
DEPTH = 2

N_MIXERS = 2
N_MLSTM_LAYERS = (DEPTH + 1) // 2
N_POOL_LAYERS = DEPTH // 2
MLSTM_HEADS = 8
MLSTM_DV = D_MODEL // MLSTM_HEADS
MLSTM_DQK = MLSTM_DV // 2
MLSTM_QK_W = MLSTM_HEADS * MLSTM_DQK
MLSTM_V_W = MLSTM_HEADS * MLSTM_DV
MLSTM_SPLITS = (MLSTM_QK_W, 2 * MLSTM_QK_W, 2 * MLSTM_QK_W + MLSTM_V_W,
                2 * MLSTM_QK_W + 2 * MLSTM_V_W, 2 * MLSTM_QK_W + 2 * MLSTM_V_W + MLSTM_HEADS)
MLSTM_PROJ = 2 * MLSTM_QK_W + 2 * MLSTM_V_W + 2 * MLSTM_HEADS
MLSTM_CHUNK = 64
GATE_SOFTCAP = 15.0
POOL_WINDOWS = (2, 4, 8, 16)
POOL_GROUPS = len(POOL_WINDOWS)
POOL_GROUP_DIM = D_MODEL // POOL_GROUPS
D_FF = ((8 * D_MODEL // 3 + 63) // 64) * 64
FFN_CONV_WIDTH = 3
RMS_EPS = 1e-6

kernel_name = "hybrid_mlstm_pool_convffn"


def rmsnorm(x, g):
    xf = x.astype(jnp.float32)
    y = xf * lax.rsqrt(jnp.mean(xf * xf, axis=-1, keepdims=True) + RMS_EPS)
    return (y * g.astype(jnp.float32)).astype(x.dtype)


def softcap(a):
    return GATE_SOFTCAP * jnp.tanh(a / GATE_SOFTCAP)


def mlstm_chunkwise(q, k, v, i_pre, logf):
    B, H, S, _ = q.shape
    L = MLSTM_CHUNK
    NC = S // L

    def to_chunks(a):
        return jnp.moveaxis(a.reshape(B, H, NC, L, *a.shape[3:]), 2, 0)

    causal = jnp.tril(jnp.ones((L, L), dtype=bool))

    def step(carry, inp):
        C, n, m = carry
        qj, kj, vj, ij, fj = inp
        b = jnp.cumsum(fj, axis=-1)
        log_inter = b + m[..., None]
        log_intra = b[..., :, None] - b[..., None, :] + ij[..., None, :]
        log_intra = jnp.where(causal, log_intra, -jnp.inf)
        m_t = jnp.maximum(log_inter, jnp.max(log_intra, axis=-1))
        w_inter = jnp.exp(log_inter - m_t)
        w_intra = jnp.exp(log_intra - m_t[..., None])
        s = jnp.einsum("bhtd,bhsd->bhts", qj, kj) * w_intra
        num = (w_inter[..., None] * jnp.einsum("bhtd,bhde->bhte", qj, C)
               + jnp.einsum("bhts,bhse->bhte", s, vj))
        den = w_inter * jnp.einsum("bhtd,bhd->bht", qj, n) + jnp.sum(s, axis=-1)
        h = num / jnp.maximum(jnp.abs(den), jnp.exp(-m_t))[..., None]
        b_last = b[..., -1]
        log_prev = b_last + m
        log_in = b_last[..., None] - b + ij
        m_new = jnp.maximum(log_prev, jnp.max(log_in, axis=-1))
        a_prev = jnp.exp(log_prev - m_new)
        ka = jnp.exp(log_in - m_new[..., None])[..., None] * kj
        C_new = a_prev[..., None, None] * C + jnp.einsum("bhsd,bhse->bhde", ka, vj)
        n_new = a_prev[..., None] * n + jnp.sum(ka, axis=2)
        return (C_new, n_new, m_new), h

    init = (jnp.zeros((B, H, MLSTM_DQK, MLSTM_DV), jnp.float32),
            jnp.zeros((B, H, MLSTM_DQK), jnp.float32),
            jnp.zeros((B, H), jnp.float32))
    _, hs = lax.scan(step, init, (to_chunks(q), to_chunks(k), to_chunks(v),
                                  to_chunks(i_pre), to_chunks(logf)))
    return jnp.moveaxis(hs, 0, 2).reshape(B, H, S, MLSTM_DV)


def mlstm_mixer(xn, w_in, b_i, b_f, head_g, w_out):
    B, S, _ = xn.shape
    H = MLSTM_HEADS
    proj = jnp.einsum("bsd,dp->bsp", xn, w_in)
    q, k, v, o, ig, fg = jnp.split(proj, MLSTM_SPLITS, axis=-1)

    def heads(a, dh):
        return a.reshape(B, S, H, dh).transpose(0, 2, 1, 3).astype(jnp.float32)

    q = heads(q, MLSTM_DQK) * (MLSTM_DQK ** -0.5)
    k = heads(k, MLSTM_DQK)
    v = heads(v, MLSTM_DV)
    i_pre = softcap(ig.astype(jnp.float32) + b_i.astype(jnp.float32)).transpose(0, 2, 1)
    logf = jax.nn.log_sigmoid(softcap(fg.astype(jnp.float32) + b_f.astype(jnp.float32))).transpose(0, 2, 1)
    h = mlstm_chunkwise(q, k, v, i_pre, logf)
    h = h * lax.rsqrt(jnp.mean(h * h, axis=-1, keepdims=True) + RMS_EPS)
    h = h.transpose(0, 2, 1, 3).reshape(B, S, H * MLSTM_DV) * head_g.astype(jnp.float32)
    h = (h * jax.nn.sigmoid(o.astype(jnp.float32))).astype(xn.dtype)
    return jnp.einsum("bse,ed->bsd", h, w_out)


def pool_mixer(xn, w_group, scale):
    B, S, D = xn.shape
    xg = xn.astype(jnp.float32).reshape(B, S, POOL_GROUPS, POOL_GROUP_DIM)
    t = jnp.arange(1, S + 1, dtype=jnp.float32)
    outs = []
    for g, w in enumerate(POOL_WINDOWS):
        xs = xg[:, :, g]
        c = jnp.cumsum(xs, axis=1)
        c_shift = jnp.concatenate(
            [jnp.zeros((B, w, POOL_GROUP_DIM), jnp.float32), c[:, :S - w]], axis=1)
        cnt = jnp.minimum(t, float(w))[None, :, None]
        outs.append((c - c_shift) / cnt - xs)
    pooled = jnp.stack(outs, axis=2)
    y = jnp.einsum("bsgc,gce->bsge", pooled, w_group.astype(jnp.float32)).reshape(B, S, D)
    return (y * scale.astype(jnp.float32)).astype(xn.dtype)


def conv_ffn(xn, w_in, conv_w, conv_b, w_out):
    S = xn.shape[1]
    h = jnp.einsum("bsd,df->bsf", xn, w_in)
    hp = jnp.pad(h, ((0, 0), (FFN_CONV_WIDTH - 1, 0), (0, 0)))
    hc = conv_b
    for j in range(FFN_CONV_WIDTH):
        hc = hc + conv_w[j] * hp[:, j:j + S]
    g, u = jnp.split(hc, 2, axis=-1)
    return jnp.einsum("bsf,fd->bsd", jax.nn.silu(g) * u, w_out)


def setup_inputs(seed: int = 0) -> dict:
    key = jax.random.key(seed)
    ks = jax.random.split(key, 16)

    def nrm(k, shape, scale):
        return jax.random.normal(k, shape, jnp.float32) * scale

    NA, NB, H = N_MLSTM_LAYERS, N_POOL_LAYERS, MLSTM_HEADS
    return {
        "x": nrm(ks[0], (BATCH, SEQ, D_MODEL), 1.0),
        "mlstm_norm_g": 1.0 + nrm(ks[1], (NA, D_MODEL), 0.02),
        "mlstm_w_in": nrm(ks[2], (NA, D_MODEL, MLSTM_PROJ), D_MODEL ** -0.5),
        "mlstm_b_i": nrm(ks[3], (NA, H), 0.1),
        "mlstm_b_f": jnp.linspace(3.0, 6.0, H, dtype=jnp.float32)[None] + nrm(ks[4], (NA, H), 0.1),
        "mlstm_head_g": 1.0 + nrm(ks[5], (NA, H * MLSTM_DV), 0.02),
        "mlstm_w_out": nrm(ks[6], (NA, H * MLSTM_DV, D_MODEL), (H * MLSTM_DV) ** -0.5),
        "pool_norm_g": 1.0 + nrm(ks[7], (NB, D_MODEL), 0.02),
        "pool_w_group": nrm(ks[8], (NB, POOL_GROUPS, POOL_GROUP_DIM, POOL_GROUP_DIM), POOL_GROUP_DIM ** -0.5),
        "pool_scale": 1.0 + nrm(ks[9], (NB, D_MODEL), 0.1),
        "ffn_norm_g": 1.0 + nrm(ks[10], (DEPTH, D_MODEL), 0.02),
        "ffn_w_in": nrm(ks[11], (DEPTH, D_MODEL, 2 * D_FF), D_MODEL ** -0.5),
        "ffn_conv_w": nrm(ks[12], (DEPTH, FFN_CONV_WIDTH, 2 * D_FF), FFN_CONV_WIDTH ** -0.5),
        "ffn_conv_b": nrm(ks[13], (DEPTH, 2 * D_FF), 0.01),
        "ffn_w_out": nrm(ks[14], (DEPTH, D_FF, D_MODEL), D_FF ** -0.5),
        "final_norm_g": 1.0 + nrm(ks[15], (D_MODEL,), 0.02),
    }


def reference(x, mlstm_norm_g, mlstm_w_in, mlstm_b_i, mlstm_b_f, mlstm_head_g, mlstm_w_out,
              pool_norm_g, pool_w_group, pool_scale,
              ffn_norm_g, ffn_w_in, ffn_conv_w, ffn_conv_b, ffn_w_out, final_norm_g):
    for layer in range(DEPTH):
        j = layer // N_MIXERS
        if layer % N_MIXERS == 0:
            x = x + mlstm_mixer(rmsnorm(x, mlstm_norm_g[j]), mlstm_w_in[j], mlstm_b_i[j],
                                mlstm_b_f[j], mlstm_head_g[j], mlstm_w_out[j])
        else:
            x = x + pool_mixer(rmsnorm(x, pool_norm_g[j]), pool_w_group[j], pool_scale[j])
        x = x + conv_ffn(rmsnorm(x, ffn_norm_g[layer]), ffn_w_in[layer], ffn_conv_w[layer],
                         ffn_conv_b[layer], ffn_w_out[layer])
    return rmsnorm(x, final_norm_g)
```

```cpp
#include <hip/hip_runtime.h>
#include <cstdio>
#include <cstdint>

#ifndef MK_N_LAUNCHES
#define MK_N_LAUNCHES 1
#endif

#define GAS __attribute__((address_space(1)))
#define LAS __attribute__((address_space(3)))
typedef unsigned short bf16;
typedef short bf16x8 __attribute__((ext_vector_type(8)));
typedef short bf16x4 __attribute__((ext_vector_type(4)));
typedef float f32x4 __attribute__((ext_vector_type(4)));
typedef float f32x2 __attribute__((ext_vector_type(2)));
typedef unsigned u32x4 __attribute__((ext_vector_type(4)));
typedef unsigned u32x2 __attribute__((ext_vector_type(2)));
typedef GAS unsigned gu32;

constexpr int D = 4096, BATCH = 8, SEQ = 2048, M = BATCH * SEQ;
constexpr int NH = 8, DQK = 256, DV = 512, QKW = 2048, VW = 4096;
constexpr int NPROJ = 12288, PROJ_W = 12304;
constexpr int DFF = 10944, DFF2 = 21888, FT = 86, NFF1 = FT * 256  , KFF2 = FT * 128  ;
constexpr float EPS = 1e-6f;
constexpr int NPHASE = 14;

constexpr size_t MiB = 1u << 20;
constexpr size_t WS_CTL = 0, CTL_ZERO_BYTES = 131072;
constexpr size_t WS_WP = 2 * MiB;
constexpr size_t WS_WG = WS_WP + (size_t)NPROJ * D * 2;
constexpr size_t WS_WO = WS_WG + 1 * MiB;
constexpr size_t WS_W1 = WS_WO + (size_t)D * D * 2;
constexpr size_t WS_W2 = WS_W1 + 2 * (size_t)NFF1 * D * 2;
constexpr size_t WS_WPOOL = WS_W2 + 2 * (size_t)D * KFF2 * 2;
constexpr size_t WS_CONVP = WS_WPOOL + 4 * (size_t)1024 * 1024 * 2;
constexpr size_t WS_XA = WS_CONVP + 1 * MiB;
constexpr size_t WS_XB = WS_XA + (size_t)M * D * 2;
constexpr size_t WS_PROJ = WS_XB + (size_t)M * D * 2;
constexpr size_t WS_HB = WS_PROJ + (size_t)M * NPROJ * 2;
constexpr size_t WS_SS = WS_HB + (size_t)M * D * 2;
constexpr size_t WS_GATES = WS_SS + (size_t)M * 32 * 4;
constexpr size_t WS_RSS = WS_GATES + (size_t)M * 16 * 4;
constexpr size_t WS_HALO = WS_RSS + (size_t)M * 64 * 4;
constexpr size_t WS_END = WS_HALO + (size_t)64 * 4 * NFF1 * 4;
constexpr size_t WS_PART = WS_END, WS_END2 = WS_PART + (size_t)128 * 65536 * 4;
static_assert((size_t)M * KFF2 * 2 <= (size_t)M * NPROJ * 2, "GATED overlays PROJ");

constexpr int CW_TMO = 0, CW_BAR = 4096, CW_SPLIT = 8192;
static_assert((CW_BAR + 3456) <= CW_SPLIT && (CW_SPLIT + 64 * 128) * 4 <= (int)CTL_ZERO_BYTES, "control words inside the memset region");

constexpr int RING_OFF = 0, RING_BYTES = 131072;
constexpr int RSTD_OFF = 131072;
constexpr int CONVP_OFF = RSTD_OFF + 1024;
constexpr int EXCH_OFF = CONVP_OFF + 8192;
constexpr int LDSCTL_OFF = EXCH_OFF + 8192;
constexpr int MISC_OFF = LDSCTL_OFF + 64;
constexpr int LDS_BYTES = LDSCTL_OFF + 512;
static_assert(LDS_BYTES <= 160 * 1024, "LDS");

#define RLX_AGENT __ATOMIC_RELAXED, __HIP_MEMORY_SCOPE_AGENT
#define LDS_WAIT() asm volatile("s_waitcnt lgkmcnt(0)" ::: "memory")
#define VM_WAIT() asm volatile("s_waitcnt vmcnt(0)" ::: "memory")
__device__ __forceinline__ unsigned f2bf(float f) { unsigned u = __builtin_bit_cast(unsigned, f); return (u + 0x7fffu + ((u >> 16) & 1u)) >> 16; }
__device__ __forceinline__ unsigned pk2(float lo, float hi) { return f2bf(lo) | (f2bf(hi) << 16); }
__device__ __forceinline__ float bf2f(unsigned b) { return __builtin_bit_cast(float, b << 16); }
__device__ __forceinline__ unsigned cvt_pk_bf16(float lo, float hi) { unsigned r; asm volatile("v_cvt_pk_bf16_f32 %0, %1, %2" : "=v"(r) : "v"(lo), "v"(hi)); return r; }

#ifndef PG8_BAL
#define PG8_BAL 1
#endif
#ifndef PG8_LOADPRIO
#define PG8_LOADPRIO 3
#endif
namespace pg8 {
constexpr int BM = 256, BK = 64, HALF = 128, HTB = HALF * BK * 2, STAGE_BYTES = 8 * HTB;
__host__ __device__ __forceinline__ int lds_byte(int r, int c) { const int st = (r >> 4) * 2 + (c >> 5), rr = r & 15, cc = c & 31, ob = rr * 64 + cc * 2; return st * 1024 + (ob ^ (((ob >> 9) & 1) << 5)); }
__host__ __device__ __forceinline__ void stage_rc(int b, int& R, int& C) { const int st = b / 1024, sb = b % 1024, swz = sb ^ (((sb >> 9) & 1) << 5); R = (st >> 1) * 16 + swz / 64; C = (st & 1) * 32 + (swz % 64) / 2; }
__host__ __device__ __forceinline__ int perm32(int rho) { const int n = rho >> 4, i = rho & 15; return 8 * (i >> 2) + 4 * n + (i & 3); }

struct Unit { int pm, pn; int kt0, nkt; };
struct Gemm { const bf16* A; const bf16* Bt; int lda, ldb, K; int agrp_shift, agrp_stride; };

struct RowOrder {
    static constexpr bool SPLIT = false;
    int pm, pn0, nN;
    __device__ __forceinline__ void init(int nN_, int c) { const int x = c & 7, j = c >> 3; pm = 8 * x + (j & 7); pn0 = j >> 3; nN = nN_; }
    __device__ __forceinline__ bool next(int i, Unit& u) const { const int pn = 4 * i + pn0; u.pm = pm; u.pn = pn; return pn < nN; }
};

struct WideOrder {
    static constexpr bool SPLIT = false;
    int x, j;
    __device__ __forceinline__ void init(int, int c) { x = c & 7; j = c >> 3; }
    __device__ __forceinline__ bool next(int i, Unit& u) const { u.pm = 8 * x + 4 * (i >> 1) + (j & 3); u.pn = 8 * (i & 1) + (j >> 2); return i < 4; }
};
struct TailOrder {
    static constexpr bool SPLIT = true;
    int pm, pn0;
    __device__ __forceinline__ void init(int c) { const int x = c & 7, j = c >> 3; pm = 8 * x + (j & 7); pn0 = j >> 3; }
    __device__ __forceinline__ bool next(int i, Unit& u) const { u.pm = pm; u.pn = 84 + (pn0 & 1); u.kt0 = pn0 < 2 ? 0 : 32; u.nkt = 32; return i == 0; }
};
template <class Epi, class Sched, int PV = 0>
__device__ __forceinline__ void gemm_phase(LAS unsigned char* lds, const Gemm g, const Sched& S, Epi& E) {
    const int tid = threadIdx.x, wid = __builtin_amdgcn_readfirstlane(tid >> 6), lane = tid & 63, wr = wid >> 2, wc = wid & 3, fr = lane & 15, fq = lane >> 4;
    int nt = g.K / BK;
    const unsigned kstep = (unsigned)(BK * 2);
    const unsigned hstepA = (unsigned)HALF * g.lda * 2, hstepB = (unsigned)HALF * g.ldb * 2;
    unsigned voffA0[2], voffB0[2];
#pragma unroll
    for (int i = 0; i < 2; ++i) { int R, C; stage_rc(tid * 16 + i * 8192, R, C); const int Rb = Epi::PERM ? ((R & ~31) + perm32(R & 31)) : R;
        const int Ra = Epi::APERM ? ((R & 64) + 4 * (R & 15) + ((R >> 4) & 3)) : R;
        voffA0[i] = (unsigned)(Ra * g.lda + C) * 2u; voffB0[i] = (unsigned)(Rb * g.ldb + C) * 2u; }
    const __amdgpu_buffer_rsrc_t rsA = __builtin_amdgcn_make_buffer_rsrc((void*)g.A, 0, 0x7fffffff, 0x00020000), rsB = __builtin_amdgcn_make_buffer_rsrc((void*)g.Bt, 0, 0x7fffffff, 0x00020000);
    const unsigned ldsw = (unsigned)wid * 1024u;
    const int aoff = lds_byte(wr * 64 + fr, fq * 8), boff = lds_byte(wc * 32 + fr, fq * 8);
#define PG8_SA(b, h) (((b) * 2 + (h)) * HTB)
#define PG8_SB(b, h) ((4 + (b) * 2 + (h)) * HTB)
#define PG8_STAGE(rs, bufoff, off, voff) do { _Pragma("unroll") for (int _i = 0; _i < 2; ++_i) \
        __builtin_amdgcn_raw_ptr_buffer_load_lds(rs, (LAS void*)(lds + (bufoff) + ldsw + _i * 8192), 16, (voff)[_i], (unsigned)(off), 0, 0); } while (0)
#define PG8_LDA(dst, b, h) do { _Pragma("unroll") for (int m = 0; m < 4; ++m) _Pragma("unroll") for (int k = 0; k < 2; ++k) dst[m][k] = *(const LAS bf16x8*)(lds + PG8_SA(b, h) + aoff + m * 2048 + k * 1024); } while (0)
#define PG8_LDB(dst, b, h) do { _Pragma("unroll") for (int n = 0; n < 2; ++n) _Pragma("unroll") for (int k = 0; k < 2; ++k) dst[n][k] = *(const LAS bf16x8*)(lds + PG8_SB(b, h) + boff + n * 2048 + k * 1024); } while (0)
#define PG8_MMA2(ai, B0) do { __builtin_amdgcn_s_setprio(1); \
          \
        _Pragma("unroll") for (int n = 0; n < 2; ++n) _Pragma("unroll") for (int m = 0; m < 4; ++m) { \
            _Pragma("unroll") for (int k = 0; k < 2; ++k) acc[ai][0][m][n] = __builtin_amdgcn_mfma_f32_16x16x32_bf16(B0[n][k], At[m][k], acc[ai][0][m][n], 0, 0, 0); \
            __builtin_amdgcn_sched_barrier(0); } \
        _Pragma("unroll") for (int n = 0; n < 2; ++n) _Pragma("unroll") for (int m = 0; m < 4; ++m) { \
            _Pragma("unroll") for (int k = 0; k < 2; ++k) acc[ai][1][m][n] = __builtin_amdgcn_mfma_f32_16x16x32_bf16(B1[n][k], At[m][k], acc[ai][1][m][n], 0, 0, 0); \
            __builtin_amdgcn_sched_barrier(0); } \
        __builtin_amdgcn_s_setprio(PG8_LOADPRIO); } while (0)
#define PG8_WAIT_V(n) asm volatile("s_waitcnt vmcnt(" #n ")" ::: "memory")
#define PG8_WAIT_VL(n) __builtin_amdgcn_s_waitcnt(0x0070 | (n))
#define PG8_BAR __builtin_amdgcn_s_barrier()
#define PG8_SCHED __builtin_amdgcn_sched_barrier(0)
#define PG8_ITER(oA1, oA2, oB2, oB3, lastrd) do { \
            PG8_LDB(B1, 0, 1); PG8_SCHED; PG8_LDA(At, 0, 0); PG8_STAGE(rsA, PG8_SA(1, 0), oA1, voffA0); PG8_STAGE(rsA, PG8_SA(1, 1), (oA1) + hstepA, voffA0); \
            PG8_WAIT_VL(6); PG8_BAR; PG8_MMA2(0, B0e); PG8_BAR; PG8_SCHED; \
            PG8_LDA(At, 0, 1); PG8_LDB(B0o, 1, 0); PG8_STAGE(rsB, PG8_SB(0, 0), oB2, voffB0); PG8_STAGE(rsB, PG8_SB(0, 1), (oB2) + hstepB, voffB0); \
            PG8_WAIT_VL(6); PG8_BAR; PG8_MMA2(1, B0e); PG8_BAR; PG8_SCHED; \
            PG8_LDB(B1, 1, 1); PG8_SCHED; PG8_LDA(At, 1, 0); PG8_STAGE(rsA, PG8_SA(0, 0), oA2, voffA0); PG8_STAGE(rsA, PG8_SA(0, 1), (oA2) + hstepA, voffA0); \
            PG8_WAIT_VL(6); PG8_BAR; PG8_MMA2(0, B0o); PG8_BAR; PG8_SCHED; \
            PG8_LDA(At, 1, 1); if (lastrd) { PG8_LDB(B0e, 0, 0); } PG8_STAGE(rsB, PG8_SB(1, 0), oB3, voffB0); PG8_STAGE(rsB, PG8_SB(1, 1), (oB3) + hstepB, voffB0); \
            PG8_WAIT_VL(6); PG8_BAR; PG8_MMA2(1, B0o); PG8_BAR; PG8_SCHED; } while (0)
    Unit cur, nxt; int ui = 0;
    if (!S.next(0, cur)) return;
    f32x4 acc[2][2][4][2];
#pragma unroll
    for (int a = 0; a < 2; ++a)
#pragma unroll
        for (int b = 0; b < 2; ++b)
#pragma unroll
            for (int m = 0; m < 4; ++m)
#pragma unroll
                for (int n = 0; n < 2; ++n) acc[a][b][m][n] = (f32x4){0.f, 0.f, 0.f, 0.f};
    bf16x8 At[4][2], B0e[2][2], B0o[2][2], B1[2][2];
    unsigned cA = (unsigned)cur.pm * 2 * hstepA + (unsigned)((cur.pn >> g.agrp_shift) * g.agrp_stride) * 2; unsigned cB = (unsigned)cur.pn * 2 * hstepB;
    if constexpr (Sched::SPLIT) { nt = cur.nkt; cA += (unsigned)cur.kt0 * kstep; cB += (unsigned)cur.kt0 * kstep; }
    E.unit_begin(cur, 0, wid, lane);
    PG8_STAGE(rsB, PG8_SB(0, 0), cB, voffB0); PG8_STAGE(rsB, PG8_SB(0, 1), cB + hstepB, voffB0); PG8_STAGE(rsA, PG8_SA(0, 0), cA, voffA0); PG8_STAGE(rsA, PG8_SA(0, 1), cA + hstepA, voffA0);
    if (wr == 1) PG8_BAR;
    PG8_STAGE(rsB, PG8_SB(1, 0), cB + kstep, voffB0); PG8_STAGE(rsB, PG8_SB(1, 1), cB + kstep + hstepB, voffB0);
    PG8_WAIT_V(6); PG8_BAR; PG8_BAR;
    PG8_LDB(B0e, 0, 0);
    for (;;) {
        const bool has_next = S.next(ui + 1, nxt);
        unsigned nko = 0; if constexpr (Sched::SPLIT) nko = has_next ? (unsigned)nxt.kt0 * kstep : 0;
        const unsigned nA = has_next ? (unsigned)nxt.pm * 2 * hstepA + (unsigned)((nxt.pn >> g.agrp_shift) * g.agrp_stride) * 2 + nko : cA; const unsigned nB = has_next ? (unsigned)nxt.pn * 2 * hstepB + nko : cB;
        unsigned oA = cA + kstep, oB = cB + 2 * kstep;
        for (int t = 0; t < nt; t += 2) {
            const bool last = (t == nt - 2);
            const unsigned a2 = last ? nA : oA + kstep, b2 = last ? nB : oB;
            PG8_ITER(oA, a2, b2, b2 + kstep, !last); oA += 2 * kstep; oB += 2 * kstep; }
        if (wr == 0) PG8_BAR;
        E(acc, cur, ui, wr, wc, fr, fq);
        if (!has_next) break;
        { f32x2 z2 = (f32x2){0.f, 0.f}; asm volatile("" : "+v"(z2));
#pragma unroll
        for (int a = 0; a < 2; ++a)
#pragma unroll
            for (int b = 0; b < 2; ++b)
#pragma unroll
                for (int m = 0; m < 4; ++m)
#pragma unroll
                    for (int n = 0; n < 2; ++n) acc[a][b][m][n] = __builtin_shufflevector(z2, z2, 0, 1, 0, 1); }
        cur = nxt; cA = nA; cB = nB; ++ui; if constexpr (Sched::SPLIT) nt = cur.nkt;
        if (wr == 1) PG8_BAR;
        E.unit_begin(cur, ui, wid, lane);
        PG8_LDB(B0e, 0, 0);
    }
    PG8_WAIT_V(0);
    PG8_BAR;
#undef PG8_SA
#undef PG8_SB
#undef PG8_STAGE
#undef PG8_LDA
#undef PG8_LDB
#undef PG8_MMA2
#undef PG8_WAIT_V
#undef PG8_WAIT_VL
#undef PG8_BAR
#undef PG8_SCHED
#undef PG8_ITER
}

struct EpiProj {
    static constexpr bool PERM = true, APERM = false;
    bf16* O; int ldc;
    __device__ __forceinline__ void unit_begin(const Unit&, int, int, int) const {}
    __device__ __forceinline__ void operator()(const f32x4 (&acc)[2][2][4][2], const Unit& u, int, int wr, int wc, int fr, int fq) const {
        asm volatile("" : "+v"(fr), "+v"(fq));
        const int row0 = u.pm * BM + wr * 64 + fr, col0 = u.pn * BM + wc * 32 + 8 * fq; const float sc = u.pn < 8 ? 0.0625f : 1.f;
#pragma unroll
        for (int ai = 0; ai < 2; ++ai)
#pragma unroll
            for (int m = 0; m < 4; ++m) { bf16* rowp = O + (size_t)(row0 + ai * HALF + m * 16) * ldc + col0;
#pragma unroll
                for (int bj = 0; bj < 2; ++bj) { const f32x4 v0 = acc[ai][bj][m][0] * sc, v1 = acc[ai][bj][m][1] * sc;
                    u32x4 w; w.x = cvt_pk_bf16(v0[0], v0[1]); w.y = cvt_pk_bf16(v0[2], v0[3]); w.z = cvt_pk_bf16(v1[0], v1[1]); w.w = cvt_pk_bf16(v1[2], v1[3]);
                    *(u32x4*)(rowp + bj * HALF) = w; } }
    }
};

struct EpiNull {
    static constexpr bool PERM = false, APERM = false;
    __device__ __forceinline__ void unit_begin(const Unit&, int, int, int) const {}
    __device__ __forceinline__ void operator()(const f32x4 (&acc)[2][2][4][2], const Unit&, int, int, int, int, int) const {
#pragma unroll
        for (int ai = 0; ai < 2; ++ai)
#pragma unroll
            for (int bj = 0; bj < 2; ++bj)
#pragma unroll
                for (int m = 0; m < 4; ++m)
#pragma unroll
                    for (int n = 0; n < 2; ++n) asm volatile("" :: "v"(acc[ai][bj][m][n]));
    }
};
template <bool BASE_F32> struct EpiResid {
    static constexpr bool PERM = true, APERM = false;
    const void* base; const float* ginv_src; const float* colscale; bf16* O; const float* gA; float* rss;
    __device__ __forceinline__ void unit_begin(const Unit&, int, int, int) const {}
    __device__ __forceinline__ void operator()(const f32x4 (&acc)[2][2][4][2], const Unit& u, int, int wr, int wc, int fr, int fq) const {
        asm volatile("" : "+v"(fr), "+v"(fq));
        const int row0 = u.pm * BM + wr * 64 + fr, col0 = u.pn * BM + wc * 32 + 8 * fq;
        f32x4 cs[2][2], gv[2][2], gi[2][2];
#pragma unroll
        for (int bj = 0; bj < 2; ++bj)
#pragma unroll
            for (int n = 0; n < 2; ++n) { const int cc = col0 + bj * HALF + 4 * n;
                cs[bj][n] = colscale ? *(const f32x4*)(colscale + cc) : (f32x4){1.f, 1.f, 1.f, 1.f};
                gv[bj][n] = gA ? *(const f32x4*)(gA + cc) : (f32x4){1.f, 1.f, 1.f, 1.f};
                if (ginv_src) { const f32x4 t = *(const f32x4*)(ginv_src + cc); gi[bj][n] = (f32x4){1.0f / t[0], 1.0f / t[1], 1.0f / t[2], 1.0f / t[3]}; } else gi[bj][n] = (f32x4){1.f, 1.f, 1.f, 1.f}; }
#pragma unroll
        for (int ai = 0; ai < 2; ++ai) {
            f32x4 pb[4][2][2]; u32x4 pw[4][2];
#pragma unroll
            for (int m = 0; m < 4; ++m) { const size_t off = (size_t)(row0 + ai * HALF + m * 16) * D + col0;
#pragma unroll
                for (int bj = 0; bj < 2; ++bj) {
                    if (BASE_F32) { pb[m][bj][0] = __builtin_nontemporal_load((const f32x4*)((const float*)base + off + bj * HALF)); pb[m][bj][1] = __builtin_nontemporal_load((const f32x4*)((const float*)base + off + bj * HALF + 4)); }
                    else pw[m][bj] = *(const u32x4*)((const bf16*)base + off + bj * HALF); } }
#pragma unroll
            for (int m = 0; m < 4; ++m) { const int r = row0 + ai * HALF + m * 16; const size_t off = (size_t)r * D + col0; float ss = 0.f;
#pragma unroll
                for (int bj = 0; bj < 2; ++bj) { f32x4 b0, b1;
                    if (BASE_F32) { b0 = pb[m][bj][0]; b1 = pb[m][bj][1]; }
                    else { const u32x4 w = pw[m][bj];
                        b0 = (f32x4){bf2f(w.x & 0xffffu), bf2f(w.x >> 16), bf2f(w.y & 0xffffu), bf2f(w.y >> 16)}; b1 = (f32x4){bf2f(w.z & 0xffffu), bf2f(w.z >> 16), bf2f(w.w & 0xffffu), bf2f(w.w >> 16)}; }
                    const f32x4 v0 = b0 * gi[bj][0] + acc[ai][bj][m][0] * cs[bj][0], v1 = b1 * gi[bj][1] + acc[ai][bj][m][1] * cs[bj][1];
                    ss += ((v0[0] * v0[0] + v0[1] * v0[1]) + (v0[2] * v0[2] + v0[3] * v0[3])) + ((v1[0] * v1[0] + v1[1] * v1[1]) + (v1[2] * v1[2] + v1[3] * v1[3]));
                    const f32x4 a0 = v0 * gv[bj][0], a1 = v1 * gv[bj][1];
                    u32x4 w; w.x = cvt_pk_bf16(a0[0], a0[1]); w.y = cvt_pk_bf16(a0[2], a0[3]); w.z = cvt_pk_bf16(a1[0], a1[1]); w.w = cvt_pk_bf16(a1[2], a1[3]);
                    *(u32x4*)(O + off + bj * HALF) = w; }
                ss += __shfl_xor(ss, 16); ss += __shfl_xor(ss, 32);
                if (fq == 0) rss[(size_t)r * 64 + u.pn * 4 + wc] = ss; }
            asm volatile("" ::: "memory");
        }
    }
};

__device__ __forceinline__ float dpp_shr1(float old, float src) { return __builtin_bit_cast(float, __builtin_amdgcn_update_dpp(__builtin_bit_cast(int, old), __builtin_bit_cast(int, src), 0x111, 0xf, 0xf, false)); }
__device__ __forceinline__ float dpp_shr2(float old, float src) { return __builtin_bit_cast(float, __builtin_amdgcn_update_dpp(__builtin_bit_cast(int, old), __builtin_bit_cast(int, src), 0x112, 0xf, 0xf, false)); }
__device__ __forceinline__ float dpp_ror1(float src) { return __builtin_bit_cast(float, __builtin_amdgcn_mov_dpp(__builtin_bit_cast(int, src), 0x121, 0xf, 0xf, true)); }
__device__ __forceinline__ float dpp_ror2(float src) { return __builtin_bit_cast(float, __builtin_amdgcn_mov_dpp(__builtin_bit_cast(int, src), 0x122, 0xf, 0xf, true)); }
__device__ __forceinline__ float silu_f(float x) { return x * __builtin_amdgcn_rcpf(1.0f + __builtin_amdgcn_exp2f(-1.44269504089f * x)); }
template <int KIND  > struct EpiFfn1T {
    static constexpr bool PERM = true, APERM = true;
    bf16* O; const float* convp; float* halo; LAS unsigned char* lds; float* part; unsigned* flag; unsigned epoch;
    __device__ __forceinline__ void unit_begin(const Unit& u, int ui, int wid, int lane) const {
        if (wid < 4)
            __builtin_amdgcn_global_load_lds((const unsigned*)((const char*)convp + (size_t)u.pn * 4096 + wid * 1024 + lane * 16), (LAS unsigned*)(lds + CONVP_OFF + (ui & 1) * 4096 + wid * 1024), 16, 0, 0);
    }
    __device__ __forceinline__ void operator()(f32x4 (&acc)[2][2][4][2], const Unit& u, int ui, int wr, int wc, int fr, int fq) const {
        asm volatile("" : "+v"(fr), "+v"(fq));
        const int wid = wr * 4 + wc;
        if constexpr (KIND == 2) {
            const __amdgpu_buffer_rsrc_t rsrc = __builtin_amdgcn_make_buffer_rsrc((void*)part, 0, 262144, 0x00020000);
            const int voff = (wid * 64 + fq * 16 + fr) * 16;
#pragma unroll
            for (int ai = 0; ai < 2; ++ai)
#pragma unroll
                for (int bj = 0; bj < 2; ++bj)
#pragma unroll
                    for (int m = 0; m < 4; ++m)
#pragma unroll
                        for (int n = 0; n < 2; ++n) __builtin_amdgcn_raw_buffer_store_b128(__builtin_bit_cast(u32x4, acc[ai][bj][m][n]), rsrc, voff + (((ai * 2 + bj) * 4 + m) * 2 + n) * 8192, 0, 16);
            asm volatile("s_waitcnt vmcnt(0)" ::: "memory"); __builtin_amdgcn_s_barrier(); asm volatile("" ::: "memory");
            if (wid == 0 && fq == 0 && fr == 0) __hip_atomic_store(flag, epoch, __ATOMIC_RELAXED, __HIP_MEMORY_SCOPE_AGENT);
            return;
        }
        if constexpr (KIND == 1) {
            if (wid == 0) { unsigned sp = 0;
                while ((unsigned)__builtin_amdgcn_readfirstlane(__hip_atomic_load(flag, __ATOMIC_RELAXED, __HIP_MEMORY_SCOPE_AGENT)) < epoch) { __builtin_amdgcn_s_sleep(2); if (++sp > (1u << 22)) break; }
                __builtin_amdgcn_fence(__ATOMIC_ACQUIRE, "agent"); asm volatile("s_waitcnt vmcnt(0)" ::: "memory"); }
            asm volatile("" ::: "memory"); __builtin_amdgcn_s_barrier(); asm volatile("" ::: "memory");
            const f32x4* pp = (const f32x4*)part + (wid * 64 + fq * 16 + fr);
#pragma unroll
            for (int ai = 0; ai < 2; ++ai)
#pragma unroll
                for (int bj = 0; bj < 2; ++bj) {
                    f32x4 t8[4][2];
#pragma unroll
                    for (int m = 0; m < 4; ++m)
#pragma unroll
                        for (int n = 0; n < 2; ++n) t8[m][n] = pp[(((ai * 2 + bj) * 4 + m) * 2 + n) * 512];
#pragma unroll
                    for (int m = 0; m < 4; ++m)
#pragma unroll
                        for (int n = 0; n < 2; ++n) acc[ai][bj][m][n] += t8[m][n];
                    asm volatile("" : "+v"(acc[ai][bj][0][0]), "+v"(acc[ai][bj][0][1]), "+v"(acc[ai][bj][1][0]), "+v"(acc[ai][bj][1][1]), "+v"(acc[ai][bj][2][0]), "+v"(acc[ai][bj][2][1]), "+v"(acc[ai][bj][3][0]), "+v"(acc[ai][bj][3][1]) :: "memory"); }
            asm volatile("" : "+v"(fr), "+v"(fq));
        }
        const LAS float* rstd = (const LAS float*)(lds + RSTD_OFF);
        const LAS float* cp = (const LAS float*)(lds + CONVP_OFF + (ui & 1) * 4096);
        LAS float* ex = (LAS float*)(lds + EXCH_OFF);
#pragma unroll
        for (int ai = 0; ai < 2; ++ai) { const f32x4 rs4 = *(const LAS f32x4*)(rstd + ai * HALF + wr * 64 + 4 * fr);
#pragma unroll
            for (int m = 0; m < 4; ++m)
#pragma unroll
                for (int bj = 0; bj < 2; ++bj)
#pragma unroll
                    for (int n = 0; n < 2; ++n) acc[ai][bj][m][n] *= rs4[m]; }
        if (fr == 15) {
#pragma unroll
            for (int ai = 0; ai < 2; ++ai)
#pragma unroll
                for (int bj = 0; bj < 2; ++bj)
#pragma unroll
                    for (int n = 0; n < 2; ++n) { *(LAS f32x4*)(ex + ((wid * 2 + ai) * 2 + 0) * 64 + (bj * 2 + n) * 16 + fq * 4) = acc[ai][bj][2][n]; *(LAS f32x4*)(ex + ((wid * 2 + ai) * 2 + 1) * 64 + (bj * 2 + n) * 16 + fq * 4) = acc[ai][bj][3][n]; }
        }
        {
            const int colb = u.pn * BM + wc * 32 + 8 * fq;
            if (wr == 0 && fr == 0) {
#pragma unroll
                for (int rr = 0; rr < 2; ++rr)
#pragma unroll
                    for (int bj = 0; bj < 2; ++bj)
#pragma unroll
                        for (int n = 0; n < 2; ++n) *(f32x4*)(halo + ((size_t)u.pm * 4 + rr) * NFF1 + colb + bj * HALF + 4 * n) = acc[0][bj][rr][n];
            }
            if (wr == 1 && fr == 15) {
#pragma unroll
                for (int rr = 0; rr < 2; ++rr)
#pragma unroll
                    for (int bj = 0; bj < 2; ++bj)
#pragma unroll
                        for (int n = 0; n < 2; ++n) *(f32x4*)(halo + ((size_t)u.pm * 4 + 2 + rr) * NFF1 + colb + bj * HALF + 4 * n) = acc[1][bj][2 + rr][n];
            }
        }
        LDS_WAIT(); __builtin_amdgcn_s_barrier(); asm volatile("" ::: "memory");
        const int row0 = u.pm * BM + wr * 64 + 4 * fr, colo = u.pn * HALF + wc * 32 + 8 * fq;
        u32x2 hold[2][4];
        f32x2 kone = (f32x2){1.0f, 1.0f}; asm volatile("" : "+v"(kone));
#pragma unroll
        for (int n = 0; n < 2; ++n) {
            f32x4 pw[4][2];
#pragma unroll
            for (int p = 0; p < 4; ++p)
#pragma unroll
                for (int bj = 0; bj < 2; ++bj) pw[p][bj] = *(const LAS f32x4*)(cp + p * 256 + bj * HALF + wc * 32 + 8 * fq + 4 * n);
#pragma unroll
            for (int ai = 0; ai < 2; ++ai) {
                const int swv = (ai == 1 && wr == 0) ? wid + 4 : wid - 4, sai = (ai == 1 && wr == 1) ? 1 : 0; const bool have = !(ai == 0 && wr == 0);
                f32x4 pm1[2], pm2[2];
#pragma unroll
                for (int bj = 0; bj < 2; ++bj) {
                    f32x4 e0 = (f32x4){0.f, 0.f, 0.f, 0.f}, e1 = e0;
                    if (have) { e0 = *(const LAS f32x4*)(ex + ((swv * 2 + sai) * 2 + 0) * 64 + (bj * 2 + n) * 16 + fq * 4); e1 = *(const LAS f32x4*)(ex + ((swv * 2 + sai) * 2 + 1) * 64 + (bj * 2 + n) * 16 + fq * 4); }
#pragma unroll
                    for (int i = 0; i < 4; ++i) { pm1[bj][i] = dpp_shr1(e1[i], acc[ai][bj][3][n][i]); pm2[bj][i] = dpp_shr1(e0[i], acc[ai][bj][2][n][i]); }
                }
#pragma unroll
                for (int m = 0; m < 4; ++m) {
                    f32x4 hc[2];
#pragma unroll
                    for (int bj = 0; bj < 2; ++bj) {
                        const f32x4 cur = acc[ai][bj][m][n];
                        const f32x4 h1 = m == 0 ? pm1[bj] : acc[ai][bj][m == 0 ? 0 : m - 1][n];
                        const f32x4 h2 = m == 0 ? pm2[bj] : (m == 1 ? pm1[bj] : acc[ai][bj][m < 2 ? 0 : m - 2][n]);
                        hc[bj] = pw[3][bj] + pw[0][bj] * h2 + pw[1][bj] * h1 + pw[2][bj] * cur;
                    }
                    const f32x2 e01 = (f32x2){__builtin_amdgcn_exp2f(hc[0][0]), __builtin_amdgcn_exp2f(hc[0][1])}, e23 = (f32x2){__builtin_amdgcn_exp2f(hc[0][2]), __builtin_amdgcn_exp2f(hc[0][3])};
                    const f32x2 d01 = e01 + kone, d23 = e23 + kone;
                    const f32x4 r = (f32x4){__builtin_amdgcn_rcpf(d01[0]), __builtin_amdgcn_rcpf(d01[1]), __builtin_amdgcn_rcpf(d23[0]), __builtin_amdgcn_rcpf(d23[1])};
                    const f32x4 o = (hc[0] * hc[1]) * r;
                    u32x2 w; w.x = cvt_pk_bf16(o[0], o[1]); w.y = cvt_pk_bf16(o[2], o[3]);
                    if (n == 0) hold[ai][m] = w;
                    else *(u32x4*)(O + (size_t)(row0 + ai * HALF + m) * KFF2 + colo) = (u32x4){hold[ai][m].x, hold[ai][m].y, w.x, w.y};
                }
            }
        }
    }
};
}

#define XB_TMO      128
#define XB_XCNT(j)  (256  + 64 * (j))
#define XB_XSUB(j)  (1280 + 64 * (j))
#define XB_XGEN(j)  (2304 + 64 * (j))
#define XB_TOP      3328
#define XB_TOPGEN   3392
#define XCD_BAR_WORDS 3456
#define XB_SPIN_CAP (1u << 18)
__device__ __forceinline__ unsigned xb_ld(unsigned* p)              { return __hip_atomic_load(p, __ATOMIC_RELAXED, __HIP_MEMORY_SCOPE_AGENT); }
__device__ __forceinline__ unsigned xb_add(unsigned* p, unsigned v) { return __hip_atomic_fetch_add(p, v, __ATOMIC_RELAXED, __HIP_MEMORY_SCOPE_AGENT); }
__device__ __forceinline__ unsigned xb_xcc_id() { return (unsigned)__builtin_amdgcn_s_getreg((3 << 11) | 20) & 0xFu; }
#define XB_SPIN(cond, bar) do { unsigned _sp = 0; while (cond) { __builtin_amdgcn_s_sleep(1); \
    if ((++_sp & 255u) == 0u) { if (xb_ld(&(bar)[XB_TMO])) break; if (_sp > XB_SPIN_CAP) { atomicAdd(&(bar)[XB_TMO], 1u); break; } } } } while (0)
struct XcdBarrier { unsigned* bar; unsigned x; volatile LAS unsigned* st; };
__device__ __forceinline__ XcdBarrier xcd_barrier_post(unsigned* bar, volatile LAS unsigned* st) {
    XcdBarrier b; b.bar = bar; b.x = xb_xcc_id(); b.st = st;
    if (threadIdx.x == 0) (void)xb_add(&bar[XB_XCNT(b.x)], 1u);
    return b;
}
__device__ __forceinline__ void xcd_barrier_complete(unsigned* bar, unsigned x, unsigned& nloc, unsigned& nx) {
    const unsigned G = gridDim.x * gridDim.y * gridDim.z;
    unsigned sum, cnt, mine, sp = 0u;
    for (;;) {
        sum = 0u; cnt = 0u; mine = 0u;
#pragma unroll
        for (unsigned j = 0; j < 16; ++j) { const unsigned c = xb_ld(&bar[XB_XCNT(j)]); sum += c; cnt += (c > 0u) ? 1u : 0u; mine = (j == x) ? c : mine; }
        if (sum == G) break;
        __builtin_amdgcn_s_sleep(1);
        if ((++sp & 255u) == 0u) { if (xb_ld(&bar[XB_TMO])) break; if (sp > XB_SPIN_CAP) { atomicAdd(&bar[XB_TMO], 1u); break; } }
    }
    nloc = mine > 0u ? mine : 1u; nx = cnt > 0u ? cnt : 1u;
}
__device__ __forceinline__ void xcd_barrier(const XcdBarrier& b) {
    asm volatile("s_waitcnt vmcnt(0)" ::: "memory");
    __syncthreads();
    if (threadIdx.x == 0) {
        unsigned* bar = b.bar;
        __builtin_amdgcn_s_waitcnt(0);
        unsigned nloc = b.st[0], nx = b.st[1];
        if (nloc == 0u) { xcd_barrier_complete(bar, b.x, nloc, nx); b.st[0] = nloc; b.st[1] = nx; }
        const unsigned old = xb_add(&bar[XB_XSUB(b.x)], 1u);
        const unsigned gen = old / nloc;
        if (old + 1u == (gen + 1u) * nloc) {
            __builtin_amdgcn_fence(__ATOMIC_RELEASE, "agent");
            asm volatile("s_waitcnt vmcnt(0)" ::: "memory");
            const unsigned og = xb_add(&bar[XB_TOP], 1u);
            const unsigned tg = og / nx;
            if (og + 1u == (tg + 1u) * nx) xb_add(&bar[XB_TOPGEN], 1u);
            else XB_SPIN(xb_ld(&bar[XB_TOPGEN]) == tg, bar);
            __builtin_amdgcn_fence(__ATOMIC_ACQUIRE, "agent");
            xb_add(&bar[XB_XGEN(b.x)], 1u);
            asm volatile("s_waitcnt vmcnt(0)" ::: "memory");
        } else {
            XB_SPIN(xb_ld(&bar[XB_XGEN(b.x)]) == gen, bar);
            __builtin_amdgcn_fence(__ATOMIC_ACQUIRE, "agent");
            asm volatile("s_waitcnt vmcnt(0)" ::: "memory");
        }
    }
    __syncthreads();
}

constexpr int NWAVES = 8;
#define WSP(T, off) ((T*)(F.ws + (off)))
struct Args { const float* in[16]; float* out; unsigned char* ws; int ph_lo, ph_hi, li, pad; };
struct Frame {
    LAS unsigned char* lds; int tid, lane, wave, vcu, G;
    unsigned char* ws; float* out;
};
__device__ __forceinline__ float wave_sum(float v) {
#pragma unroll
    for (int o = 1; o < 64; o <<= 1) v += __shfl_xor(v, o);
    return v;
}

constexpr int CV_NB1 = DFF2 / 64, CV_W1 = (D / 32) * CV_NB1, CV_KB2 = DFF / 32, CV_TOTAL = CV_W1 + CV_KB2 * (D / 64);
static_assert(DFF % 64 == 0 && DFF2 % 64 == 0 && DFF % 32 == 0 && D / 32 == 128, "SCANCVT block shapes");
struct CvBlk { const float* src; bf16* dst; unsigned lds; };
__device__ __forceinline__ CvBlk cv_decode(const float* w1src, const float* w2src, unsigned char* ws, int id, int lane) {
    CvBlk b;
    if (id < CV_W1) { const int kb = id & (D / 32 - 1), nb = id >> 7, n = 64 * nb + lane;        const int f0 = n < DFF ? n : n - DFF; const int rowdst = 256 * (f0 >> 7) + (n < DFF ? 0 : 128) + (f0 & 127);
        b.src = w1src + (size_t)D * DFF2 + (size_t)(32 * kb) * DFF2 + n; b.dst = (bf16*)(ws + WS_W1) + (size_t)NFF1 * D + (size_t)rowdst * D + 32 * kb; b.lds = (unsigned)DFF2; }
    else { const int id2 = id - CV_W1, kb = id2 >> 6, nb = id2 & 63, n = 64 * nb + lane;
        b.src = w2src + (size_t)DFF * D + (size_t)(32 * kb) * D + n; b.dst = (bf16*)(ws + WS_W2) + (size_t)D * KFF2 + (size_t)n * KFF2 + 32 * kb; b.lds = (unsigned)D; }
    return b;
}
__device__ __forceinline__ void cv_load(const CvBlk& b, float (&v)[32]) {
#pragma unroll
    for (int i = 0; i < 32; ++i) v[i] = __builtin_nontemporal_load(b.src + (size_t)i * b.lds);
}
__device__ __forceinline__ void cv_store(const CvBlk& b, const float (&v)[32]) {
#pragma unroll
    for (int q = 0; q < 4; ++q) { u32x4 o; o.x = cvt_pk_bf16(v[8 * q], v[8 * q + 1]); o.y = cvt_pk_bf16(v[8 * q + 2], v[8 * q + 3]); o.z = cvt_pk_bf16(v[8 * q + 4], v[8 * q + 5]); o.w = cvt_pk_bf16(v[8 * q + 6], v[8 * q + 7]);
        *(u32x4*)(b.dst + 8 * q) = o; }
}

__device__ __forceinline__ void tr_item(const float* W, size_t ldw, int k0, int n0, bf16* WT, size_t ldt, int rowdst, LAS float* scr, int lane) {
#pragma unroll 8
    for (int i = 0; i < 32; ++i) { const int kk = 2 * i + (lane >> 5); scr[kk * 33 + (lane & 31)] = __builtin_nontemporal_load(W + (size_t)(k0 + kk) * ldw + n0 + (lane & 31)); }
    LDS_WAIT(); asm volatile("" ::: "memory");
    const int c = lane & 7;
#pragma unroll
    for (int j = 0; j < 4; ++j) { const int n = (lane >> 3) + 8 * j; const LAS float* s = scr + (8 * c) * 33 + n;
        u32x4 o; o.x = pk2(s[0 * 33], s[1 * 33]); o.y = pk2(s[2 * 33], s[3 * 33]); o.z = pk2(s[4 * 33], s[5 * 33]); o.w = pk2(s[6 * 33], s[7 * 33]);
        *(u32x4*)(WT + (size_t)(rowdst + n) * ldt + k0 + 8 * c) = o; }
    LDS_WAIT(); asm volatile("" ::: "memory");
}
__device__ __forceinline__ void rms_row_to_bf16(const float* xrow, const float* g, bf16* orow, int lane) {
    const f32x4* xr = (const f32x4*)xrow + lane; const f32x4* gr = (const f32x4*)g + lane;
    f32x4 v[16]; float s = 0.f;
#pragma unroll
    for (int j = 0; j < 16; ++j) { v[j] = __builtin_nontemporal_load(xr + 64 * j); s += (v[j][0] * v[j][0] + v[j][1] * v[j][1]) + (v[j][2] * v[j][2] + v[j][3] * v[j][3]); }
    const float rstd = 1.0f / sqrtf(wave_sum(s) * (1.f / D) + EPS);
    u32x2* o8 = (u32x2*)orow + lane;
#pragma unroll
    for (int j = 0; j < 16; ++j) { const f32x4 gg = gr[64 * j]; u32x2 w; w.x = pk2(v[j][0] * rstd * gg[0], v[j][1] * rstd * gg[1]); w.y = pk2(v[j][2] * rstd * gg[2], v[j][3] * rstd * gg[3]); o8[64 * j] = w; }
}
__device__ __forceinline__ void p0_prologue(Frame& F, const Args& args) {
    LAS float* scr = (LAS float*)(F.lds + RING_OFF + F.wave * 16384);
    const int gw = F.vcu * NWAVES + F.wave, NGW = F.G * NWAVES;
    constexpr int I_P = 64 * 384, I_O = 64 * 128, I_1 = 64 * 684, I_2 = 171 * 128, I_G = 16 * 32;
    constexpr int NITEMS = I_P + I_O + I_1 + I_2 + 4 * I_G;
    for (int it = gw; it < NITEMS; it += NGW) {
        int r = it + I_P; if (r >= NITEMS) r -= NITEMS;
        if (r < I_P) { const int kb = r / 384, nb = r % 384; tr_item(args.in[2], PROJ_W, 64 * kb, 32 * nb, WSP(bf16, WS_WP), D, 32 * nb, scr, F.lane); continue; } r -= I_P;
        if (r < I_O) { const int kb = r / 128, nb = r % 128; tr_item(args.in[6], D, 64 * kb, 32 * nb, WSP(bf16, WS_WO), D, 32 * nb, scr, F.lane); continue; } r -= I_O;
        if (r < I_1) { const int l = 0; const int kb = r / 684, nb = r % 684; const int n0 = 32 * nb; const int f0 = n0 < DFF ? n0 : n0 - DFF;
            const int rowdst = 256 * (f0 >> 7) + (n0 < DFF ? 0 : 128) + (f0 & 127);
            tr_item(args.in[11] + (size_t)l * D * DFF2, DFF2, 64 * kb, n0, WSP(bf16, WS_W1) + (size_t)l * NFF1 * D, D, rowdst, scr, F.lane); continue; } r -= I_1;
        if (r < I_2) { const int l = 0; const int kb = r / 128, nb = r % 128;
            tr_item(args.in[14] + (size_t)l * DFF * D, D, 64 * kb, 32 * nb, WSP(bf16, WS_W2) + (size_t)l * D * KFF2, KFF2, 32 * nb, scr, F.lane); continue; } r -= I_2;
        { const int gidx = r / I_G; r -= gidx * I_G; const int kb = r / 32, nb = r % 32;
            tr_item(args.in[8] + (size_t)gidx * 1024 * 1024, 1024, 64 * kb, 32 * nb, WSP(bf16, WS_WPOOL) + (size_t)gidx * 1024 * 1024, 1024, 32 * nb, scr, F.lane); }
    }
    {
        const int scan_blocks = ((256 + F.G - 1) / F.G) * (SEQ / 64) * NGW;
        for (int id = scan_blocks + gw; id < CV_TOTAL; id += NGW) { float v[32]; const CvBlk b = cv_decode(args.in[11], args.in[14], F.ws, id, F.lane); cv_load(b, v); cv_store(b, v); }
    }
    const int gt = F.vcu * (NWAVES * 64) + F.tid, NGT = F.G * NWAVES * 64;
    for (int i = gt; i < 2 * 128 * (D / 8); i += NGT) { const int l = i / (128 * (D / 8)), rr = (i / (D / 8)) % 128, c8 = i % (D / 8); const int row = 85 * 256 + (rr < 64 ? 64 + rr : 192 + (rr - 64));
        *(u32x4*)(WSP(bf16, WS_W1) + ((size_t)l * NFF1 + row) * D + 8 * c8) = (u32x4){0u, 0u, 0u, 0u}; }
    for (int i = gt; i < 2 * D * 8; i += NGT) { const int l = i / (D * 8), row = (i / 8) % D, c8 = i % 8; *(u32x4*)(WSP(bf16, WS_W2) + ((size_t)l * D + row) * KFF2 + DFF + 8 * c8) = (u32x4){0u, 0u, 0u, 0u}; }
    for (int i = gt; i < 2 * FT * 4 * 256; i += NGT) { const int cc = i & 255, p = (i >> 8) & 3, j = (i >> 10) % FT, l = i / (FT * 1024); const int f = 128 * j + (cc & 127); const int col = cc < 128 ? f : DFF + f;
        float v = 0.f; if (f < DFF) v = p < 3 ? args.in[12][((size_t)l * 3 + p) * DFF2 + col] : args.in[13][(size_t)l * DFF2 + col];
        WSP(float, WS_CONVP)[i] = v * (cc < 128 ? -1.44269504089f : -0.69314718056f); }
    for (int i = gt; i < 16 * D; i += NGT) { const int c = i & 15, k = i >> 4; WSP(bf16, WS_WG)[(size_t)c * D + k] = (bf16)f2bf(args.in[2][(size_t)k * PROJ_W + NPROJ + c]); }
    for (int m = gw; m < M; m += NGW) rms_row_to_bf16(args.in[0] + (size_t)m * D, args.in[1], WSP(bf16, WS_XA) + (size_t)m * D, F.lane);
}

__device__ __forceinline__ float softcap15(float a) { return 15.0f * tanhf(a * (1.0f / 15.0f)); }
__device__ __forceinline__ void p1_gates(Frame& F, const Args& args) {
    const int gw = F.vcu * NWAVES + F.wave, NGW = F.G * NWAVES; const int fr = F.lane & 15, fq = F.lane >> 4;
    for (int rb = gw; rb < M / 16; rb += NGW) {
        const bf16* ap = WSP(bf16, WS_XA) + (size_t)(rb * 16 + fr) * D + 8 * fq; const bf16* bp = WSP(bf16, WS_WG) + (size_t)fr * D + 8 * fq;
        f32x4 acc = (f32x4){0.f, 0.f, 0.f, 0.f};
#pragma unroll 16
        for (int k = 0; k < D; k += 32) { const bf16x8 a = *(const bf16x8*)(ap + k); const bf16x8 b = *(const bf16x8*)(bp + k); acc = __builtin_amdgcn_mfma_f32_16x16x32_bf16(a, b, acc, 0, 0, 0); }
        const int c = fr; const float bias = c < 8 ? args.in[3][c] : args.in[4][c - 8];
#pragma unroll
        for (int r = 0; r < 4; ++r) { const float z = softcap15(acc[r] + bias); float o = z;
            if (c >= 8) o = fminf(z, 0.f) - log1pf(expf(-fabsf(z)));
            WSP(float, WS_GATES)[(size_t)(rb * 16 + 4 * fq + r) * 16 + c] = o; }
    }
}

__device__ __forceinline__ float row_sum16(float x) {
    x += __builtin_bit_cast(float, __builtin_amdgcn_update_dpp(0, __builtin_bit_cast(int, x), 0x128, 0xf, 0xf, false));
    x += __builtin_bit_cast(float, __builtin_amdgcn_update_dpp(0, __builtin_bit_cast(int, x), 0x124, 0xf, 0xf, false));
    x += __builtin_bit_cast(float, __builtin_amdgcn_update_dpp(0, __builtin_bit_cast(int, x), 0x122, 0xf, 0xf, false));
    x += __builtin_bit_cast(float, __builtin_amdgcn_update_dpp(0, __builtin_bit_cast(int, x), 0x121, 0xf, 0xf, false));
    return x;
}
__device__ __forceinline__ float wave_scan_add(float x, int lane) {
#define SC_STEP(ctrl) x += __builtin_bit_cast(float, __builtin_amdgcn_update_dpp(0, __builtin_bit_cast(int, x), ctrl, 0xf, 0xf, true))
    SC_STEP(0x111); SC_STEP(0x112); SC_STEP(0x114); SC_STEP(0x118);
#undef SC_STEP
    const float t0 = __builtin_bit_cast(float, __builtin_amdgcn_readlane(__builtin_bit_cast(int, x), 15)), t1 = __builtin_bit_cast(float, __builtin_amdgcn_readlane(__builtin_bit_cast(int, x), 31)), t2 = __builtin_bit_cast(float, __builtin_amdgcn_readlane(__builtin_bit_cast(int, x), 47));
    const int g = lane >> 4; return x + (g >= 1 ? t0 : 0.f) + (g >= 2 ? t1 : 0.f) + (g >= 3 ? t2 : 0.f);
}
__device__ __forceinline__ float wave_scan_max(float x, int lane) {
    const int ninf = (int)0xff800000u;
#define SC_STEP(ctrl) x = fmaxf(x, __builtin_bit_cast(float, __builtin_amdgcn_update_dpp(ninf, __builtin_bit_cast(int, x), ctrl, 0xf, 0xf, false)))
    SC_STEP(0x111); SC_STEP(0x112); SC_STEP(0x114); SC_STEP(0x118);
#undef SC_STEP
    const float t0 = __builtin_bit_cast(float, __builtin_amdgcn_readlane(__builtin_bit_cast(int, x), 15)), t1 = __builtin_bit_cast(float, __builtin_amdgcn_readlane(__builtin_bit_cast(int, x), 31)), t2 = __builtin_bit_cast(float, __builtin_amdgcn_readlane(__builtin_bit_cast(int, x), 47));
    const int g = lane >> 4; const float ninff = __builtin_bit_cast(float, ninf);
    return fmaxf(fmaxf(x, g >= 1 ? t0 : ninff), fmaxf(g >= 2 ? t1 : ninff, g >= 3 ? t2 : ninff));
}
typedef short v4i16_t __attribute__((ext_vector_type(4)));
__device__ __forceinline__ v4i16_t tr16(const LAS unsigned char* p) { return __builtin_amdgcn_ds_read_tr16_b64_v4i16((LAS v4i16_t*)p); }
__device__ __forceinline__ bf16x8 cat8(v4i16_t a, v4i16_t b) { return (bf16x8){a[0], a[1], a[2], a[3], b[0], b[1], b[2], b[3]}; }
constexpr int SC_QS = 0, SC_KS = 33792, SC_VS = 67584, SC_VW = 84992, SC_SS = 102400, SC_HS = 111616, SC_FA = 129024;
static_assert(SC_FA + 8192 <= LDSCTL_OFF, "scan LDS map");
__device__ __forceinline__ void p2_scan(Frame& F, const Args& args) {
    LAS unsigned char* L = F.lds;
    LAS float* fa = (LAS float*)(L + SC_FA);
    LAS float *sA = fa, *sM = fa + 64, *sWi = fa + 128, *sEi = fa + 192, *sKw = fa + 256, *sInv = fa + 320, *rsp = fa + 384  , *qnp = fa + 640  , *sn = fa + 1152  , *ssp = fa + 1408  , *scal = fa + 1920;
    const int tid0 = F.tid, w = F.wave;
    const bf16* PROJ = WSP(bf16, WS_PROJ); bf16* HB = WSP(bf16, WS_HB); float* SSg = WSP(float, WS_SS); const float* GATES = WSP(float, WS_GATES);
    const __amdgpu_buffer_rsrc_t rsP = __builtin_amdgcn_make_buffer_rsrc((void*)PROJ, 0, 0x7fffffff, 0x00020000), rsH = __builtin_amdgcn_make_buffer_rsrc((void*)HB, 0, 0x7fffffff, 0x00020000);
#define SC_LDQ(i, soff) __builtin_bit_cast(u32x4, __builtin_amdgcn_raw_buffer_load_b128(rsP, (unsigned)((((tid + 512 * (i)) >> 5) * NPROJ + ((tid + 512 * (i)) & 31) * 8) * 2), (soff), 0))
#define SC_LDV(i, soff) __builtin_bit_cast(u32x4, __builtin_amdgcn_raw_buffer_load_b128(rsP, (unsigned)((((tid + 512 * (i)) >> 4) * NPROJ + ((tid + 512 * (i)) & 15) * 8) * 2), (soff), 2))
    int cvid = F.vcu * NWAVES + F.wave;
    for (int item = F.vcu; item < 256; item += F.G) {
        const int bh = item >> 2, es = item & 3, b = bh >> 3, h = bh & 7;
        f32x4 C[16];
#pragma unroll
        for (int i = 0; i < 16; ++i) C[i] = (f32x4){0.f, 0.f, 0.f, 0.f};
        __syncthreads();
        if (tid0 < 256) sn[tid0] = 0.f;
        if (tid0 == 0) scal[0] = 0.f;
        u32x4 qv[4], kv[4], vv[2]; float ig_n, lf_n;
        { const size_t row0 = (size_t)b * SEQ; const int tid = tid0; ig_n = GATES[(row0 + (tid & 63)) * 16 + h]; lf_n = GATES[(row0 + (tid & 63)) * 16 + 8 + h];
#pragma unroll
            for (int i = 0; i < 4; ++i) { const unsigned so = (unsigned)((row0 * NPROJ + h * DQK) * 2); qv[i] = SC_LDQ(i, so); kv[i] = SC_LDQ(i, so + QKW * 2); }
#pragma unroll
            for (int i = 0; i < 2; ++i) vv[i] = SC_LDV(i, (unsigned)((row0 * NPROJ + 2 * QKW + h * DV + es * 128) * 2)); }
        for (int c = 0; c <= SEQ / 64; ++c) {
            const size_t row0 = (size_t)b * SEQ + 64 * c;
            int tid = tid0; asm volatile("" : "+v"(tid));
            const int lane = tid & 63, fr = lane & 15, fq = lane >> 4, tq = fr >> 2, tp = fr & 3;
            __syncthreads();
            if (c > 0) {
                const size_t prow0 = row0 - 64;
#pragma unroll
                for (int i = 0; i < 2; ++i) { const int p = tid + 512 * i, row = p >> 4, cc = p & 15; __builtin_amdgcn_raw_buffer_store_b128(*(const LAS u32x4*)(L + SC_HS + row * 272 + cc * 16), rsH, (unsigned)((row * D + cc * 8) * 2), (unsigned)((prow0 * D + h * DV + es * 128) * 2), 0); }
                if (tid < 64) { float q = 0.f;
#pragma unroll
                    for (int p = 0; p < 8; ++p) q += ssp[p * 64 + tid];
                    SSg[(prow0 + tid) * 32 + h * 4 + es] = q; }
                if (tid == 0) scal[0] = scal[2];
            }
            if (c == SEQ / 64) break;
#pragma unroll
            for (int i = 0; i < 4; ++i) { const int p = tid + 512 * i, row = p >> 5, cc = p & 31; *(LAS u32x4*)(L + SC_QS + row * 528 + cc * 16) = qv[i]; *(LAS u32x4*)(L + SC_KS + row * 528 + cc * 16) = kv[i]; }
#pragma unroll
            for (int i = 0; i < 2; ++i) { const int p = tid + 512 * i, row = p >> 4, cc = p & 15; *(LAS u32x4*)(L + SC_VS + row * 272 + cc * 16) = vv[i]; }
            const float ig = ig_n, lf = lf_n;
            if (c + 1 < SEQ / 64) {
                const size_t nrow0 = row0 + 64; ig_n = GATES[(nrow0 + lane) * 16 + h]; lf_n = GATES[(nrow0 + lane) * 16 + 8 + h];
#pragma unroll
                for (int i = 0; i < 4; ++i) { const unsigned so = (unsigned)((nrow0 * NPROJ + h * DQK) * 2); qv[i] = SC_LDQ(i, so); kv[i] = SC_LDQ(i, so + QKW * 2); }
#pragma unroll
                for (int i = 0; i < 2; ++i) vv[i] = SC_LDV(i, (unsigned)((nrow0 * NPROJ + 2 * QKW + h * DV + es * 128) * 2));
            }
            float cv[32]; CvBlk cvb; const bool cvon = cvid < CV_TOTAL;
            if (cvon) { cvb = cv_decode(args.in[11], args.in[14], F.ws, cvid, tid & 63); cv_load(cvb, cv); }
            cvid += F.G * NWAVES;
            LDS_WAIT(); __builtin_amdgcn_s_barrier(); asm volatile("" ::: "memory");
            if (w == 0) {
                const float bs = wave_scan_add(lf, lane);
                const float a = ig - bs; const float pm = wave_scan_max(a, lane);
                const float mprev = scal[0]; const float Mt = fmaxf(mprev, pm);
                const float M63 = __builtin_bit_cast(float, __builtin_amdgcn_readlane(__builtin_bit_cast(int, Mt), 63)), b63 = __builtin_bit_cast(float, __builtin_amdgcn_readlane(__builtin_bit_cast(int, bs), 63));
                sA[lane] = a; sM[lane] = Mt; sWi[lane] = __expf(mprev - Mt); sEi[lane] = __expf(-(bs + Mt)); sKw[lane] = __expf(a - M63);
                if (lane == 0) { scal[1] = __expf(mprev - M63); scal[2] = b63 + M63; }
            }
            { const int t = tid & 63; float s = 0.f;
#pragma unroll
                for (int j = 0; j < 4; ++j) { const int d0 = w * 32 + 8 * j; const u32x4 q = *(const LAS u32x4*)(L + SC_QS + t * 528 + d0 * 2); const LAS float* np = sn + d0;
                    s += bf2f(q.x & 0xffffu) * np[0] + bf2f(q.x >> 16) * np[1] + bf2f(q.y & 0xffffu) * np[2] + bf2f(q.y >> 16) * np[3] + bf2f(q.z & 0xffffu) * np[4] + bf2f(q.z >> 16) * np[5] + bf2f(q.w & 0xffffu) * np[6] + bf2f(q.w >> 16) * np[7]; }
                qnp[w * 64 + t] = s; }
            const int tr = w >> 1, tc0 = (w & 1) * 2; f32x4 s0 = (f32x4){0.f, 0.f, 0.f, 0.f}, s1 = s0;
#pragma unroll
            for (int kk = 0; kk < 8; ++kk) { const bf16x8 a = *(const LAS bf16x8*)(L + SC_QS + (16 * tr + fr) * 528 + (32 * kk + 8 * fq) * 2);
                const bf16x8 b0 = *(const LAS bf16x8*)(L + SC_KS + (16 * tc0 + fr) * 528 + (32 * kk + 8 * fq) * 2); const bf16x8 b1 = *(const LAS bf16x8*)(L + SC_KS + (16 * tc0 + 16 + fr) * 528 + (32 * kk + 8 * fq) * 2);
                s0 = __builtin_amdgcn_mfma_f32_16x16x32_bf16(a, b0, s0, 0, 0, 0); s1 = __builtin_amdgcn_mfma_f32_16x16x32_bf16(a, b1, s1, 0, 0, 0); }
            __syncthreads();
#pragma unroll
            for (int q = 0; q < 2; ++q) { const int tc = tc0 + q, sidx = 16 * tc + fr; const float as = sA[sidx];
#pragma unroll
                for (int r = 0; r < 4; ++r) { const int t = 16 * tr + 4 * fq + r; const float e = __expf(fminf(as - sM[t], 0.f)); const float wgt = (sidx <= t) ? e : 0.f; const float v = (q == 0 ? s0[r] : s1[r]) * wgt;
                    *(LAS unsigned short*)(L + SC_SS + (t * 72 + sidx) * 2) = (unsigned short)cvt_pk_bf16(v, v);
                    rsp[t * 4 + tc] = row_sum16(v); } }
#pragma unroll
            for (int i = 0; i < 2; ++i) { const int p = tid + 512 * i, row = p >> 4, cc = p & 15; const float kw = sKw[row]; const u32x4 v = *(const LAS u32x4*)(L + SC_VS + row * 272 + cc * 16); u32x4 o;
                o.x = cvt_pk_bf16(kw * bf2f(v.x & 0xffffu), kw * bf2f(v.x >> 16)); o.y = cvt_pk_bf16(kw * bf2f(v.y & 0xffffu), kw * bf2f(v.y >> 16));
                o.z = cvt_pk_bf16(kw * bf2f(v.z & 0xffffu), kw * bf2f(v.z >> 16)); o.w = cvt_pk_bf16(kw * bf2f(v.w & 0xffffu), kw * bf2f(v.w >> 16));
                *(LAS u32x4*)(L + SC_VW + row * 272 + cc * 16) = o; }
            __syncthreads();
            if (tid < 64) { const int t = tid; float qn = 0.f;
#pragma unroll
                for (int p = 0; p < 8; ++p) qn += qnp[p * 64 + t];
                const float den = sWi[t] * qn + ((rsp[t * 4 + 0] + rsp[t * 4 + 1]) + (rsp[t * 4 + 2] + rsp[t * 4 + 3]));
                sInv[t] = 1.0f / fmaxf(fabsf(den), sEi[t]); }
            f32x4 nacc[4];
#pragma unroll
            for (int tt = 0; tt < 4; ++tt) nacc[tt] = (f32x4){0.f, 0.f, 0.f, 0.f};
#pragma unroll
            for (int kk = 0; kk < 8; ++kk) {
                u32x4 bw; bw.x = cvt_pk_bf16(C[2 * kk][0], C[2 * kk][1]); bw.y = cvt_pk_bf16(C[2 * kk][2], C[2 * kk][3]); bw.z = cvt_pk_bf16(C[2 * kk + 1][0], C[2 * kk + 1][1]); bw.w = cvt_pk_bf16(C[2 * kk + 1][2], C[2 * kk + 1][3]);
                const bf16x8 bq = __builtin_bit_cast(bf16x8, bw);
#pragma unroll
                for (int tt = 0; tt < 4; ++tt) { const bf16x8 a = *(const LAS bf16x8*)(L + SC_QS + (16 * tt + fr) * 528 + (32 * kk + 8 * fq) * 2);
                    nacc[tt] = __builtin_amdgcn_mfma_f32_16x16x32_bf16(a, bq, nacc[tt], 0, 0, 0); }
            }
#pragma unroll
            for (int tt = 0; tt < 4; ++tt)
#pragma unroll
                for (int r = 0; r < 4; ++r) nacc[tt][r] *= sWi[16 * tt + 4 * fq + r];
#pragma unroll
            for (int kk = 0; kk < 2; ++kk) { const LAS unsigned char* vp = L + SC_VS + (32 * kk + 8 * fq + tq) * 272 + (16 * w + 4 * tp) * 2;
                const bf16x8 bv = cat8(tr16(vp), tr16(vp + 4 * 272));
#pragma unroll
                for (int tt = 0; tt < 4; ++tt) { const bf16x8 as = *(const LAS bf16x8*)(L + SC_SS + ((16 * tt + fr) * 72 + 32 * kk + 8 * fq) * 2);
                    nacc[tt] = __builtin_amdgcn_mfma_f32_16x16x32_bf16(as, bv, nacc[tt], 0, 0, 0); } }
            __syncthreads();
#pragma unroll
            for (int tt = 0; tt < 4; ++tt)
#pragma unroll
                for (int r = 0; r < 4; ++r) { const int t = 16 * tt + 4 * fq + r; const float hv = nacc[tt][r] * sInv[t];
                    *(LAS unsigned short*)(L + SC_HS + t * 272 + (16 * w + fr) * 2) = (unsigned short)cvt_pk_bf16(hv, hv);
                    ssp[w * 64 + t] = row_sum16(hv * hv); }
            const float aprev = scal[1];
#pragma unroll
            for (int i = 0; i < 16; ++i) C[i] *= aprev;
            f32x4 ninc0 = (f32x4){0.f, 0.f, 0.f, 0.f}, ninc1 = ninc0;
#pragma unroll
            for (int kk = 0; kk < 2; ++kk) { const LAS unsigned char* vp = L + SC_VW + (32 * kk + 8 * fq + tq) * 272 + (16 * w + 4 * tp) * 2;
                const bf16x8 bvw = cat8(tr16(vp), tr16(vp + 4 * 272));
                u32x4 kn; { const LAS float* kp = sKw + 32 * kk + 8 * fq; kn.x = cvt_pk_bf16(kp[0], kp[1]); kn.y = cvt_pk_bf16(kp[2], kp[3]); kn.z = cvt_pk_bf16(kp[4], kp[5]); kn.w = cvt_pk_bf16(kp[6], kp[7]); }
                const bf16x8 bn = __builtin_bit_cast(bf16x8, kn);
                const LAS unsigned char* kp0 = L + SC_KS + (32 * kk + 8 * fq + tq) * 528 + (8 * tp) * 2;
#pragma unroll
                for (int T = 0; T < 16; ++T) { const LAS unsigned char* kp = kp0 + (32 * (T >> 1) + 4 * (T & 1)) * 2;
                    const bf16x8 ak = cat8(tr16(kp), tr16(kp + 4 * 528));
                    C[T] = __builtin_amdgcn_mfma_f32_16x16x32_bf16(ak, bvw, C[T], 0, 0, 0); }
                { const LAS unsigned char* kp = kp0 + (32 * w) * 2; const bf16x8 a0 = cat8(tr16(kp), tr16(kp + 4 * 528)), a1 = cat8(tr16(kp + 8), tr16(kp + 8 + 4 * 528));
                    ninc0 = __builtin_amdgcn_mfma_f32_16x16x32_bf16(a0, bn, ninc0, 0, 0, 0); ninc1 = __builtin_amdgcn_mfma_f32_16x16x32_bf16(a1, bn, ninc1, 0, 0, 0); } }
            {
#pragma unroll
                for (int r = 0; r < 4; ++r) { const int d0 = 32 * w + 8 * fq + r; const float n0 = aprev * sn[d0] + ninc0[r], n1 = aprev * sn[d0 + 4] + ninc1[r]; sn[d0] = n0; sn[d0 + 4] = n1; } }
            if (cvon) cv_store(cvb, cv);
        }
    }
    __syncthreads();
#undef SC_LDQ
#undef SC_LDV
}

__device__ __forceinline__ void p3_headnorm(Frame& F, const Args& args) {
    const int gw = F.vcu * NWAVES + F.wave, NGW = F.G * NWAVES;
    for (int m = gw; m < M; m += NGW) {
        u32x4 hva[8], ova[8];
#pragma unroll
        for (int j = 0; j < 8; ++j) { const int col = 512 * j + 8 * F.lane; hva[j] = __builtin_nontemporal_load((const u32x4*)(WSP(bf16, WS_HB) + (size_t)m * D + col)); ova[j] = __builtin_nontemporal_load((const u32x4*)(WSP(bf16, WS_PROJ) + (size_t)m * NPROJ + 2 * QKW + VW + col)); }
#pragma unroll
        for (int j = 0; j < 8; ++j) {
            const f32x4 s4 = *(const f32x4*)(WSP(float, WS_SS) + (size_t)m * 32 + 4 * j); const float r = 1.0f / sqrtf(((s4[0] + s4[1]) + (s4[2] + s4[3])) * (1.f / DV) + EPS);
            const int col = 512 * j + 8 * F.lane;
            const u32x4 hv = hva[j]; const u32x4 ov = ova[j];
            const f32x4 g0 = *(const f32x4*)(args.in[5] + col), g1 = *(const f32x4*)(args.in[5] + col + 4);
            const unsigned hw[4] = {hv.x, hv.y, hv.z, hv.w}, ow[4] = {ov.x, ov.y, ov.z, ov.w}; const float gg[8] = {g0[0], g0[1], g0[2], g0[3], g1[0], g1[1], g1[2], g1[3]}; unsigned res[4];
#pragma unroll
            for (int q = 0; q < 4; ++q) { const float h0 = bf2f(hw[q] & 0xffffu), h1 = bf2f(hw[q] >> 16), o0 = bf2f(ow[q] & 0xffffu), o1 = bf2f(ow[q] >> 16);
                const float y0 = h0 * r * gg[2 * q] / (1.0f + __expf(-o0)), y1 = h1 * r * gg[2 * q + 1] / (1.0f + __expf(-o1)); res[q] = pk2(y0, y1); }
            *(u32x4*)(WSP(bf16, WS_XB) + (size_t)m * D + col) = (u32x4){res[0], res[1], res[2], res[3]};
        }
    }
}

__device__ __forceinline__ void rstd_to_lds(Frame& F, int pm) {
    __syncthreads();
    if (F.tid < 256) { const f32x4* p = (const f32x4*)(WSP(float, WS_RSS) + (size_t)(pm * 256 + F.tid) * 64); float s = 0.f;
#pragma unroll
        for (int j = 0; j < 16; ++j) { const f32x4 v = p[j]; s += (v[0] + v[1]) + (v[2] + v[3]); }
        ((LAS float*)(F.lds + RSTD_OFF))[F.tid] = 1.0f / sqrtf(s * (1.f / D) + EPS); }
    VM_WAIT(); LDS_WAIT();
    __syncthreads();
}

__device__ __forceinline__ void p6_fixup(Frame& F, int layer, bf16* __restrict__ GATED) {
    const int gt = F.vcu * (NWAVES * 64) + F.tid, NGT = F.G * NWAVES * 64;
    const float* __restrict__ cpl = WSP(float, WS_CONVP) + (size_t)layer * FT * 1024; const float* __restrict__ HALO = WSP(float, WS_HALO);
    for (int i = gt; i < 64 * FT * 128; i += NGT) { const int ci = i & 127, pn = (i >> 7) % FT, pm = i / (FT * 128); if ((pm & 7) == 0) continue;
        float hc[2][2];
#pragma unroll
        for (int bj = 0; bj < 2; ++bj) { const int col = 256 * pn + 128 * bj + ci; const float* cp = cpl + (size_t)pn * 1024 + 128 * bj + ci;
            const float w0 = cp[0], w1 = cp[256], w2 = cp[512], cb = cp[768];
            const float hm2 = HALO[((size_t)(pm - 1) * 4 + 2) * NFF1 + col], hm1 = HALO[((size_t)(pm - 1) * 4 + 3) * NFF1 + col], h0 = HALO[((size_t)pm * 4 + 0) * NFF1 + col], h1 = HALO[((size_t)pm * 4 + 1) * NFF1 + col];
            hc[bj][0] = cb + w0 * hm2 + w1 * hm1 + w2 * h0; hc[bj][1] = cb + w0 * hm1 + w1 * h0 + w2 * h1; }
#pragma unroll
        for (int rr = 0; rr < 2; ++rr) GATED[(size_t)(pm * 256 + rr) * KFF2 + 128 * pn + ci] = (bf16)f2bf(hc[0][rr] * hc[1][rr] * __builtin_amdgcn_rcpf(1.0f + __builtin_amdgcn_exp2f(hc[0][rr])));
    }
}

__device__ __forceinline__ f32x2 ld_bf2(const bf16* p) { const unsigned w = *(const unsigned*)p; return (f32x2){bf2f(w & 0xffffu), bf2f(w >> 16)}; }
template <int W> __device__ __forceinline__ void pool_cols(const bf16* xb, const LAS float* rs, const f32x2 g, bf16* ob, int tb) {
    f32x2 prev[16], cur[16]; unsigned raw[16];
#pragma unroll
    for (int i = 0; i < 16; ++i) { if (tb == 0) prev[i] = (f32x2){0.f, 0.f}; else prev[i] = ld_bf2(xb + (size_t)i * D) * rs[i] * g; }
#pragma unroll
    for (int i = 0; i < 16; ++i) raw[i] = *(const unsigned*)(xb + (size_t)(16 + i) * D);
#pragma unroll 1
    for (int blk = 0; blk < 4; ++blk) {
#pragma unroll
        for (int i = 0; i < 16; ++i) cur[i] = (f32x2){bf2f(raw[i] & 0xffffu), bf2f(raw[i] >> 16)} * rs[16 + 16 * blk + i] * g;
        if (blk < 3) {
#pragma unroll
            for (int i = 0; i < 16; ++i) raw[i] = *(const unsigned*)(xb + (size_t)(32 + 16 * blk + i) * D); }
#pragma unroll
        for (int i = 0; i < 16; ++i) { f32x2 s = cur[i];
#pragma unroll
            for (int j = 1; j < W; ++j) s += (i - j >= 0) ? cur[(i - j) & 15] : prev[(16 + i - j) & 15];
            const int t = 64 * tb + 16 * blk + i; const float inv = 1.0f / (float)((t + 1) < W ? (t + 1) : W);
            const f32x2 o = s * inv - cur[i];
            *(unsigned*)(ob + (size_t)(16 * blk + i) * D) = pk2(o[0], o[1]); }
#pragma unroll
        for (int i = 0; i < 16; ++i) prev[i] = cur[i];
    }
}
__device__ __forceinline__ void p8_pool(Frame& F, const Args& args) {
    LAS float* rs = (LAS float*)(F.lds);
    for (int item = F.vcu; item < 256; item += F.G) {
        const int b = item >> 5, tb = item & 31; const size_t r0 = (size_t)b * SEQ + 64 * tb;
        __syncthreads();
        if (F.tid < 80) { float v = 0.f; if (tb > 0 || F.tid >= 16) { const f32x4* p = (const f32x4*)(WSP(float, WS_RSS) + (r0 - 16 + F.tid) * 64); float s = 0.f;
#pragma unroll
                for (int j = 0; j < 16; ++j) { const f32x4 q = p[j]; s += (q[0] + q[1]) + (q[2] + q[3]); }
                v = 1.0f / sqrtf(s * (1.f / D) + EPS); }
            rs[F.tid] = v; }
        __syncthreads();
#pragma unroll 1
        for (int part = 0; part < 4; ++part) { const int q = F.tid + 512 * part, col = 2 * q, grp = part;
            const f32x2 g = *(const f32x2*)(args.in[7] + col); const bf16* xb = WSP(bf16, WS_XA) + (r0 - 16) * D + col; bf16* ob = WSP(bf16, WS_XB) + r0 * D + col;
            if (grp == 0) pool_cols<2>(xb, rs, g, ob, tb); else if (grp == 1) pool_cols<4>(xb, rs, g, ob, tb); else if (grp == 2) pool_cols<8>(xb, rs, g, ob, tb); else pool_cols<16>(xb, rs, g, ob, tb); }
    }
    __syncthreads();
}

__device__ __forceinline__ void p13_final(Frame& F, const Args& args) {
    const int gw = F.vcu * NWAVES + F.wave, NGW = F.G * NWAVES;
    for (int m = gw; m < M; m += NGW) {
        const float rstd = 1.0f / sqrtf(wave_sum(WSP(float, WS_RSS)[(size_t)m * 64 + F.lane]) * (1.f / D) + EPS);
        const u32x4* xr = (const u32x4*)(WSP(bf16, WS_XA) + (size_t)m * D) + F.lane; f32x4* orow = (f32x4*)(F.out + (size_t)m * D) + 2 * F.lane; const f32x4* gr = (const f32x4*)args.in[15] + 2 * F.lane;
        u32x4 xw[8];
#pragma unroll
        for (int j = 0; j < 8; ++j) xw[j] = __builtin_nontemporal_load(xr + 64 * j);
#pragma unroll
        for (int j = 0; j < 8; ++j) { const u32x4 w = xw[j]; const f32x4 g0 = gr[128 * j], g1 = gr[128 * j + 1];
            __builtin_nontemporal_store((f32x4){bf2f(w.x & 0xffffu), bf2f(w.x >> 16), bf2f(w.y & 0xffffu), bf2f(w.y >> 16)} * rstd * g0, orow + 128 * j);
            __builtin_nontemporal_store((f32x4){bf2f(w.z & 0xffffu), bf2f(w.z >> 16), bf2f(w.w & 0xffffu), bf2f(w.w >> 16)} * rstd * g1, orow + 128 * j + 1); }
    }
}

__global__ void __launch_bounds__(NWAVES * 64, 2) fwd(Args args) {
    extern __shared__ __attribute__((aligned(16))) unsigned char lds[];
    Frame F;
    F.lds = (LAS unsigned char*)lds;
    F.tid = threadIdx.x; F.lane = F.tid & 63; F.wave = __builtin_amdgcn_readfirstlane(F.tid >> 6);
    F.G = gridDim.x; { const int bx = blockIdx.x; F.vcu = (F.G % 8 == 0) ? (bx % 8) * (F.G / 8) + bx / 8 : bx; }
    unsigned char* ws = args.ws; F.ws = ws; F.out = args.out;
    gu32* ctl = (gu32*)(ws + WS_CTL);
    for (int u = F.tid; u < (LDS_BYTES - LDSCTL_OFF) / 4; u += NWAVES * 64) ((LAS unsigned*)(F.lds + LDSCTL_OFF))[u] = 0u;
    __syncthreads();
    XcdBarrier bar; bar.bar = (unsigned*)(ctl + CW_BAR); bar.x = 0; bar.st = nullptr;
    if (MK_N_LAUNCHES == 1) bar = xcd_barrier_post((unsigned*)(ctl + CW_BAR), (volatile LAS unsigned*)(F.lds + MISC_OFF));
#define GRID_BAR() do { if (MK_N_LAUNCHES == 1) xcd_barrier(bar); } while (0)
    const int lo = args.ph_lo, hi = args.ph_hi;
#ifndef PHASE_MASK
#define PHASE_MASK 0x3fff
#endif
#define IN(k) ((((PHASE_MASK) >> (k)) & 1) && lo <= (k) && (k) < hi)
#define BOTH(k) (IN(k) && IN((k) + 1))
    bf16* GATED = WSP(bf16, WS_PROJ);
    const int c = (int)blockIdx.x;

    if (IN(0)) { p0_prologue(F, args); if (BOTH(0)) GRID_BAR(); }
    if (IN(1)) {
        pg8::Gemm g{WSP(bf16, WS_XA), WSP(bf16, WS_WP), D, D, D, 0, 0}; pg8::RowOrder S; S.init(NPROJ / 256, c);
        pg8::EpiProj E{WSP(bf16, WS_PROJ), NPROJ};
        pg8::gemm_phase(F.lds + RING_OFF, g, S, E);
        p1_gates(F, args);
        if (BOTH(1)) GRID_BAR();
    }
    if (IN(2)) { p2_scan(F, args); if (BOTH(2)) GRID_BAR(); }
    if (IN(3)) { p3_headnorm(F, args); if (BOTH(3)) GRID_BAR(); }
    if (IN(4)) {
        pg8::Gemm g{WSP(bf16, WS_XB), WSP(bf16, WS_WO), D, D, D, 0, 0}; pg8::RowOrder S; S.init(D / 256, c);
        pg8::EpiResid<true> E{args.in[0], nullptr, nullptr, WSP(bf16, WS_XA), args.in[10], WSP(float, WS_RSS)};
        pg8::gemm_phase(F.lds + RING_OFF, g, S, E);
        if (BOTH(4)) GRID_BAR();
    }
    if (IN(5)) {
        pg8::Gemm g{WSP(bf16, WS_XA), WSP(bf16, WS_W1), D, D, D, 0, 0}; pg8::RowOrder S; S.init(FT - 2, c);
        rstd_to_lds(F, S.pm);
        float* part = WSP(float, WS_PART) + (size_t)(c & 127) * 65536; unsigned* sflag = (unsigned*)(ctl + CW_SPLIT + 64 * (c & 127));
        { pg8::EpiFfn1T<0> E{GATED, WSP(float, WS_CONVP), WSP(float, WS_HALO), F.lds, part, sflag, 1u};
          pg8::gemm_phase(F.lds + RING_OFF, g, S, E); }
        pg8::TailOrder T; T.init(c);
        if (T.pn0 < 2) { pg8::EpiFfn1T<1> E{GATED, WSP(float, WS_CONVP), WSP(float, WS_HALO), F.lds, part, sflag, 1u}; pg8::gemm_phase(F.lds + RING_OFF, g, T, E); }
        else { pg8::EpiFfn1T<2> E{GATED, WSP(float, WS_CONVP), WSP(float, WS_HALO), F.lds, part, sflag, 1u}; pg8::gemm_phase(F.lds + RING_OFF, g, T, E); }
        if (BOTH(5)) GRID_BAR();
    }
    if (IN(6)) { p6_fixup(F, 0, GATED); if (BOTH(6)) GRID_BAR(); }
    if (IN(7)) {
        pg8::Gemm g{GATED, WSP(bf16, WS_W2), KFF2, KFF2, KFF2, 0, 0}; pg8::WideOrder S; S.init(D / 256, c);
        pg8::EpiResid<false> E{WSP(bf16, WS_XA), args.in[10], nullptr, WSP(bf16, WS_XA), nullptr, WSP(float, WS_RSS)};
        pg8::gemm_phase(F.lds + RING_OFF, g, S, E);
        if (BOTH(7)) GRID_BAR();
    }
    if (IN(8)) { p8_pool(F, args); if (BOTH(8)) GRID_BAR(); }
    if (IN(9)) {
        pg8::Gemm g{WSP(bf16, WS_XB), WSP(bf16, WS_WPOOL), D, 1024, 1024, 2, 1024}; pg8::RowOrder S; S.init(D / 256, c);
        pg8::EpiResid<false> E{WSP(bf16, WS_XA), nullptr, args.in[9], WSP(bf16, WS_XA), args.in[10] + D, WSP(float, WS_RSS)};
        pg8::gemm_phase(F.lds + RING_OFF, g, S, E);
        if (BOTH(9)) GRID_BAR();
    }
    if (IN(10)) {
        pg8::Gemm g{WSP(bf16, WS_XA), WSP(bf16, WS_W1) + (size_t)NFF1 * D, D, D, D, 0, 0}; pg8::RowOrder S; S.init(FT - 2, c);
        rstd_to_lds(F, S.pm);
        float* part = WSP(float, WS_PART) + (size_t)(c & 127) * 65536; unsigned* sflag = (unsigned*)(ctl + CW_SPLIT + 64 * (c & 127));
        { pg8::EpiFfn1T<0> E{GATED, WSP(float, WS_CONVP) + (size_t)FT * 1024, WSP(float, WS_HALO), F.lds, part, sflag, 2u};
          pg8::gemm_phase(F.lds + RING_OFF, g, S, E); }
        pg8::TailOrder T; T.init(c);
        if (T.pn0 < 2) { pg8::EpiFfn1T<1> E{GATED, WSP(float, WS_CONVP) + (size_t)FT * 1024, WSP(float, WS_HALO), F.lds, part, sflag, 2u}; pg8::gemm_phase(F.lds + RING_OFF, g, T, E); }
        else { pg8::EpiFfn1T<2> E{GATED, WSP(float, WS_CONVP) + (size_t)FT * 1024, WSP(float, WS_HALO), F.lds, part, sflag, 2u}; pg8::gemm_phase(F.lds + RING_OFF, g, T, E); }
        if (BOTH(10)) GRID_BAR();
    }
    if (IN(11)) { p6_fixup(F, 1, GATED); if (BOTH(11)) GRID_BAR(); }
    if (IN(12)) {
        pg8::Gemm g{GATED, WSP(bf16, WS_W2) + (size_t)D * KFF2, KFF2, KFF2, KFF2, 0, 0}; pg8::WideOrder S; S.init(D / 256, c);
        pg8::EpiResid<false> E{WSP(bf16, WS_XA), args.in[10] + D, nullptr, WSP(bf16, WS_XA), nullptr, WSP(float, WS_RSS)};
        pg8::gemm_phase(F.lds + RING_OFF, g, S, E);
        if (BOTH(12)) GRID_BAR();
    }
    if (IN(13)) { p13_final(F, args); }
#undef IN
#undef BOTH
}

extern "C" void kernel_launch(void* const* d_in, const int* in_sizes, int n_in, void* d_out, int out_size, void* d_ws, size_t ws_size, hipStream_t stream) {
    static int grid = 0;
    if (grid == 0) {
        if (n_in != 16 || out_size != M * D || ws_size < WS_END2) { fprintf(stderr, "kernel_launch: unexpected shapes (n_in %d, out %d, ws %zu, need %zu)\n", n_in, out_size, ws_size, (size_t)WS_END2); grid = -1; return; }
        if (hipFuncSetAttribute((const void*)fwd, hipFuncAttributeMaxDynamicSharedMemorySize, LDS_BYTES) != hipSuccess) { fprintf(stderr, "kernel_launch: hipFuncSetAttribute failed\n"); grid = -1; return; }
        int per_cu = 0;
        if (hipOccupancyMaxActiveBlocksPerMultiprocessor(&per_cu, (const void*)fwd, NWAVES * 64, LDS_BYTES) != hipSuccess || per_cu < 1) fprintf(stderr, "kernel_launch: occupancy query reports %d\n", per_cu);
        (void)hipGetLastError();
        grid = 256;
    }
    if (grid < 0) return;
    (void)hipMemsetAsync((char*)d_ws + WS_CTL, 0, CTL_ZERO_BYTES, stream);
    Args a{};
    for (int i = 0; i < 16; ++i) a.in[i] = (const float*)d_in[i];
    a.out = (float*)d_out; a.ws = (unsigned char*)d_ws;
    if (MK_N_LAUNCHES == 1) { a.ph_lo = 0; a.ph_hi = NPHASE; a.li = 0; hipLaunchKernelGGL(fwd, dim3(grid), dim3(NWAVES * 64), LDS_BYTES, stream, a); }
    else for (int p = 0; p < NPHASE; ++p) { a.ph_lo = p; a.ph_hi = p + 1; a.li = p; hipLaunchKernelGGL(fwd, dim3(grid), dim3(NWAVES * 64), LDS_BYTES, stream, a); }
}
```

```cpp
#include <hip/hip_runtime.h>
#include <cstdio>
#include <cstdint>

#ifndef MK_N_LAUNCHES
#define MK_N_LAUNCHES 1
#endif

#define GAS __attribute__((address_space(1)))
#define LAS __attribute__((address_space(3)))
typedef unsigned short bf16;
typedef short bf16x8 __attribute__((ext_vector_type(8)));
typedef short bf16x4 __attribute__((ext_vector_type(4)));
typedef float f32x4 __attribute__((ext_vector_type(4)));
typedef float f32x2 __attribute__((ext_vector_type(2)));
typedef unsigned u32x4 __attribute__((ext_vector_type(4)));
typedef unsigned u32x2 __attribute__((ext_vector_type(2)));
typedef GAS unsigned gu32;

constexpr int D = 4096, BATCH = 8, SEQ = 2048, M = BATCH * SEQ;
constexpr int NH = 8, DQK = 256, DV = 512, QKW = 2048, VW = 4096;
constexpr int NPROJ = 12288, PROJ_W = 12304;
constexpr int DFF = 10944, DFF2 = 21888, FT = 86, NFF1 = FT * 256  , KFF2 = FT * 128  ;
constexpr float EPS = 1e-6f;
constexpr int NPHASE = 14;

constexpr size_t MiB = 1u << 20;
constexpr size_t WS_CTL = 0, CTL_ZERO_BYTES = 131072;
constexpr size_t WS_WP = 2 * MiB;
constexpr size_t WS_WG = WS_WP + (size_t)NPROJ * D * 2;
constexpr size_t WS_WO = WS_WG + 1 * MiB;
constexpr size_t WS_W1 = WS_WO + (size_t)D * D * 2;
constexpr size_t WS_W2 = WS_W1 + 2 * (size_t)NFF1 * D * 2;
constexpr size_t WS_WPOOL = WS_W2 + 2 * (size_t)D * KFF2 * 2;
constexpr size_t WS_CONVP = WS_WPOOL + 4 * (size_t)1024 * 1024 * 2;
constexpr size_t WS_XA = WS_CONVP + 1 * MiB;
constexpr size_t WS_XB = WS_XA + (size_t)M * D * 2;
constexpr size_t WS_PROJ = WS_XB + (size_t)M * D * 2;
constexpr size_t WS_HB = WS_PROJ + (size_t)M * NPROJ * 2;
constexpr size_t WS_SS = WS_HB + (size_t)M * D * 2;
constexpr size_t WS_GATES = WS_SS + (size_t)M * 32 * 4;
constexpr size_t WS_RSS = WS_GATES + (size_t)M * 16 * 4;
constexpr size_t WS_HALO = WS_RSS + (size_t)M * 64 * 4;
constexpr size_t WS_END = WS_HALO + (size_t)64 * 4 * NFF1 * 4;
constexpr size_t WS_PART = WS_END, WS_END2 = WS_PART + (size_t)128 * 65536 * 4;
static_assert((size_t)M * KFF2 * 2 <= (size_t)M * NPROJ * 2, "GATED overlays PROJ");

constexpr int CW_TMO = 0, CW_BAR = 4096, CW_SPLIT = 8192;
static_assert((CW_BAR + 3456) <= CW_SPLIT && (CW_SPLIT + 64 * 128) * 4 <= (int)CTL_ZERO_BYTES, "control words inside the memset region");

constexpr int RING_OFF = 0, RING_BYTES = 131072;
constexpr int RSTD_OFF = 131072;
constexpr int CONVP_OFF = RSTD_OFF + 1024;
constexpr int EXCH_OFF = CONVP_OFF + 8192;
constexpr int LDSCTL_OFF = EXCH_OFF + 8192;
constexpr int MISC_OFF = LDSCTL_OFF + 64;
constexpr int LDS_BYTES = LDSCTL_OFF + 512;
static_assert(LDS_BYTES <= 160 * 1024, "LDS");

#define RLX_AGENT __ATOMIC_RELAXED, __HIP_MEMORY_SCOPE_AGENT
#define LDS_WAIT() asm volatile("s_waitcnt lgkmcnt(0)" ::: "memory")
#define VM_WAIT() asm volatile("s_waitcnt vmcnt(0)" ::: "memory")
__device__ __forceinline__ unsigned f2bf(float f) { unsigned u = __builtin_bit_cast(unsigned, f); return (u + 0x7fffu + ((u >> 16) & 1u)) >> 16; }
__device__ __forceinline__ unsigned pk2(float lo, float hi) { unsigned r; asm("v_cvt_pk_bf16_f32 %0, %1, %2" : "=v"(r) : "v"(lo), "v"(hi)); return r; }
__device__ __forceinline__ float bf2f(unsigned b) { return __builtin_bit_cast(float, b << 16); }
__device__ __forceinline__ unsigned cvt_pk_bf16(float lo, float hi) { unsigned r; asm volatile("v_cvt_pk_bf16_f32 %0, %1, %2" : "=v"(r) : "v"(lo), "v"(hi)); return r; }

#ifndef PG8_BAL
#define PG8_BAL 1
#endif
#ifndef PG8_LOADPRIO
#define PG8_LOADPRIO 3
#endif
namespace pg8 {
constexpr int BM = 256, BK = 64, HALF = 128, HTB = HALF * BK * 2, STAGE_BYTES = 8 * HTB;
__host__ __device__ __forceinline__ int lds_byte(int r, int c) { const int st = (r >> 4) * 2 + (c >> 5), rr = r & 15, cc = c & 31, ob = rr * 64 + cc * 2; return st * 1024 + (ob ^ (((ob >> 9) & 1) << 5)); }
__host__ __device__ __forceinline__ void stage_rc(int b, int& R, int& C) { const int st = b / 1024, sb = b % 1024, swz = sb ^ (((sb >> 9) & 1) << 5); R = (st >> 1) * 16 + swz / 64; C = (st & 1) * 32 + (swz % 64) / 2; }
__host__ __device__ __forceinline__ int perm32(int rho) { const int n = rho >> 4, i = rho & 15; return 8 * (i >> 2) + 4 * n + (i & 3); }

struct Unit { int pm, pn; int kt0, nkt; };
struct Gemm { const bf16* A; const bf16* Bt; int lda, ldb, K; int agrp_shift, agrp_stride; };

struct RowOrder {
    static constexpr bool SPLIT = false;
    int pm, pn0, nN;
    __device__ __forceinline__ void init(int nN_, int c) { const int x = c & 7, j = c >> 3; pm = 8 * x + (j & 7); pn0 = j >> 3; nN = nN_; }
    __device__ __forceinline__ bool next(int i, Unit& u) const { const int pn = 4 * i + pn0; u.pm = pm; u.pn = pn; return pn < nN; }
};

struct WideOrder {
    static constexpr bool SPLIT = false;
    int x, j;
    __device__ __forceinline__ void init(int, int c) { x = c & 7; j = c >> 3; }
    __device__ __forceinline__ bool next(int i, Unit& u) const { u.pm = 8 * x + 4 * (i >> 1) + (j & 3); u.pn = 8 * (i & 1) + (j >> 2); return i < 4; }
};
struct TailOrder {
    static constexpr bool SPLIT = true;
    int pm, pn0;
    __device__ __forceinline__ void init(int c) { const int x = c & 7, j = c >> 3; pm = 8 * x + (j & 7); pn0 = j >> 3; }
    __device__ __forceinline__ bool next(int i, Unit& u) const { u.pm = pm; u.pn = 84 + (pn0 & 1); u.kt0 = pn0 < 2 ? 0 : 32; u.nkt = 32; return i == 0; }
};
template <class Epi, class Sched, int PV = 0>
__device__ __forceinline__ void gemm_phase(LAS unsigned char* lds, const Gemm g, const Sched& S, Epi& E) {
    const int tid = threadIdx.x, wid = __builtin_amdgcn_readfirstlane(tid >> 6), lane = tid & 63, wr = wid >> 2, wc = wid & 3, fr = lane & 15, fq = lane >> 4;
    int nt = g.K / BK;
    const unsigned kstep = (unsigned)(BK * 2);
    const unsigned hstepA = (unsigned)HALF * g.lda * 2, hstepB = (unsigned)HALF * g.ldb * 2;
    unsigned voffA0[2], voffB0[2];
#pragma unroll
    for (int i = 0; i < 2; ++i) { int R, C; stage_rc(tid * 16 + i * 8192, R, C); const int Rb = Epi::PERM ? ((R & ~31) + perm32(R & 31)) : R;
        const int Ra = Epi::APERM ? ((R & 64) + 4 * (R & 15) + ((R >> 4) & 3)) : R;
        voffA0[i] = (unsigned)(Ra * g.lda + C) * 2u; voffB0[i] = (unsigned)(Rb * g.ldb + C) * 2u; }
    const __amdgpu_buffer_rsrc_t rsA = __builtin_amdgcn_make_buffer_rsrc((void*)g.A, 0, 0x7fffffff, 0x00020000), rsB = __builtin_amdgcn_make_buffer_rsrc((void*)g.Bt, 0, 0x7fffffff, 0x00020000);
    const unsigned ldsw = (unsigned)wid * 1024u;
    const int aoff = lds_byte(wr * 64 + fr, fq * 8), boff = lds_byte(wc * 32 + fr, fq * 8);
#define PG8_SA(b, h) (((b) * 2 + (h)) * HTB)
#define PG8_SB(b, h) ((4 + (b) * 2 + (h)) * HTB)
#define PG8_STAGE(rs, bufoff, off, voff) do { _Pragma("unroll") for (int _i = 0; _i < 2; ++_i) \
        __builtin_amdgcn_raw_ptr_buffer_load_lds(rs, (LAS void*)(lds + (bufoff) + ldsw + _i * 8192), 16, (voff)[_i], (unsigned)(off), 0, 0); } while (0)
#define PG8_LDA(dst, b, h) do { _Pragma("unroll") for (int m = 0; m < 4; ++m) _Pragma("unroll") for (int k = 0; k < 2; ++k) dst[m][k] = *(const LAS bf16x8*)(lds + PG8_SA(b, h) + aoff + m * 2048 + k * 1024); } while (0)
#define PG8_LDB(dst, b, h) do { _Pragma("unroll") for (int n = 0; n < 2; ++n) _Pragma("unroll") for (int k = 0; k < 2; ++k) dst[n][k] = *(const LAS bf16x8*)(lds + PG8_SB(b, h) + boff + n * 2048 + k * 1024); } while (0)
#define PG8_MMA2(ai, B0) do { __builtin_amdgcn_s_setprio(1); \
          \
        _Pragma("unroll") for (int m = 0; m < 4; ++m) { \
            _Pragma("unroll") for (int n = 0; n < 2; ++n) { \
                _Pragma("unroll") for (int k = 0; k < 2; ++k) acc[ai][0][m][n] = __builtin_amdgcn_mfma_f32_16x16x32_bf16(B0[n][k], At[m][k], acc[ai][0][m][n], 0, 0, 0); \
                __builtin_amdgcn_sched_barrier(0); } \
            _Pragma("unroll") for (int n = 0; n < 2; ++n) { \
                _Pragma("unroll") for (int k = 0; k < 2; ++k) acc[ai][1][m][n] = __builtin_amdgcn_mfma_f32_16x16x32_bf16(B1[n][k], At[m][k], acc[ai][1][m][n], 0, 0, 0); \
                __builtin_amdgcn_sched_barrier(0); } } \
        __builtin_amdgcn_s_setprio(PG8_LOADPRIO); } while (0)
#define PG8_WAIT_V(n) asm volatile("s_waitcnt vmcnt(" #n ")" ::: "memory")
#define PG8_WAIT_VL(n) __builtin_amdgcn_s_waitcnt(0x0070 | (n))
#define PG8_BAR __builtin_amdgcn_s_barrier()
#define PG8_SCHED __builtin_amdgcn_sched_barrier(0)
#define PG8_ITER(oA1, oA2, oB2, oB3, lastrd) do { \
            PG8_LDB(B1, 0, 1); PG8_SCHED; PG8_LDA(At, 0, 0); PG8_STAGE(rsA, PG8_SA(1, 0), oA1, voffA0); PG8_STAGE(rsA, PG8_SA(1, 1), (oA1) + hstepA, voffA0); \
            PG8_WAIT_VL(6); PG8_BAR; PG8_MMA2(0, B0e); PG8_BAR; PG8_SCHED; \
            PG8_LDA(At, 0, 1); PG8_LDB(B0o, 1, 0); PG8_STAGE(rsB, PG8_SB(0, 0), oB2, voffB0); PG8_STAGE(rsB, PG8_SB(0, 1), (oB2) + hstepB, voffB0); \
            PG8_WAIT_VL(6); PG8_BAR; PG8_MMA2(1, B0e); PG8_BAR; PG8_SCHED; \
            PG8_LDB(B1, 1, 1); PG8_SCHED; PG8_LDA(At, 1, 0); PG8_STAGE(rsA, PG8_SA(0, 0), oA2, voffA0); PG8_STAGE(rsA, PG8_SA(0, 1), (oA2) + hstepA, voffA0); \
            PG8_WAIT_VL(6); PG8_BAR; PG8_MMA2(0, B0o); PG8_BAR; PG8_SCHED; \
            PG8_LDA(At, 1, 1); if (lastrd) { PG8_LDB(B0e, 0, 0); } PG8_STAGE(rsB, PG8_SB(1, 0), oB3, voffB0); PG8_STAGE(rsB, PG8_SB(1, 1), (oB3) + hstepB, voffB0); \
            PG8_WAIT_VL(6); PG8_BAR; PG8_MMA2(1, B0o); PG8_BAR; PG8_SCHED; } while (0)
    Unit cur, nxt; int ui = 0;
    if (!S.next(0, cur)) return;
    f32x4 acc[2][2][4][2];
#pragma unroll
    for (int a = 0; a < 2; ++a)
#pragma unroll
        for (int b = 0; b < 2; ++b)
#pragma unroll
            for (int m = 0; m < 4; ++m)
#pragma unroll
                for (int n = 0; n < 2; ++n) acc[a][b][m][n] = (f32x4){0.f, 0.f, 0.f, 0.f};
    bf16x8 At[4][2], B0e[2][2], B0o[2][2], B1[2][2];
    unsigned cA = (unsigned)cur.pm * 2 * hstepA + (unsigned)((cur.pn >> g.agrp_shift) * g.agrp_stride) * 2; unsigned cB = (unsigned)cur.pn * 2 * hstepB;
    if constexpr (Sched::SPLIT) { nt = cur.nkt; cA += (unsigned)cur.kt0 * kstep; cB += (unsigned)cur.kt0 * kstep; }
    E.unit_begin(cur, 0, wid, lane);
    PG8_STAGE(rsB, PG8_SB(0, 0), cB, voffB0); PG8_STAGE(rsB, PG8_SB(0, 1), cB + hstepB, voffB0); PG8_STAGE(rsA, PG8_SA(0, 0), cA, voffA0); PG8_STAGE(rsA, PG8_SA(0, 1), cA + hstepA, voffA0);
    if (wr == 1) PG8_BAR;
    PG8_STAGE(rsB, PG8_SB(1, 0), cB + kstep, voffB0); PG8_STAGE(rsB, PG8_SB(1, 1), cB + kstep + hstepB, voffB0);
    PG8_WAIT_V(6); PG8_BAR; PG8_BAR;
    PG8_LDB(B0e, 0, 0);
    for (;;) {
        const bool has_next = S.next(ui + 1, nxt);
        unsigned nko = 0; if constexpr (Sched::SPLIT) nko = has_next ? (unsigned)nxt.kt0 * kstep : 0;
        const unsigned nA = has_next ? (unsigned)nxt.pm * 2 * hstepA + (unsigned)((nxt.pn >> g.agrp_shift) * g.agrp_stride) * 2 + nko : cA; const unsigned nB = has_next ? (unsigned)nxt.pn * 2 * hstepB + nko : cB;
        unsigned oA = cA + kstep, oB = cB + 2 * kstep;
        for (int t = 0; t < nt; t += 2) {
            const bool last = (t == nt - 2);
            const unsigned a2 = last ? nA : oA + kstep, b2 = last ? nB : oB;
            PG8_ITER(oA, a2, b2, b2 + kstep, !last); oA += 2 * kstep; oB += 2 * kstep; }
        if (wr == 0) PG8_BAR;
        E(acc, cur, ui, wr, wc, fr, fq);
        if (!has_next) break;
        { f32x2 z2 = (f32x2){0.f, 0.f}; asm volatile("" : "+v"(z2));
#pragma unroll
        for (int a = 0; a < 2; ++a)
#pragma unroll
            for (int b = 0; b < 2; ++b)
#pragma unroll
                for (int m = 0; m < 4; ++m)
#pragma unroll
                    for (int n = 0; n < 2; ++n) acc[a][b][m][n] = __builtin_shufflevector(z2, z2, 0, 1, 0, 1); }
        cur = nxt; cA = nA; cB = nB; ++ui; if constexpr (Sched::SPLIT) nt = cur.nkt;
        if (wr == 1) PG8_BAR;
        E.unit_begin(cur, ui, wid, lane);
        PG8_LDB(B0e, 0, 0);
    }
    PG8_WAIT_V(0);
    PG8_BAR;
#undef PG8_SA
#undef PG8_SB
#undef PG8_STAGE
#undef PG8_LDA
#undef PG8_LDB
#undef PG8_MMA2
#undef PG8_WAIT_V
#undef PG8_WAIT_VL
#undef PG8_BAR
#undef PG8_SCHED
#undef PG8_ITER
}

struct EpiProj {
    static constexpr bool PERM = true, APERM = false;
    bf16* O; int ldc;
    __device__ __forceinline__ void unit_begin(const Unit&, int, int, int) const {}
    __device__ __forceinline__ void operator()(const f32x4 (&acc)[2][2][4][2], const Unit& u, int, int wr, int wc, int fr, int fq) const {
        asm volatile("" : "+v"(fr), "+v"(fq));
        const int row0 = u.pm * BM + wr * 64 + fr, col0 = u.pn * BM + wc * 32 + 8 * fq; const float sc = u.pn < 8 ? 0.0625f : 1.f;
#pragma unroll
        for (int ai = 0; ai < 2; ++ai)
#pragma unroll
            for (int m = 0; m < 4; ++m) { bf16* rowp = O + (size_t)(row0 + ai * HALF + m * 16) * ldc + col0;
#pragma unroll
                for (int bj = 0; bj < 2; ++bj) { const f32x4 v0 = acc[ai][bj][m][0] * sc, v1 = acc[ai][bj][m][1] * sc;
                    u32x4 w; w.x = cvt_pk_bf16(v0[0], v0[1]); w.y = cvt_pk_bf16(v0[2], v0[3]); w.z = cvt_pk_bf16(v1[0], v1[1]); w.w = cvt_pk_bf16(v1[2], v1[3]);
                    *(u32x4*)(rowp + bj * HALF) = w; } }
    }
};

struct EpiNull {
    static constexpr bool PERM = false, APERM = false;
    __device__ __forceinline__ void unit_begin(const Unit&, int, int, int) const {}
    __device__ __forceinline__ void operator()(const f32x4 (&acc)[2][2][4][2], const Unit&, int, int, int, int, int) const {
#pragma unroll
        for (int ai = 0; ai < 2; ++ai)
#pragma unroll
            for (int bj = 0; bj < 2; ++bj)
#pragma unroll
                for (int m = 0; m < 4; ++m)
#pragma unroll
                    for (int n = 0; n < 2; ++n) asm volatile("" :: "v"(acc[ai][bj][m][n]));
    }
};
template <bool BASE_F32> struct EpiResid {
    static constexpr bool PERM = true, APERM = false;
    const void* base; const float* ginv_src; const float* colscale; bf16* O; const float* gA; float* rss;
    __device__ __forceinline__ void unit_begin(const Unit&, int, int, int) const {}
    __device__ __forceinline__ void operator()(const f32x4 (&acc)[2][2][4][2], const Unit& u, int, int wr, int wc, int fr, int fq) const {
        asm volatile("" : "+v"(fr), "+v"(fq));
        const int row0 = u.pm * BM + wr * 64 + fr, col0 = u.pn * BM + wc * 32 + 8 * fq;
        f32x4 cs[2][2], gv[2][2], gi[2][2];
#pragma unroll
        for (int bj = 0; bj < 2; ++bj)
#pragma unroll
            for (int n = 0; n < 2; ++n) { const int cc = col0 + bj * HALF + 4 * n;
                cs[bj][n] = colscale ? *(const f32x4*)(colscale + cc) : (f32x4){1.f, 1.f, 1.f, 1.f};
                gv[bj][n] = gA ? *(const f32x4*)(gA + cc) : (f32x4){1.f, 1.f, 1.f, 1.f};
                if (ginv_src) { const f32x4 t = *(const f32x4*)(ginv_src + cc); gi[bj][n] = (f32x4){1.0f / t[0], 1.0f / t[1], 1.0f / t[2], 1.0f / t[3]}; } else gi[bj][n] = (f32x4){1.f, 1.f, 1.f, 1.f}; }
#pragma unroll
        for (int ai = 0; ai < 2; ++ai) {
            f32x4 pb[4][2][2]; u32x4 pw[4][2];
#pragma unroll
            for (int m = 0; m < 4; ++m) { const size_t off = (size_t)(row0 + ai * HALF + m * 16) * D + col0;
#pragma unroll
                for (int bj = 0; bj < 2; ++bj) {
                    if (BASE_F32) { pb[m][bj][0] = __builtin_nontemporal_load((const f32x4*)((const float*)base + off + bj * HALF)); pb[m][bj][1] = __builtin_nontemporal_load((const f32x4*)((const float*)base + off + bj * HALF + 4)); }
                    else pw[m][bj] = *(const u32x4*)((const bf16*)base + off + bj * HALF); } }
#pragma unroll
            for (int m = 0; m < 4; ++m) { const int r = row0 + ai * HALF + m * 16; const size_t off = (size_t)r * D + col0; float ss = 0.f;
#pragma unroll
                for (int bj = 0; bj < 2; ++bj) { f32x4 b0, b1;
                    if (BASE_F32) { b0 = pb[m][bj][0]; b1 = pb[m][bj][1]; }
                    else { const u32x4 w = pw[m][bj];
                        b0 = (f32x4){bf2f(w.x & 0xffffu), bf2f(w.x >> 16), bf2f(w.y & 0xffffu), bf2f(w.y >> 16)}; b1 = (f32x4){bf2f(w.z & 0xffffu), bf2f(w.z >> 16), bf2f(w.w & 0xffffu), bf2f(w.w >> 16)}; }
                    const f32x4 v0 = b0 * gi[bj][0] + acc[ai][bj][m][0] * cs[bj][0], v1 = b1 * gi[bj][1] + acc[ai][bj][m][1] * cs[bj][1];
                    ss += ((v0[0] * v0[0] + v0[1] * v0[1]) + (v0[2] * v0[2] + v0[3] * v0[3])) + ((v1[0] * v1[0] + v1[1] * v1[1]) + (v1[2] * v1[2] + v1[3] * v1[3]));
                    const f32x4 a0 = v0 * gv[bj][0], a1 = v1 * gv[bj][1];
                    u32x4 w; w.x = cvt_pk_bf16(a0[0], a0[1]); w.y = cvt_pk_bf16(a0[2], a0[3]); w.z = cvt_pk_bf16(a1[0], a1[1]); w.w = cvt_pk_bf16(a1[2], a1[3]);
                    *(u32x4*)(O + off + bj * HALF) = w; }
                ss += __shfl_xor(ss, 16); ss += __shfl_xor(ss, 32);
                if (fq == 0) rss[(size_t)r * 64 + u.pn * 4 + wc] = ss; }
            asm volatile("" ::: "memory");
        }
    }
};

__device__ __forceinline__ float dpp_shr1(float old, float src) { return __builtin_bit_cast(float, __builtin_amdgcn_update_dpp(__builtin_bit_cast(int, old), __builtin_bit_cast(int, src), 0x111, 0xf, 0xf, false)); }
__device__ __forceinline__ float dpp_shr2(float old, float src) { return __builtin_bit_cast(float, __builtin_amdgcn_update_dpp(__builtin_bit_cast(int, old), __builtin_bit_cast(int, src), 0x112, 0xf, 0xf, false)); }
__device__ __forceinline__ float dpp_ror1(float src) { return __builtin_bit_cast(float, __builtin_amdgcn_mov_dpp(__builtin_bit_cast(int, src), 0x121, 0xf, 0xf, true)); }
__device__ __forceinline__ float dpp_ror2(float src) { return __builtin_bit_cast(float, __builtin_amdgcn_mov_dpp(__builtin_bit_cast(int, src), 0x122, 0xf, 0xf, true)); }
__device__ __forceinline__ float silu_f(float x) { return x * __builtin_amdgcn_rcpf(1.0f + __builtin_amdgcn_exp2f(-1.44269504089f * x)); }
template <int KIND  > struct EpiFfn1T {
    static constexpr bool PERM = true, APERM = true;
    bf16* O; const float* convp; float* halo; LAS unsigned char* lds; float* part; unsigned* flag; unsigned epoch;
    __device__ __forceinline__ void unit_begin(const Unit& u, int ui, int wid, int lane) const {
        if (wid < 4)
            __builtin_amdgcn_global_load_lds((const unsigned*)((const char*)convp + (size_t)u.pn * 4096 + wid * 1024 + lane * 16), (LAS unsigned*)(lds + CONVP_OFF + (ui & 1) * 4096 + wid * 1024), 16, 0, 0);
    }
    __device__ __forceinline__ void operator()(f32x4 (&acc)[2][2][4][2], const Unit& u, int ui, int wr, int wc, int fr, int fq) const {
        asm volatile("" : "+v"(fr), "+v"(fq));
        const int wid = wr * 4 + wc;
        if constexpr (KIND == 2) {
            const __amdgpu_buffer_rsrc_t rsrc = __builtin_amdgcn_make_buffer_rsrc((void*)part, 0, 262144, 0x00020000);
            const int voff = (wid * 64 + fq * 16 + fr) * 16;
#pragma unroll
            for (int ai = 0; ai < 2; ++ai)
#pragma unroll
                for (int bj = 0; bj < 2; ++bj)
#pragma unroll
                    for (int m = 0; m < 4; ++m)
#pragma unroll
                        for (int n = 0; n < 2; ++n) __builtin_amdgcn_raw_buffer_store_b128(__builtin_bit_cast(u32x4, acc[ai][bj][m][n]), rsrc, voff + (((ai * 2 + bj) * 4 + m) * 2 + n) * 8192, 0, 16);
            asm volatile("s_waitcnt vmcnt(0)" ::: "memory"); __builtin_amdgcn_s_barrier(); asm volatile("" ::: "memory");
            if (wid == 0 && fq == 0 && fr == 0) __hip_atomic_store(flag, epoch, __ATOMIC_RELAXED, __HIP_MEMORY_SCOPE_AGENT);
            return;
        }
        if constexpr (KIND == 1) {
            if (wid == 0) { unsigned sp = 0;
                while ((unsigned)__builtin_amdgcn_readfirstlane(__hip_atomic_load(flag, __ATOMIC_RELAXED, __HIP_MEMORY_SCOPE_AGENT)) < epoch) { __builtin_amdgcn_s_sleep(2); if (++sp > (1u << 22)) break; }
                __builtin_amdgcn_fence(__ATOMIC_ACQUIRE, "agent"); asm volatile("s_waitcnt vmcnt(0)" ::: "memory"); }
            asm volatile("" ::: "memory"); __builtin_amdgcn_s_barrier(); asm volatile("" ::: "memory");
            const f32x4* pp = (const f32x4*)part + (wid * 64 + fq * 16 + fr);
#pragma unroll
            for (int ai = 0; ai < 2; ++ai)
#pragma unroll
                for (int bj = 0; bj < 2; ++bj) {
                    f32x4 t8[4][2];
#pragma unroll
                    for (int m = 0; m < 4; ++m)
#pragma unroll
                        for (int n = 0; n < 2; ++n) t8[m][n] = pp[(((ai * 2 + bj) * 4 + m) * 2 + n) * 512];
#pragma unroll
                    for (int m = 0; m < 4; ++m)
#pragma unroll
                        for (int n = 0; n < 2; ++n) acc[ai][bj][m][n] += t8[m][n];
                    asm volatile("" : "+v"(acc[ai][bj][0][0]), "+v"(acc[ai][bj][0][1]), "+v"(acc[ai][bj][1][0]), "+v"(acc[ai][bj][1][1]), "+v"(acc[ai][bj][2][0]), "+v"(acc[ai][bj][2][1]), "+v"(acc[ai][bj][3][0]), "+v"(acc[ai][bj][3][1]) :: "memory"); }
            asm volatile("" : "+v"(fr), "+v"(fq));
        }
        const LAS float* rstd = (const LAS float*)(lds + RSTD_OFF);
        const LAS float* cp = (const LAS float*)(lds + CONVP_OFF + (ui & 1) * 4096);
        LAS float* ex = (LAS float*)(lds + EXCH_OFF);
#pragma unroll
        for (int ai = 0; ai < 2; ++ai) { const f32x4 rs4 = *(const LAS f32x4*)(rstd + ai * HALF + wr * 64 + 4 * fr);
#pragma unroll
            for (int m = 0; m < 4; ++m)
#pragma unroll
                for (int bj = 0; bj < 2; ++bj)
#pragma unroll
                    for (int n = 0; n < 2; ++n) acc[ai][bj][m][n] *= rs4[m]; }
        if (fr == 15) {
#pragma unroll
            for (int ai = 0; ai < 2; ++ai)
#pragma unroll
                for (int bj = 0; bj < 2; ++bj)
#pragma unroll
                    for (int n = 0; n < 2; ++n) { *(LAS f32x4*)(ex + ((wid * 2 + ai) * 2 + 0) * 64 + (bj * 2 + n) * 16 + fq * 4) = acc[ai][bj][2][n]; *(LAS f32x4*)(ex + ((wid * 2 + ai) * 2 + 1) * 64 + (bj * 2 + n) * 16 + fq * 4) = acc[ai][bj][3][n]; }
        }
        {
            const int colb = u.pn * BM + wc * 32 + 8 * fq;
            if (wr == 0 && fr == 0) {
#pragma unroll
                for (int rr = 0; rr < 2; ++rr)
#pragma unroll
                    for (int bj = 0; bj < 2; ++bj)
#pragma unroll
                        for (int n = 0; n < 2; ++n) *(f32x4*)(halo + ((size_t)u.pm * 4 + rr) * NFF1 + colb + bj * HALF + 4 * n) = acc[0][bj][rr][n];
            }
            if (wr == 1 && fr == 15) {
#pragma unroll
                for (int rr = 0; rr < 2; ++rr)
#pragma unroll
                    for (int bj = 0; bj < 2; ++bj)
#pragma unroll
                        for (int n = 0; n < 2; ++n) *(f32x4*)(halo + ((size_t)u.pm * 4 + 2 + rr) * NFF1 + colb + bj * HALF + 4 * n) = acc[1][bj][2 + rr][n];
            }
        }
        LDS_WAIT(); __builtin_amdgcn_s_barrier(); asm volatile("" ::: "memory");
        const int row0 = u.pm * BM + wr * 64 + 4 * fr, colo = u.pn * HALF + wc * 32 + 8 * fq;
        u32x2 hold[2][4];
        f32x2 kone = (f32x2){1.0f, 1.0f}; asm volatile("" : "+v"(kone));
#pragma unroll
        for (int n = 0; n < 2; ++n) {
            f32x4 pw[4][2];
#pragma unroll
            for (int p = 0; p < 4; ++p)
#pragma unroll
                for (int bj = 0; bj < 2; ++bj) pw[p][bj] = *(const LAS f32x4*)(cp + p * 256 + bj * HALF + wc * 32 + 8 * fq + 4 * n);
#pragma unroll
            for (int ai = 0; ai < 2; ++ai) {
                const int swv = (ai == 1 && wr == 0) ? wid + 4 : wid - 4, sai = (ai == 1 && wr == 1) ? 1 : 0; const bool have = !(ai == 0 && wr == 0);
                f32x4 pm1[2], pm2[2];
#pragma unroll
                for (int bj = 0; bj < 2; ++bj) {
                    f32x4 e0 = (f32x4){0.f, 0.f, 0.f, 0.f}, e1 = e0;
                    if (have) { e0 = *(const LAS f32x4*)(ex + ((swv * 2 + sai) * 2 + 0) * 64 + (bj * 2 + n) * 16 + fq * 4); e1 = *(const LAS f32x4*)(ex + ((swv * 2 + sai) * 2 + 1) * 64 + (bj * 2 + n) * 16 + fq * 4); }
#pragma unroll
                    for (int i = 0; i < 4; ++i) { pm1[bj][i] = dpp_shr1(e1[i], acc[ai][bj][3][n][i]); pm2[bj][i] = dpp_shr1(e0[i], acc[ai][bj][2][n][i]); }
                }
#pragma unroll
                for (int m = 0; m < 4; ++m) {
                    f32x4 hc[2];
#pragma unroll
                    for (int bj = 0; bj < 2; ++bj) {
                        const f32x4 cur = acc[ai][bj][m][n];
                        const f32x4 h1 = m == 0 ? pm1[bj] : acc[ai][bj][m == 0 ? 0 : m - 1][n];
                        const f32x4 h2 = m == 0 ? pm2[bj] : (m == 1 ? pm1[bj] : acc[ai][bj][m < 2 ? 0 : m - 2][n]);
                        hc[bj] = pw[3][bj] + pw[0][bj] * h2 + pw[1][bj] * h1 + pw[2][bj] * cur;
                    }
                    const f32x2 e01 = (f32x2){__builtin_amdgcn_exp2f(hc[0][0]), __builtin_amdgcn_exp2f(hc[0][1])}, e23 = (f32x2){__builtin_amdgcn_exp2f(hc[0][2]), __builtin_amdgcn_exp2f(hc[0][3])};
                    const f32x2 d01 = e01 + kone, d23 = e23 + kone;
                    const f32x4 r = (f32x4){__builtin_amdgcn_rcpf(d01[0]), __builtin_amdgcn_rcpf(d01[1]), __builtin_amdgcn_rcpf(d23[0]), __builtin_amdgcn_rcpf(d23[1])};
                    const f32x4 o = (hc[0] * hc[1]) * r;
                    u32x2 w; w.x = cvt_pk_bf16(o[0], o[1]); w.y = cvt_pk_bf16(o[2], o[3]);
                    if (n == 0) hold[ai][m] = w;
                    else *(u32x4*)(O + (size_t)(row0 + ai * HALF + m) * KFF2 + colo) = (u32x4){hold[ai][m].x, hold[ai][m].y, w.x, w.y};
                }
            }
        }
    }
};
}

#define XB_TMO      128
#define XB_XCNT(j)  (256  + 64 * (j))
#define XB_XSUB(j)  (1280 + 64 * (j))
#define XB_XGEN(j)  (2304 + 64 * (j))
#define XB_TOP      3328
#define XB_TOPGEN   3392
#define XCD_BAR_WORDS 3456
#define XB_SPIN_CAP (1u << 18)
__device__ __forceinline__ unsigned xb_ld(unsigned* p)              { return __hip_atomic_load(p, __ATOMIC_RELAXED, __HIP_MEMORY_SCOPE_AGENT); }
__device__ __forceinline__ unsigned xb_add(unsigned* p, unsigned v) { return __hip_atomic_fetch_add(p, v, __ATOMIC_RELAXED, __HIP_MEMORY_SCOPE_AGENT); }
__device__ __forceinline__ unsigned xb_xcc_id() { return (unsigned)__builtin_amdgcn_s_getreg((3 << 11) | 20) & 0xFu; }
#define XB_SPIN(cond, bar) do { unsigned _sp = 0; while (cond) { __builtin_amdgcn_s_sleep(1); \
    if ((++_sp & 255u) == 0u) { if (xb_ld(&(bar)[XB_TMO])) break; if (_sp > XB_SPIN_CAP) { atomicAdd(&(bar)[XB_TMO], 1u); break; } } } } while (0)
struct XcdBarrier { unsigned* bar; unsigned x; volatile LAS unsigned* st; };
__device__ __forceinline__ XcdBarrier xcd_barrier_post(unsigned* bar, volatile LAS unsigned* st) {
    XcdBarrier b; b.bar = bar; b.x = xb_xcc_id(); b.st = st;
    if (threadIdx.x == 0) (void)xb_add(&bar[XB_XCNT(b.x)], 1u);
    return b;
}
__device__ __forceinline__ void xcd_barrier_complete(unsigned* bar, unsigned x, unsigned& nloc, unsigned& nx) {
    const unsigned G = gridDim.x * gridDim.y * gridDim.z;
    unsigned sum, cnt, mine, sp = 0u;
    for (;;) {
        sum = 0u; cnt = 0u; mine = 0u;
#pragma unroll
        for (unsigned j = 0; j < 16; ++j) { const unsigned c = xb_ld(&bar[XB_XCNT(j)]); sum += c; cnt += (c > 0u) ? 1u : 0u; mine = (j == x) ? c : mine; }
        if (sum == G) break;
        __builtin_amdgcn_s_sleep(1);
        if ((++sp & 255u) == 0u) { if (xb_ld(&bar[XB_TMO])) break; if (sp > XB_SPIN_CAP) { atomicAdd(&bar[XB_TMO], 1u); break; } }
    }
    nloc = mine > 0u ? mine : 1u; nx = cnt > 0u ? cnt : 1u;
}
__device__ __forceinline__ void xcd_barrier(const XcdBarrier& b) {
    asm volatile("s_waitcnt vmcnt(0)" ::: "memory");
    __syncthreads();
    if (threadIdx.x == 0) {
        unsigned* bar = b.bar;
        __builtin_amdgcn_s_waitcnt(0);
        unsigned nloc = b.st[0], nx = b.st[1];
        if (nloc == 0u) { xcd_barrier_complete(bar, b.x, nloc, nx); b.st[0] = nloc; b.st[1] = nx; }
        const unsigned old = xb_add(&bar[XB_XSUB(b.x)], 1u);
        const unsigned gen = old / nloc;
        if (old + 1u == (gen + 1u) * nloc) {
            __builtin_amdgcn_fence(__ATOMIC_RELEASE, "agent");
            asm volatile("s_waitcnt vmcnt(0)" ::: "memory");
            const unsigned og = xb_add(&bar[XB_TOP], 1u);
            const unsigned tg = og / nx;
            if (og + 1u == (tg + 1u) * nx) xb_add(&bar[XB_TOPGEN], 1u);
            else XB_SPIN(xb_ld(&bar[XB_TOPGEN]) == tg, bar);
            __builtin_amdgcn_fence(__ATOMIC_ACQUIRE, "agent");
            xb_add(&bar[XB_XGEN(b.x)], 1u);
            asm volatile("s_waitcnt vmcnt(0)" ::: "memory");
        } else {
            XB_SPIN(xb_ld(&bar[XB_XGEN(b.x)]) == gen, bar);
            __builtin_amdgcn_fence(__ATOMIC_ACQUIRE, "agent");
            asm volatile("s_waitcnt vmcnt(0)" ::: "memory");
        }
    }
    __syncthreads();
}

constexpr int NWAVES = 8;
#define WSP(T, off) ((T*)(F.ws + (off)))
struct Args { const float* in[16]; float* out; unsigned char* ws; int ph_lo, ph_hi, li, pad; };
struct Frame {
    LAS unsigned char* lds; int tid, lane, wave, vcu, G;
    unsigned char* ws; float* out;
};
__device__ __forceinline__ float wave_sum(float v) {
#pragma unroll
    for (int o = 1; o < 64; o <<= 1) v += __shfl_xor(v, o);
    return v;
}

constexpr int CV_NB1 = DFF2 / 64, CV_W1 = (D / 32) * CV_NB1, CV_KB2 = DFF / 32, CV_TOTAL = CV_W1 + CV_KB2 * (D / 64);
static_assert(DFF % 64 == 0 && DFF2 % 64 == 0 && DFF % 32 == 0 && D / 32 == 128, "SCANCVT block shapes");
struct CvBlk { const float* src; bf16* dst; unsigned lds; };
__device__ __forceinline__ CvBlk cv_decode(const float* w1src, const float* w2src, unsigned char* ws, int id, int lane) {
    CvBlk b;
    if (id < CV_W1) { const int kb = id & (D / 32 - 1), nb = id >> 7, n = 64 * nb + lane;        const int f0 = n < DFF ? n : n - DFF; const int rowdst = 256 * (f0 >> 7) + (n < DFF ? 0 : 128) + (f0 & 127);
        b.src = w1src + (size_t)D * DFF2 + (size_t)(32 * kb) * DFF2 + n; b.dst = (bf16*)(ws + WS_W1) + (size_t)NFF1 * D + (size_t)rowdst * D + 32 * kb; b.lds = (unsigned)DFF2; }
    else { const int id2 = id - CV_W1, kb = id2 >> 6, nb = id2 & 63, n = 64 * nb + lane;
        b.src = w2src + (size_t)DFF * D + (size_t)(32 * kb) * D + n; b.dst = (bf16*)(ws + WS_W2) + (size_t)D * KFF2 + (size_t)n * KFF2 + 32 * kb; b.lds = (unsigned)D; }
    return b;
}
__device__ __forceinline__ void cv_load(const CvBlk& b, float (&v)[32]) {
#pragma unroll
    for (int i = 0; i < 32; ++i) v[i] = __builtin_nontemporal_load(b.src + (size_t)i * b.lds);
}
__device__ __forceinline__ void cv_store(const CvBlk& b, const float (&v)[32]) {
#pragma unroll
    for (int q = 0; q < 4; ++q) { u32x4 o; o.x = cvt_pk_bf16(v[8 * q], v[8 * q + 1]); o.y = cvt_pk_bf16(v[8 * q + 2], v[8 * q + 3]); o.z = cvt_pk_bf16(v[8 * q + 4], v[8 * q + 5]); o.w = cvt_pk_bf16(v[8 * q + 6], v[8 * q + 7]);
        *(u32x4*)(b.dst + 8 * q) = o; }
}

__device__ __forceinline__ void tr_item(const float* W, size_t ldw, int k0, int n0, bf16* WT, size_t ldt, int rowdst, LAS float* scr, int lane) {
#pragma unroll 8
    for (int i = 0; i < 32; ++i) { const int kk = 2 * i + (lane >> 5); scr[kk * 33 + (lane & 31)] = __builtin_nontemporal_load(W + (size_t)(k0 + kk) * ldw + n0 + (lane & 31)); }
    LDS_WAIT(); asm volatile("" ::: "memory");
    const int c = lane & 7;
#pragma unroll
    for (int j = 0; j < 4; ++j) { const int n = (lane >> 3) + 8 * j; const LAS float* s = scr + (8 * c) * 33 + n;
        u32x4 o; o.x = pk2(s[0 * 33], s[1 * 33]); o.y = pk2(s[2 * 33], s[3 * 33]); o.z = pk2(s[4 * 33], s[5 * 33]); o.w = pk2(s[6 * 33], s[7 * 33]);
        *(u32x4*)(WT + (size_t)(rowdst + n) * ldt + k0 + 8 * c) = o; }
    LDS_WAIT(); asm volatile("" ::: "memory");
}
__device__ __forceinline__ void rms_row_to_bf16(const float* xrow, const float* g, bf16* orow, int lane) {
    const f32x4* xr = (const f32x4*)xrow + lane; const f32x4* gr = (const f32x4*)g + lane;
    f32x4 v[16]; float s = 0.f;
#pragma unroll
    for (int j = 0; j < 16; ++j) { v[j] = __builtin_nontemporal_load(xr + 64 * j); s += (v[j][0] * v[j][0] + v[j][1] * v[j][1]) + (v[j][2] * v[j][2] + v[j][3] * v[j][3]); }
    const float rstd = 1.0f / sqrtf(wave_sum(s) * (1.f / D) + EPS);
    u32x2* o8 = (u32x2*)orow + lane;
#pragma unroll
    for (int j = 0; j < 16; ++j) { const f32x4 gg = gr[64 * j]; u32x2 w; w.x = pk2(v[j][0] * rstd * gg[0], v[j][1] * rstd * gg[1]); w.y = pk2(v[j][2] * rstd * gg[2], v[j][3] * rstd * gg[3]); o8[64 * j] = w; }
}
__device__ __forceinline__ void p0_prologue(Frame& F, const Args& args) {
    LAS float* scr = (LAS float*)(F.lds + RING_OFF + F.wave * 16384);
    const int gw = F.vcu * NWAVES + F.wave, NGW = F.G * NWAVES;
    constexpr int I_P = 64 * 384, I_O = 64 * 128, I_1 = 64 * 684, I_2 = 171 * 128, I_G = 16 * 32;
    constexpr int NITEMS = I_P + I_O + I_1 + I_2 + 4 * I_G;
    for (int it = gw; it < NITEMS; it += NGW) {
        int r = it + I_P; if (r >= NITEMS) r -= NITEMS;
        if (r < I_P) { const int kb = r / 384, nb = r % 384; tr_item(args.in[2], PROJ_W, 64 * kb, 32 * nb, WSP(bf16, WS_WP), D, 32 * nb, scr, F.lane); continue; } r -= I_P;
        if (r < I_O) { const int kb = r / 128, nb = r % 128; tr_item(args.in[6], D, 64 * kb, 32 * nb, WSP(bf16, WS_WO), D, 32 * nb, scr, F.lane); continue; } r -= I_O;
        if (r < I_1) { const int l = 0; const int kb = r / 684, nb = r % 684; const int n0 = 32 * nb; const int f0 = n0 < DFF ? n0 : n0 - DFF;
            const int rowdst = 256 * (f0 >> 7) + (n0 < DFF ? 0 : 128) + (f0 & 127);
            tr_item(args.in[11] + (size_t)l * D * DFF2, DFF2, 64 * kb, n0, WSP(bf16, WS_W1) + (size_t)l * NFF1 * D, D, rowdst, scr, F.lane); continue; } r -= I_1;
        if (r < I_2) { const int l = 0; const int kb = r / 128, nb = r % 128;
            tr_item(args.in[14] + (size_t)l * DFF * D, D, 64 * kb, 32 * nb, WSP(bf16, WS_W2) + (size_t)l * D * KFF2, KFF2, 32 * nb, scr, F.lane); continue; } r -= I_2;
        { const int gidx = r / I_G; r -= gidx * I_G; const int kb = r / 32, nb = r % 32;
            tr_item(args.in[8] + (size_t)gidx * 1024 * 1024, 1024, 64 * kb, 32 * nb, WSP(bf16, WS_WPOOL) + (size_t)gidx * 1024 * 1024, 1024, 32 * nb, scr, F.lane); }
    }
    {
        const int scan_blocks = ((256 + F.G - 1) / F.G) * (SEQ / 64) * NGW;
        for (int id = scan_blocks + gw; id < CV_TOTAL; id += NGW) { float v[32]; const CvBlk b = cv_decode(args.in[11], args.in[14], F.ws, id, F.lane); cv_load(b, v); cv_store(b, v); }
    }
    const int gt = F.vcu * (NWAVES * 64) + F.tid, NGT = F.G * NWAVES * 64;
    for (int i = gt; i < 2 * 128 * (D / 8); i += NGT) { const int l = i / (128 * (D / 8)), rr = (i / (D / 8)) % 128, c8 = i % (D / 8); const int row = 85 * 256 + (rr < 64 ? 64 + rr : 192 + (rr - 64));
        *(u32x4*)(WSP(bf16, WS_W1) + ((size_t)l * NFF1 + row) * D + 8 * c8) = (u32x4){0u, 0u, 0u, 0u}; }
    for (int i = gt; i < 2 * D * 8; i += NGT) { const int l = i / (D * 8), row = (i / 8) % D, c8 = i % 8; *(u32x4*)(WSP(bf16, WS_W2) + ((size_t)l * D + row) * KFF2 + DFF + 8 * c8) = (u32x4){0u, 0u, 0u, 0u}; }
    for (int i = gt; i < 2 * FT * 4 * 256; i += NGT) { const int cc = i & 255, p = (i >> 8) & 3, j = (i >> 10) % FT, l = i / (FT * 1024); const int f = 128 * j + (cc & 127); const int col = cc < 128 ? f : DFF + f;
        float v = 0.f; if (f < DFF) v = p < 3 ? args.in[12][((size_t)l * 3 + p) * DFF2 + col] : args.in[13][(size_t)l * DFF2 + col];
        WSP(float, WS_CONVP)[i] = v * (cc < 128 ? -1.44269504089f : -0.69314718056f); }
    for (int i = gt; i < 16 * D; i += NGT) { const int c = i & 15, k = i >> 4; WSP(bf16, WS_WG)[(size_t)c * D + k] = (bf16)f2bf(args.in[2][(size_t)k * PROJ_W + NPROJ + c]); }
    for (int m = gw; m < M; m += NGW) rms_row_to_bf16(args.in[0] + (size_t)m * D, args.in[1], WSP(bf16, WS_XA) + (size_t)m * D, F.lane);
}

__device__ __forceinline__ float softcap15(float a) { return 15.0f * tanhf(a * (1.0f / 15.0f)); }
__device__ __forceinline__ void p1_gates(Frame& F, const Args& args) {
    const int gw = F.vcu * NWAVES + F.wave, NGW = F.G * NWAVES; const int fr = F.lane & 15, fq = F.lane >> 4;
    for (int rb = gw; rb < M / 16; rb += NGW) {
        const bf16* ap = WSP(bf16, WS_XA) + (size_t)(rb * 16 + fr) * D + 8 * fq; const bf16* bp = WSP(bf16, WS_WG) + (size_t)fr * D + 8 * fq;
        f32x4 acc = (f32x4){0.f, 0.f, 0.f, 0.f};
#pragma unroll 16
        for (int k = 0; k < D; k += 32) { const bf16x8 a = *(const bf16x8*)(ap + k); const bf16x8 b = *(const bf16x8*)(bp + k); acc = __builtin_amdgcn_mfma_f32_16x16x32_bf16(a, b, acc, 0, 0, 0); }
        const int c = fr; const float bias = c < 8 ? args.in[3][c] : args.in[4][c - 8];
#pragma unroll
        for (int r = 0; r < 4; ++r) { const float z = softcap15(acc[r] + bias); float o = z;
            if (c >= 8) o = fminf(z, 0.f) - log1pf(expf(-fabsf(z)));
            WSP(float, WS_GATES)[(size_t)(rb * 16 + 4 * fq + r) * 16 + c] = o; }
    }
}

__device__ __forceinline__ float row_sum16(float x) {
    x += __builtin_bit_cast(float, __builtin_amdgcn_update_dpp(0, __builtin_bit_cast(int, x), 0x128, 0xf, 0xf, false));
    x += __builtin_bit_cast(float, __builtin_amdgcn_update_dpp(0, __builtin_bit_cast(int, x), 0x124, 0xf, 0xf, false));
    x += __builtin_bit_cast(float, __builtin_amdgcn_update_dpp(0, __builtin_bit_cast(int, x), 0x122, 0xf, 0xf, false));
    x += __builtin_bit_cast(float, __builtin_amdgcn_update_dpp(0, __builtin_bit_cast(int, x), 0x121, 0xf, 0xf, false));
    return x;
}
__device__ __forceinline__ float wave_scan_add(float x, int lane) {
#define SC_STEP(ctrl) x += __builtin_bit_cast(float, __builtin_amdgcn_update_dpp(0, __builtin_bit_cast(int, x), ctrl, 0xf, 0xf, true))
    SC_STEP(0x111); SC_STEP(0x112); SC_STEP(0x114); SC_STEP(0x118);
#undef SC_STEP
    const float t0 = __builtin_bit_cast(float, __builtin_amdgcn_readlane(__builtin_bit_cast(int, x), 15)), t1 = __builtin_bit_cast(float, __builtin_amdgcn_readlane(__builtin_bit_cast(int, x), 31)), t2 = __builtin_bit_cast(float, __builtin_amdgcn_readlane(__builtin_bit_cast(int, x), 47));
    const int g = lane >> 4; return x + (g >= 1 ? t0 : 0.f) + (g >= 2 ? t1 : 0.f) + (g >= 3 ? t2 : 0.f);
}
__device__ __forceinline__ float wave_scan_max(float x, int lane) {
    const int ninf = (int)0xff800000u;
#define SC_STEP(ctrl) x = fmaxf(x, __builtin_bit_cast(float, __builtin_amdgcn_update_dpp(ninf, __builtin_bit_cast(int, x), ctrl, 0xf, 0xf, false)))
    SC_STEP(0x111); SC_STEP(0x112); SC_STEP(0x114); SC_STEP(0x118);
#undef SC_STEP
    const float t0 = __builtin_bit_cast(float, __builtin_amdgcn_readlane(__builtin_bit_cast(int, x), 15)), t1 = __builtin_bit_cast(float, __builtin_amdgcn_readlane(__builtin_bit_cast(int, x), 31)), t2 = __builtin_bit_cast(float, __builtin_amdgcn_readlane(__builtin_bit_cast(int, x), 47));
    const int g = lane >> 4; const float ninff = __builtin_bit_cast(float, ninf);
    return fmaxf(fmaxf(x, g >= 1 ? t0 : ninff), fmaxf(g >= 2 ? t1 : ninff, g >= 3 ? t2 : ninff));
}
typedef short v4i16_t __attribute__((ext_vector_type(4)));
__device__ __forceinline__ v4i16_t tr16(const LAS unsigned char* p) { return __builtin_amdgcn_ds_read_tr16_b64_v4i16((LAS v4i16_t*)p); }
__device__ __forceinline__ bf16x8 cat8(v4i16_t a, v4i16_t b) { return (bf16x8){a[0], a[1], a[2], a[3], b[0], b[1], b[2], b[3]}; }
constexpr int SC_QS = 0, SC_KS = 33792, SC_VS = 67584, SC_VW = 84992, SC_SS = 102400, SC_HS = 111616, SC_FA = 129024;
static_assert(SC_FA + 8192 <= LDSCTL_OFF, "scan LDS map");
__device__ __forceinline__ void p2_scan(Frame& F, const Args& args) {
    LAS unsigned char* L = F.lds;
    LAS float* fa = (LAS float*)(L + SC_FA);
    LAS float *sA = fa, *sM = fa + 64, *sWi = fa + 128, *sEi = fa + 192, *sKw = fa + 256, *sInv = fa + 320, *rsp = fa + 384  , *qnp = fa + 640  , *sn = fa + 1152  , *ssp = fa + 1408  , *scal = fa + 1920;
    const int tid0 = F.tid, w = F.wave;
    const bf16* PROJ = WSP(bf16, WS_PROJ); bf16* HB = WSP(bf16, WS_HB); float* SSg = WSP(float, WS_SS); const float* GATES = WSP(float, WS_GATES);
    const __amdgpu_buffer_rsrc_t rsP = __builtin_amdgcn_make_buffer_rsrc((void*)PROJ, 0, 0x7fffffff, 0x00020000), rsH = __builtin_amdgcn_make_buffer_rsrc((void*)HB, 0, 0x7fffffff, 0x00020000);
#define SC_LDQ(i, soff) __builtin_bit_cast(u32x4, __builtin_amdgcn_raw_buffer_load_b128(rsP, (unsigned)((((tid + 512 * (i)) >> 5) * NPROJ + ((tid + 512 * (i)) & 31) * 8) * 2), (soff), 0))
#define SC_LDV(i, soff) __builtin_bit_cast(u32x4, __builtin_amdgcn_raw_buffer_load_b128(rsP, (unsigned)((((tid + 512 * (i)) >> 4) * NPROJ + ((tid + 512 * (i)) & 15) * 8) * 2), (soff), 2))
    int cvid = F.vcu * NWAVES + F.wave;
    for (int item = F.vcu; item < 256; item += F.G) {
        const int bh = item >> 2, es = item & 3, b = bh >> 3, h = bh & 7;
        f32x4 C[16];
#pragma unroll
        for (int i = 0; i < 16; ++i) C[i] = (f32x4){0.f, 0.f, 0.f, 0.f};
        __syncthreads();
        if (tid0 < 256) sn[tid0] = 0.f;
        if (tid0 == 0) scal[0] = 0.f;
        u32x4 qv[4], kv[4], vv[2]; float ig_n, lf_n;
        { const size_t row0 = (size_t)b * SEQ; const int tid = tid0; ig_n = GATES[(row0 + (tid & 63)) * 16 + h]; lf_n = GATES[(row0 + (tid & 63)) * 16 + 8 + h];
#pragma unroll
            for (int i = 0; i < 4; ++i) { const unsigned so = (unsigned)((row0 * NPROJ + h * DQK) * 2); qv[i] = SC_LDQ(i, so); kv[i] = SC_LDQ(i, so + QKW * 2); }
#pragma unroll
            for (int i = 0; i < 2; ++i) vv[i] = SC_LDV(i, (unsigned)((row0 * NPROJ + 2 * QKW + h * DV + es * 128) * 2)); }
        for (int c = 0; c <= SEQ / 64; ++c) {
            const size_t row0 = (size_t)b * SEQ + 64 * c;
            int tid = tid0; asm volatile("" : "+v"(tid));
            const int lane = tid & 63, fr = lane & 15, fq = lane >> 4, tq = fr >> 2, tp = fr & 3;
            __syncthreads();
            if (c > 0) {
                const size_t prow0 = row0 - 64;
#pragma unroll
                for (int i = 0; i < 2; ++i) { const int p = tid + 512 * i, row = p >> 4, cc = p & 15; __builtin_amdgcn_raw_buffer_store_b128(*(const LAS u32x4*)(L + SC_HS + row * 272 + cc * 16), rsH, (unsigned)((row * D + cc * 8) * 2), (unsigned)((prow0 * D + h * DV + es * 128) * 2), 0); }
                if (tid < 64) { float q = 0.f;
#pragma unroll
                    for (int p = 0; p < 8; ++p) q += ssp[p * 64 + tid];
                    SSg[(prow0 + tid) * 32 + h * 4 + es] = q; }
                if (tid == 0) scal[0] = scal[2];
            }
            if (c == SEQ / 64) break;
#pragma unroll
            for (int i = 0; i < 4; ++i) { const int p = tid + 512 * i, row = p >> 5, cc = p & 31; *(LAS u32x4*)(L + SC_QS + row * 528 + cc * 16) = qv[i]; *(LAS u32x4*)(L + SC_KS + row * 528 + cc * 16) = kv[i]; }
#pragma unroll
            for (int i = 0; i < 2; ++i) { const int p = tid + 512 * i, row = p >> 4, cc = p & 15; *(LAS u32x4*)(L + SC_VS + row * 272 + cc * 16) = vv[i]; }
            const float ig = ig_n, lf = lf_n;
            if (c + 1 < SEQ / 64) {
                const size_t nrow0 = row0 + 64; ig_n = GATES[(nrow0 + lane) * 16 + h]; lf_n = GATES[(nrow0 + lane) * 16 + 8 + h];
#pragma unroll
                for (int i = 0; i < 4; ++i) { const unsigned so = (unsigned)((nrow0 * NPROJ + h * DQK) * 2); qv[i] = SC_LDQ(i, so); kv[i] = SC_LDQ(i, so + QKW * 2); }
#pragma unroll
                for (int i = 0; i < 2; ++i) vv[i] = SC_LDV(i, (unsigned)((nrow0 * NPROJ + 2 * QKW + h * DV + es * 128) * 2));
            }
            float cv[32]; CvBlk cvb; const bool cvon = cvid < CV_TOTAL;
            if (cvon) { cvb = cv_decode(args.in[11], args.in[14], F.ws, cvid, tid & 63); cv_load(cvb, cv); }
            cvid += F.G * NWAVES;
            LDS_WAIT(); __builtin_amdgcn_s_barrier(); asm volatile("" ::: "memory");
            if (w == 0) {
                const float bs = wave_scan_add(lf, lane);
                const float a = ig - bs; const float pm = wave_scan_max(a, lane);
                const float mprev = scal[0]; const float Mt = fmaxf(mprev, pm);
                const float M63 = __builtin_bit_cast(float, __builtin_amdgcn_readlane(__builtin_bit_cast(int, Mt), 63)), b63 = __builtin_bit_cast(float, __builtin_amdgcn_readlane(__builtin_bit_cast(int, bs), 63));
                sA[lane] = a; sM[lane] = Mt; sWi[lane] = __expf(mprev - Mt); sEi[lane] = __expf(-(bs + Mt)); sKw[lane] = __expf(a - M63);
                if (lane == 0) { scal[1] = __expf(mprev - M63); scal[2] = b63 + M63; }
            }
            { const int t = tid & 63; float s = 0.f;
#pragma unroll
                for (int j = 0; j < 4; ++j) { const int d0 = w * 32 + 8 * j; const u32x4 q = *(const LAS u32x4*)(L + SC_QS + t * 528 + d0 * 2); const LAS float* np = sn + d0;
                    s += bf2f(q.x & 0xffffu) * np[0] + bf2f(q.x >> 16) * np[1] + bf2f(q.y & 0xffffu) * np[2] + bf2f(q.y >> 16) * np[3] + bf2f(q.z & 0xffffu) * np[4] + bf2f(q.z >> 16) * np[5] + bf2f(q.w & 0xffffu) * np[6] + bf2f(q.w >> 16) * np[7]; }
                qnp[w * 64 + t] = s; }
            const int tr = w >> 1, tc0 = (w & 1) * 2; f32x4 s0 = (f32x4){0.f, 0.f, 0.f, 0.f}, s1 = s0;
#pragma unroll
            for (int kk = 0; kk < 8; ++kk) { const bf16x8 a = *(const LAS bf16x8*)(L + SC_QS + (16 * tr + fr) * 528 + (32 * kk + 8 * fq) * 2);
                const bf16x8 b0 = *(const LAS bf16x8*)(L + SC_KS + (16 * tc0 + fr) * 528 + (32 * kk + 8 * fq) * 2); const bf16x8 b1 = *(const LAS bf16x8*)(L + SC_KS + (16 * tc0 + 16 + fr) * 528 + (32 * kk + 8 * fq) * 2);
                s0 = __builtin_amdgcn_mfma_f32_16x16x32_bf16(a, b0, s0, 0, 0, 0); s1 = __builtin_amdgcn_mfma_f32_16x16x32_bf16(a, b1, s1, 0, 0, 0); }
            __syncthreads();
#pragma unroll
            for (int q = 0; q < 2; ++q) { const int tc = tc0 + q, sidx = 16 * tc + fr; const float as = sA[sidx];
#pragma unroll
                for (int r = 0; r < 4; ++r) { const int t = 16 * tr + 4 * fq + r; const float e = __expf(fminf(as - sM[t], 0.f)); const float wgt = (sidx <= t) ? e : 0.f; const float v = (q == 0 ? s0[r] : s1[r]) * wgt;
                    *(LAS unsigned short*)(L + SC_SS + (t * 72 + sidx) * 2) = (unsigned short)cvt_pk_bf16(v, v);
                    rsp[t * 4 + tc] = row_sum16(v); } }
#pragma unroll
            for (int i = 0; i < 2; ++i) { const int p = tid + 512 * i, row = p >> 4, cc = p & 15; const float kw = sKw[row]; const u32x4 v = *(const LAS u32x4*)(L + SC_VS + row * 272 + cc * 16); u32x4 o;
                o.x = cvt_pk_bf16(kw * bf2f(v.x & 0xffffu), kw * bf2f(v.x >> 16)); o.y = cvt_pk_bf16(kw * bf2f(v.y & 0xffffu), kw * bf2f(v.y >> 16));
                o.z = cvt_pk_bf16(kw * bf2f(v.z & 0xffffu), kw * bf2f(v.z >> 16)); o.w = cvt_pk_bf16(kw * bf2f(v.w & 0xffffu), kw * bf2f(v.w >> 16));
                *(LAS u32x4*)(L + SC_VW + row * 272 + cc * 16) = o; }
            __syncthreads();
            if (tid < 64) { const int t = tid; float qn = 0.f;
#pragma unroll
                for (int p = 0; p < 8; ++p) qn += qnp[p * 64 + t];
                const float den = sWi[t] * qn + ((rsp[t * 4 + 0] + rsp[t * 4 + 1]) + (rsp[t * 4 + 2] + rsp[t * 4 + 3]));
                sInv[t] = 1.0f / fmaxf(fabsf(den), sEi[t]); }
            f32x4 nacc[4];
#pragma unroll
            for (int tt = 0; tt < 4; ++tt) nacc[tt] = (f32x4){0.f, 0.f, 0.f, 0.f};
#pragma unroll
            for (int kk = 0; kk < 8; ++kk) {
                u32x4 bw; bw.x = cvt_pk_bf16(C[2 * kk][0], C[2 * kk][1]); bw.y = cvt_pk_bf16(C[2 * kk][2], C[2 * kk][3]); bw.z = cvt_pk_bf16(C[2 * kk + 1][0], C[2 * kk + 1][1]); bw.w = cvt_pk_bf16(C[2 * kk + 1][2], C[2 * kk + 1][3]);
                const bf16x8 bq = __builtin_bit_cast(bf16x8, bw);
#pragma unroll
                for (int tt = 0; tt < 4; ++tt) { const bf16x8 a = *(const LAS bf16x8*)(L + SC_QS + (16 * tt + fr) * 528 + (32 * kk + 8 * fq) * 2);
                    nacc[tt] = __builtin_amdgcn_mfma_f32_16x16x32_bf16(a, bq, nacc[tt], 0, 0, 0); }
            }
#pragma unroll
            for (int tt = 0; tt < 4; ++tt)
#pragma unroll
                for (int r = 0; r < 4; ++r) nacc[tt][r] *= sWi[16 * tt + 4 * fq + r];
#pragma unroll
            for (int kk = 0; kk < 2; ++kk) { const LAS unsigned char* vp = L + SC_VS + (32 * kk + 8 * fq + tq) * 272 + (16 * w + 4 * tp) * 2;
                const bf16x8 bv = cat8(tr16(vp), tr16(vp + 4 * 272));
#pragma unroll
                for (int tt = 0; tt < 4; ++tt) { const bf16x8 as = *(const LAS bf16x8*)(L + SC_SS + ((16 * tt + fr) * 72 + 32 * kk + 8 * fq) * 2);
                    nacc[tt] = __builtin_amdgcn_mfma_f32_16x16x32_bf16(as, bv, nacc[tt], 0, 0, 0); } }
            __syncthreads();
#pragma unroll
            for (int tt = 0; tt < 4; ++tt)
#pragma unroll
                for (int r = 0; r < 4; ++r) { const int t = 16 * tt + 4 * fq + r; const float hv = nacc[tt][r] * sInv[t];
                    *(LAS unsigned short*)(L + SC_HS + t * 272 + (16 * w + fr) * 2) = (unsigned short)cvt_pk_bf16(hv, hv);
                    ssp[w * 64 + t] = row_sum16(hv * hv); }
            const float aprev = scal[1];
#pragma unroll
            for (int i = 0; i < 16; ++i) C[i] *= aprev;
            f32x4 ninc0 = (f32x4){0.f, 0.f, 0.f, 0.f}, ninc1 = ninc0;
#pragma unroll
            for (int kk = 0; kk < 2; ++kk) { const LAS unsigned char* vp = L + SC_VW + (32 * kk + 8 * fq + tq) * 272 + (16 * w + 4 * tp) * 2;
                const bf16x8 bvw = cat8(tr16(vp), tr16(vp + 4 * 272));
                u32x4 kn; { const LAS float* kp = sKw + 32 * kk + 8 * fq; kn.x = cvt_pk_bf16(kp[0], kp[1]); kn.y = cvt_pk_bf16(kp[2], kp[3]); kn.z = cvt_pk_bf16(kp[4], kp[5]); kn.w = cvt_pk_bf16(kp[6], kp[7]); }
                const bf16x8 bn = __builtin_bit_cast(bf16x8, kn);
                const LAS unsigned char* kp0 = L + SC_KS + (32 * kk + 8 * fq + tq) * 528 + (8 * tp) * 2;
#pragma unroll
                for (int T = 0; T < 16; ++T) { const LAS unsigned char* kp = kp0 + (32 * (T >> 1) + 4 * (T & 1)) * 2;
                    const bf16x8 ak = cat8(tr16(kp), tr16(kp + 4 * 528));
                    C[T] = __builtin_amdgcn_mfma_f32_16x16x32_bf16(ak, bvw, C[T], 0, 0, 0); }
                { const LAS unsigned char* kp = kp0 + (32 * w) * 2; const bf16x8 a0 = cat8(tr16(kp), tr16(kp + 4 * 528)), a1 = cat8(tr16(kp + 8), tr16(kp + 8 + 4 * 528));
                    ninc0 = __builtin_amdgcn_mfma_f32_16x16x32_bf16(a0, bn, ninc0, 0, 0, 0); ninc1 = __builtin_amdgcn_mfma_f32_16x16x32_bf16(a1, bn, ninc1, 0, 0, 0); } }
            {
#pragma unroll
                for (int r = 0; r < 4; ++r) { const int d0 = 32 * w + 8 * fq + r; const float n0 = aprev * sn[d0] + ninc0[r], n1 = aprev * sn[d0 + 4] + ninc1[r]; sn[d0] = n0; sn[d0 + 4] = n1; } }
            if (cvon) cv_store(cvb, cv);
        }
    }
    __syncthreads();
#undef SC_LDQ
#undef SC_LDV
}

__device__ __forceinline__ void p3_headnorm(Frame& F, const Args& args) {
    const int gw = F.vcu * NWAVES + F.wave, NGW = F.G * NWAVES;
    for (int m = gw; m < M; m += NGW) {
        u32x4 hva[8], ova[8];
#pragma unroll
        for (int j = 0; j < 8; ++j) { const int col = 512 * j + 8 * F.lane; hva[j] = __builtin_nontemporal_load((const u32x4*)(WSP(bf16, WS_HB) + (size_t)m * D + col)); ova[j] = __builtin_nontemporal_load((const u32x4*)(WSP(bf16, WS_PROJ) + (size_t)m * NPROJ + 2 * QKW + VW + col)); }
#pragma unroll
        for (int j = 0; j < 8; ++j) {
            const f32x4 s4 = *(const f32x4*)(WSP(float, WS_SS) + (size_t)m * 32 + 4 * j); const float r = 1.0f / sqrtf(((s4[0] + s4[1]) + (s4[2] + s4[3])) * (1.f / DV) + EPS);
            const int col = 512 * j + 8 * F.lane;
            const u32x4 hv = hva[j]; const u32x4 ov = ova[j];
            const f32x4 g0 = *(const f32x4*)(args.in[5] + col), g1 = *(const f32x4*)(args.in[5] + col + 4);
            const unsigned hw[4] = {hv.x, hv.y, hv.z, hv.w}, ow[4] = {ov.x, ov.y, ov.z, ov.w}; const float gg[8] = {g0[0], g0[1], g0[2], g0[3], g1[0], g1[1], g1[2], g1[3]}; unsigned res[4];
#pragma unroll
            for (int q = 0; q < 4; ++q) { const float h0 = bf2f(hw[q] & 0xffffu), h1 = bf2f(hw[q] >> 16), o0 = bf2f(ow[q] & 0xffffu), o1 = bf2f(ow[q] >> 16);
                const float y0 = h0 * r * gg[2 * q] / (1.0f + __expf(-o0)), y1 = h1 * r * gg[2 * q + 1] / (1.0f + __expf(-o1)); res[q] = pk2(y0, y1); }
            *(u32x4*)(WSP(bf16, WS_XB) + (size_t)m * D + col) = (u32x4){res[0], res[1], res[2], res[3]};
        }
    }
}

__device__ __forceinline__ void rstd_to_lds(Frame& F, int pm) {
    __syncthreads();
    if (F.tid < 256) { const f32x4* p = (const f32x4*)(WSP(float, WS_RSS) + (size_t)(pm * 256 + F.tid) * 64); float s = 0.f;
#pragma unroll
        for (int j = 0; j < 16; ++j) { const f32x4 v = p[j]; s += (v[0] + v[1]) + (v[2] + v[3]); }
        ((LAS float*)(F.lds + RSTD_OFF))[F.tid] = 1.0f / sqrtf(s * (1.f / D) + EPS); }
    VM_WAIT(); LDS_WAIT();
    __syncthreads();
}

__device__ __forceinline__ void p6_fixup(Frame& F, int layer, bf16* __restrict__ GATED) {
    const int gt = F.vcu * (NWAVES * 64) + F.tid, NGT = F.G * NWAVES * 64;
    const float* __restrict__ cpl = WSP(float, WS_CONVP) + (size_t)layer * FT * 1024; const float* __restrict__ HALO = WSP(float, WS_HALO);
    for (int i = gt; i < 64 * FT * 128; i += NGT) { const int ci = i & 127, pn = (i >> 7) % FT, pm = i / (FT * 128); if ((pm & 7) == 0) continue;
        float hc[2][2];
#pragma unroll
        for (int bj = 0; bj < 2; ++bj) { const int col = 256 * pn + 128 * bj + ci; const float* cp = cpl + (size_t)pn * 1024 + 128 * bj + ci;
            const float w0 = cp[0], w1 = cp[256], w2 = cp[512], cb = cp[768];
            const float hm2 = HALO[((size_t)(pm - 1) * 4 + 2) * NFF1 + col], hm1 = HALO[((size_t)(pm - 1) * 4 + 3) * NFF1 + col], h0 = HALO[((size_t)pm * 4 + 0) * NFF1 + col], h1 = HALO[((size_t)pm * 4 + 1) * NFF1 + col];
            hc[bj][0] = cb + w0 * hm2 + w1 * hm1 + w2 * h0; hc[bj][1] = cb + w0 * hm1 + w1 * h0 + w2 * h1; }
#pragma unroll
        for (int rr = 0; rr < 2; ++rr) GATED[(size_t)(pm * 256 + rr) * KFF2 + 128 * pn + ci] = (bf16)f2bf(hc[0][rr] * hc[1][rr] * __builtin_amdgcn_rcpf(1.0f + __builtin_amdgcn_exp2f(hc[0][rr])));
    }
}

__device__ __forceinline__ f32x2 ld_bf2(const bf16* p) { const unsigned w = *(const unsigned*)p; return (f32x2){bf2f(w & 0xffffu), bf2f(w >> 16)}; }
template <int W> __device__ __forceinline__ void pool_cols(const bf16* xb, const LAS float* rs, const f32x2 g, bf16* ob, int tb) {
    f32x2 prev[16], cur[16]; unsigned raw[16];
#pragma unroll
    for (int i = 0; i < 16; ++i) { if (tb == 0) prev[i] = (f32x2){0.f, 0.f}; else prev[i] = ld_bf2(xb + (size_t)i * D) * rs[i] * g; }
#pragma unroll
    for (int i = 0; i < 16; ++i) raw[i] = *(const unsigned*)(xb + (size_t)(16 + i) * D);
#pragma unroll 1
    for (int blk = 0; blk < 4; ++blk) {
#pragma unroll
        for (int i = 0; i < 16; ++i) cur[i] = (f32x2){bf2f(raw[i] & 0xffffu), bf2f(raw[i] >> 16)} * rs[16 + 16 * blk + i] * g;
        if (blk < 3) {
#pragma unroll
            for (int i = 0; i < 16; ++i) raw[i] = *(const unsigned*)(xb + (size_t)(32 + 16 * blk + i) * D); }
#pragma unroll
        for (int i = 0; i < 16; ++i) { f32x2 s = cur[i];
#pragma unroll
            for (int j = 1; j < W; ++j) s += (i - j >= 0) ? cur[(i - j) & 15] : prev[(16 + i - j) & 15];
            const int t = 64 * tb + 16 * blk + i; const float inv = 1.0f / (float)((t + 1) < W ? (t + 1) : W);
            const f32x2 o = s * inv - cur[i];
            *(unsigned*)(ob + (size_t)(16 * blk + i) * D) = pk2(o[0], o[1]); }
#pragma unroll
        for (int i = 0; i < 16; ++i) prev[i] = cur[i];
    }
}
__device__ __forceinline__ void p8_pool(Frame& F, const Args& args) {
    LAS float* rs = (LAS float*)(F.lds);
    for (int item = F.vcu; item < 256; item += F.G) {
        const int b = item >> 5, tb = item & 31; const size_t r0 = (size_t)b * SEQ + 64 * tb;
        __syncthreads();
        if (F.tid < 80) { float v = 0.f; if (tb > 0 || F.tid >= 16) { const f32x4* p = (const f32x4*)(WSP(float, WS_RSS) + (r0 - 16 + F.tid) * 64); float s = 0.f;
#pragma unroll
                for (int j = 0; j < 16; ++j) { const f32x4 q = p[j]; s += (q[0] + q[1]) + (q[2] + q[3]); }
                v = 1.0f / sqrtf(s * (1.f / D) + EPS); }
            rs[F.tid] = v; }
        __syncthreads();
#pragma unroll 1
        for (int part = 0; part < 4; ++part) { const int q = F.tid + 512 * part, col = 2 * q, grp = part;
            const f32x2 g = *(const f32x2*)(args.in[7] + col); const bf16* xb = WSP(bf16, WS_XA) + (r0 - 16) * D + col; bf16* ob = WSP(bf16, WS_XB) + r0 * D + col;
            if (grp == 0) pool_cols<2>(xb, rs, g, ob, tb); else if (grp == 1) pool_cols<4>(xb, rs, g, ob, tb); else if (grp == 2) pool_cols<8>(xb, rs, g, ob, tb); else pool_cols<16>(xb, rs, g, ob, tb); }
    }
    __syncthreads();
}

__device__ __forceinline__ void p13_final(Frame& F, const Args& args) {
    const int gw = F.vcu * NWAVES + F.wave, NGW = F.G * NWAVES;
    for (int m = gw; m < M; m += NGW) {
        const float rstd = 1.0f / sqrtf(wave_sum(WSP(float, WS_RSS)[(size_t)m * 64 + F.lane]) * (1.f / D) + EPS);
        const u32x4* xr = (const u32x4*)(WSP(bf16, WS_XA) + (size_t)m * D) + F.lane; f32x4* orow = (f32x4*)(F.out + (size_t)m * D) + 2 * F.lane; const f32x4* gr = (const f32x4*)args.in[15] + 2 * F.lane;
        u32x4 xw[8];
#pragma unroll
        for (int j = 0; j < 8; ++j) xw[j] = __builtin_nontemporal_load(xr + 64 * j);
#pragma unroll
        for (int j = 0; j < 8; ++j) { const u32x4 w = xw[j]; const f32x4 g0 = gr[128 * j], g1 = gr[128 * j + 1];
            __builtin_nontemporal_store((f32x4){bf2f(w.x & 0xffffu), bf2f(w.x >> 16), bf2f(w.y & 0xffffu), bf2f(w.y >> 16)} * rstd * g0, orow + 128 * j);
            __builtin_nontemporal_store((f32x4){bf2f(w.z & 0xffffu), bf2f(w.z >> 16), bf2f(w.w & 0xffffu), bf2f(w.w >> 16)} * rstd * g1, orow + 128 * j + 1); }
    }
}

__global__ void __launch_bounds__(NWAVES * 64, 2) fwd(Args args) {
    extern __shared__ __attribute__((aligned(16))) unsigned char lds[];
    Frame F;
    F.lds = (LAS unsigned char*)lds;
    F.tid = threadIdx.x; F.lane = F.tid & 63; F.wave = __builtin_amdgcn_readfirstlane(F.tid >> 6);
    F.G = gridDim.x; { const int bx = blockIdx.x; F.vcu = (F.G % 8 == 0) ? (bx % 8) * (F.G / 8) + bx / 8 : bx; }
    unsigned char* ws = args.ws; F.ws = ws; F.out = args.out;
    gu32* ctl = (gu32*)(ws + WS_CTL);
    for (int u = F.tid; u < (LDS_BYTES - LDSCTL_OFF) / 4; u += NWAVES * 64) ((LAS unsigned*)(F.lds + LDSCTL_OFF))[u] = 0u;
    __syncthreads();
    XcdBarrier bar; bar.bar = (unsigned*)(ctl + CW_BAR); bar.x = 0; bar.st = nullptr;
    if (MK_N_LAUNCHES == 1) bar = xcd_barrier_post((unsigned*)(ctl + CW_BAR), (volatile LAS unsigned*)(F.lds + MISC_OFF));
#define GRID_BAR() do { if (MK_N_LAUNCHES == 1) xcd_barrier(bar); } while (0)
    const int lo = args.ph_lo, hi = args.ph_hi;
#ifndef PHASE_MASK
#define PHASE_MASK 0x3fff
#endif
#define IN(k) ((((PHASE_MASK) >> (k)) & 1) && lo <= (k) && (k) < hi)
#define BOTH(k) (IN(k) && IN((k) + 1))
    bf16* GATED = WSP(bf16, WS_PROJ);
    const int c = (int)blockIdx.x;

    if (IN(0)) { p0_prologue(F, args); if (BOTH(0)) GRID_BAR(); }
    if (IN(1)) {
        pg8::Gemm g{WSP(bf16, WS_XA), WSP(bf16, WS_WP), D, D, D, 0, 0}; pg8::RowOrder S; S.init(NPROJ / 256, c);
        pg8::EpiProj E{WSP(bf16, WS_PROJ), NPROJ};
        pg8::gemm_phase(F.lds + RING_OFF, g, S, E);
        p1_gates(F, args);
        if (BOTH(1)) GRID_BAR();
    }
    if (IN(2)) { p2_scan(F, args); if (BOTH(2)) GRID_BAR(); }
    if (IN(3)) { p3_headnorm(F, args); if (BOTH(3)) GRID_BAR(); }
    if (IN(4)) {
        pg8::Gemm g{WSP(bf16, WS_XB), WSP(bf16, WS_WO), D, D, D, 0, 0}; pg8::RowOrder S; S.init(D / 256, c);
        pg8::EpiResid<true> E{args.in[0], nullptr, nullptr, WSP(bf16, WS_XA), args.in[10], WSP(float, WS_RSS)};
        pg8::gemm_phase(F.lds + RING_OFF, g, S, E);
        if (BOTH(4)) GRID_BAR();
    }
    if (IN(5)) {
        pg8::Gemm g{WSP(bf16, WS_XA), WSP(bf16, WS_W1), D, D, D, 0, 0}; pg8::RowOrder S; S.init(FT - 2, c);
        rstd_to_lds(F, S.pm);
        float* part = WSP(float, WS_PART) + (size_t)(c & 127) * 65536; unsigned* sflag = (unsigned*)(ctl + CW_SPLIT + 64 * (c & 127));
        { pg8::EpiFfn1T<0> E{GATED, WSP(float, WS_CONVP), WSP(float, WS_HALO), F.lds, part, sflag, 1u};
          pg8::gemm_phase(F.lds + RING_OFF, g, S, E); }
        pg8::TailOrder T; T.init(c);
        if (T.pn0 < 2) { pg8::EpiFfn1T<1> E{GATED, WSP(float, WS_CONVP), WSP(float, WS_HALO), F.lds, part, sflag, 1u}; pg8::gemm_phase(F.lds + RING_OFF, g, T, E); }
        else { pg8::EpiFfn1T<2> E{GATED, WSP(float, WS_CONVP), WSP(float, WS_HALO), F.lds, part, sflag, 1u}; pg8::gemm_phase(F.lds + RING_OFF, g, T, E); }
        if (BOTH(5)) GRID_BAR();
    }
    if (IN(6)) { p6_fixup(F, 0, GATED); if (BOTH(6)) GRID_BAR(); }
    if (IN(7)) {
        pg8::Gemm g{GATED, WSP(bf16, WS_W2), KFF2, KFF2, KFF2, 0, 0}; pg8::WideOrder S; S.init(D / 256, c);
        pg8::EpiResid<false> E{WSP(bf16, WS_XA), args.in[10], nullptr, WSP(bf16, WS_XA), nullptr, WSP(float, WS_RSS)};
        pg8::gemm_phase(F.lds + RING_OFF, g, S, E);
        if (BOTH(7)) GRID_BAR();
    }
    if (IN(8)) { p8_pool(F, args); if (BOTH(8)) GRID_BAR(); }
    if (IN(9)) {
        pg8::Gemm g{WSP(bf16, WS_XB), WSP(bf16, WS_WPOOL), D, 1024, 1024, 2, 1024}; pg8::RowOrder S; S.init(D / 256, c);
        pg8::EpiResid<false> E{WSP(bf16, WS_XA), nullptr, args.in[9], WSP(bf16, WS_XA), args.in[10] + D, WSP(float, WS_RSS)};
        pg8::gemm_phase(F.lds + RING_OFF, g, S, E);
        if (BOTH(9)) GRID_BAR();
    }
    if (IN(10)) {
        pg8::Gemm g{WSP(bf16, WS_XA), WSP(bf16, WS_W1) + (size_t)NFF1 * D, D, D, D, 0, 0}; pg8::RowOrder S; S.init(FT - 2, c);
        rstd_to_lds(F, S.pm);
        float* part = WSP(float, WS_PART) + (size_t)(c & 127) * 65536; unsigned* sflag = (unsigned*)(ctl + CW_SPLIT + 64 * (c & 127));
        { pg8::EpiFfn1T<0> E{GATED, WSP(float, WS_CONVP) + (size_t)FT * 1024, WSP(float, WS_HALO), F.lds, part, sflag, 2u};
          pg8::gemm_phase(F.lds + RING_OFF, g, S, E); }
        pg8::TailOrder T; T.init(c);
        if (T.pn0 < 2) { pg8::EpiFfn1T<1> E{GATED, WSP(float, WS_CONVP) + (size_t)FT * 1024, WSP(float, WS_HALO), F.lds, part, sflag, 2u}; pg8::gemm_phase(F.lds + RING_OFF, g, T, E); }
        else { pg8::EpiFfn1T<2> E{GATED, WSP(float, WS_CONVP) + (size_t)FT * 1024, WSP(float, WS_HALO), F.lds, part, sflag, 2u}; pg8::gemm_phase(F.lds + RING_OFF, g, T, E); }
        if (BOTH(10)) GRID_BAR();
    }
    if (IN(11)) { p6_fixup(F, 1, GATED); if (BOTH(11)) GRID_BAR(); }
    if (IN(12)) {
        pg8::Gemm g{GATED, WSP(bf16, WS_W2) + (size_t)D * KFF2, KFF2, KFF2, KFF2, 0, 0}; pg8::WideOrder S; S.init(D / 256, c);
        pg8::EpiResid<false> E{WSP(bf16, WS_XA), args.in[10] + D, nullptr, WSP(bf16, WS_XA), nullptr, WSP(float, WS_RSS)};
        pg8::gemm_phase(F.lds + RING_OFF, g, S, E);
        if (BOTH(12)) GRID_BAR();
    }
    if (IN(13)) { p13_final(F, args); }
#undef IN
#undef BOTH
}

extern "C" void kernel_launch(void* const* d_in, const int* in_sizes, int n_in, void* d_out, int out_size, void* d_ws, size_t ws_size, hipStream_t stream) {
    static int grid = 0;
    if (grid == 0) {
        if (n_in != 16 || out_size != M * D || ws_size < WS_END2) { fprintf(stderr, "kernel_launch: unexpected shapes (n_in %d, out %d, ws %zu, need %zu)\n", n_in, out_size, ws_size, (size_t)WS_END2); grid = -1; return; }
        if (hipFuncSetAttribute((const void*)fwd, hipFuncAttributeMaxDynamicSharedMemorySize, LDS_BYTES) != hipSuccess) { fprintf(stderr, "kernel_launch: hipFuncSetAttribute failed\n"); grid = -1; return; }
        int per_cu = 0;
        if (hipOccupancyMaxActiveBlocksPerMultiprocessor(&per_cu, (const void*)fwd, NWAVES * 64, LDS_BYTES) != hipSuccess || per_cu < 1) fprintf(stderr, "kernel_launch: occupancy query reports %d\n", per_cu);
        (void)hipGetLastError();
        grid = 256;
    }
    if (grid < 0) return;
    (void)hipMemsetAsync((char*)d_ws + WS_CTL, 0, CTL_ZERO_BYTES, stream);
    Args a{};
    for (int i = 0; i < 16; ++i) a.in[i] = (const float*)d_in[i];
    a.out = (float*)d_out; a.ws = (unsigned char*)d_ws;
    if (MK_N_LAUNCHES == 1) { a.ph_lo = 0; a.ph_hi = NPHASE; a.li = 0; hipLaunchKernelGGL(fwd, dim3(grid), dim3(NWAVES * 64), LDS_BYTES, stream, a); }
    else for (int p = 0; p < NPHASE; ++p) { a.ph_lo = p; a.ph_hi = p + 1; a.li = p; hipLaunchKernelGGL(fwd, dim3(grid), dim3(NWAVES * 64), LDS_BYTES, stream, a); }
}
```

```cpp
#include <hip/hip_runtime.h>
#include <cstdio>
#include <cstdint>

#ifndef MK_N_LAUNCHES
#define MK_N_LAUNCHES 1
#endif

#define GAS __attribute__((address_space(1)))
#define LAS __attribute__((address_space(3)))
typedef unsigned short bf16;
typedef short bf16x8 __attribute__((ext_vector_type(8)));
typedef short bf16x4 __attribute__((ext_vector_type(4)));
typedef float f32x4 __attribute__((ext_vector_type(4)));
typedef float f32x2 __attribute__((ext_vector_type(2)));
typedef unsigned u32x4 __attribute__((ext_vector_type(4)));
typedef unsigned u32x2 __attribute__((ext_vector_type(2)));
typedef GAS unsigned gu32;

constexpr int D = 4096, BATCH = 8, SEQ = 2048, M = BATCH * SEQ;
constexpr int NH = 8, DQK = 256, DV = 512, QKW = 2048, VW = 4096;
constexpr int NPROJ = 12288, PROJ_W = 12304;
constexpr int DFF = 10944, DFF2 = 21888, FT = 86, NFF1 = FT * 256  , KFF2 = FT * 128  ;
constexpr float EPS = 1e-6f;
constexpr int NPHASE = 14;

constexpr size_t MiB = 1u << 20;
constexpr size_t WS_CTL = 0, CTL_ZERO_BYTES = 131072;
constexpr size_t WS_WP = 2 * MiB;
constexpr size_t WS_WG = WS_WP + (size_t)NPROJ * D * 2;
constexpr size_t WS_WO = WS_WG + 1 * MiB;
constexpr size_t WS_W1 = WS_WO + (size_t)D * D * 2;
constexpr size_t WS_W2 = WS_W1 + 2 * (size_t)NFF1 * D * 2;
constexpr size_t WS_WPOOL = WS_W2 + 2 * (size_t)D * KFF2 * 2;
constexpr size_t WS_CONVP = WS_WPOOL + 4 * (size_t)1024 * 1024 * 2;
constexpr size_t WS_XA = WS_CONVP + 1 * MiB;
constexpr size_t WS_XB = WS_XA + (size_t)M * D * 2;
constexpr size_t WS_PROJ = WS_XB + (size_t)M * D * 2;
constexpr size_t WS_HB = WS_PROJ + (size_t)M * NPROJ * 2;
constexpr size_t WS_SS = WS_HB + (size_t)M * D * 2;
constexpr size_t WS_GATES = WS_SS + (size_t)M * 32 * 4;
constexpr size_t WS_RSS = WS_GATES + (size_t)M * 16 * 4;
constexpr size_t WS_HALO = WS_RSS + (size_t)M * 64 * 4;
constexpr size_t WS_END = WS_HALO + (size_t)64 * 4 * NFF1 * 4;
constexpr size_t WS_PART = WS_END, WS_END2 = WS_PART + (size_t)128 * 65536 * 4;
static_assert((size_t)M * KFF2 * 2 <= (size_t)M * NPROJ * 2, "GATED overlays PROJ");

constexpr int CW_TMO = 0, CW_BAR = 4096, CW_SPLIT = 8192;
static_assert((CW_BAR + 3456) <= CW_SPLIT && (CW_SPLIT + 64 * 128) * 4 <= (int)CTL_ZERO_BYTES, "control words inside the memset region");

constexpr int RING_OFF = 0, RING_BYTES = 131072;
constexpr int RSTD_OFF = 131072;
constexpr int CONVP_OFF = RSTD_OFF + 1024;
constexpr int EXCH_OFF = CONVP_OFF + 8192;
constexpr int LDSCTL_OFF = EXCH_OFF + 8192;
constexpr int MISC_OFF = LDSCTL_OFF + 64;
constexpr int LDS_BYTES = LDSCTL_OFF + 512;
static_assert(LDS_BYTES <= 160 * 1024, "LDS");

#define RLX_AGENT __ATOMIC_RELAXED, __HIP_MEMORY_SCOPE_AGENT
#define LDS_WAIT() asm volatile("s_waitcnt lgkmcnt(0)" ::: "memory")
#define VM_WAIT() asm volatile("s_waitcnt vmcnt(0)" ::: "memory")
__device__ __forceinline__ unsigned f2bf(float f) { unsigned u = __builtin_bit_cast(unsigned, f); return (u + 0x7fffu + ((u >> 16) & 1u)) >> 16; }
__device__ __forceinline__ unsigned pk2(float lo, float hi) { return f2bf(lo) | (f2bf(hi) << 16); }
__device__ __forceinline__ float bf2f(unsigned b) { return __builtin_bit_cast(float, b << 16); }
__device__ __forceinline__ unsigned cvt_pk_bf16(float lo, float hi) { unsigned r; asm volatile("v_cvt_pk_bf16_f32 %0, %1, %2" : "=v"(r) : "v"(lo), "v"(hi)); return r; }

#ifndef PG8_BAL
#define PG8_BAL 1
#endif
#ifndef PG8_LOADPRIO
#define PG8_LOADPRIO 3
#endif
namespace pg8 {
constexpr int BM = 256, BK = 64, HALF = 128, HTB = HALF * BK * 2, STAGE_BYTES = 8 * HTB;
__host__ __device__ __forceinline__ int lds_byte(int r, int c) { const int st = (r >> 4) * 2 + (c >> 5), rr = r & 15, cc = c & 31, ob = rr * 64 + cc * 2; return st * 1024 + (ob ^ (((ob >> 9) & 1) << 5)); }
__host__ __device__ __forceinline__ void stage_rc(int b, int& R, int& C) { const int st = b / 1024, sb = b % 1024, swz = sb ^ (((sb >> 9) & 1) << 5); R = (st >> 1) * 16 + swz / 64; C = (st & 1) * 32 + (swz % 64) / 2; }
__host__ __device__ __forceinline__ int perm32(int rho) { const int n = rho >> 4, i = rho & 15; return 8 * (i >> 2) + 4 * n + (i & 3); }

struct Unit { int pm, pn; int kt0, nkt; };
struct Gemm { const bf16* A; const bf16* Bt; int lda, ldb, K; int agrp_shift, agrp_stride; };

struct RowOrder {
    static constexpr bool SPLIT = false;
    int pm, pn0, nN;
    __device__ __forceinline__ void init(int nN_, int c) { const int x = c & 7, j = c >> 3; pm = 8 * x + (j & 7); pn0 = j >> 3; nN = nN_; }
    __device__ __forceinline__ bool next(int i, Unit& u) const { const int pn = 4 * i + pn0; u.pm = pm; u.pn = pn; return pn < nN; }
};

struct WideOrder {
    static constexpr bool SPLIT = false;
    int x, j;
    __device__ __forceinline__ void init(int, int c) { x = c & 7; j = c >> 3; }
    __device__ __forceinline__ bool next(int i, Unit& u) const { u.pm = 8 * x + 4 * (i >> 1) + (j & 3); u.pn = 8 * (i & 1) + (j >> 2); return i < 4; }
};
struct TailOrder {
    static constexpr bool SPLIT = true;
    int pm, pn0;
    __device__ __forceinline__ void init(int c) { const int x = c & 7, j = c >> 3; pm = 8 * x + (j & 7); pn0 = j >> 3; }
    __device__ __forceinline__ bool next(int i, Unit& u) const { u.pm = pm; u.pn = 84 + (pn0 & 1); u.kt0 = pn0 < 2 ? 0 : 32; u.nkt = 32; return i == 0; }
};
template <class Epi, class Sched, int PV = 0>
__device__ __forceinline__ void gemm_phase(LAS unsigned char* lds, const Gemm g, const Sched& S, Epi& E) {
    const int tid = threadIdx.x, wid = __builtin_amdgcn_readfirstlane(tid >> 6), lane = tid & 63, wr = wid >> 2, wc = wid & 3, fr = lane & 15, fq = lane >> 4;
    int nt = g.K / BK;
    const unsigned kstep = (unsigned)(BK * 2);
    const unsigned hstepA = (unsigned)HALF * g.lda * 2, hstepB = (unsigned)HALF * g.ldb * 2;
    unsigned voffA0[2], voffB0[2];
#pragma unroll
    for (int i = 0; i < 2; ++i) { int R, C; stage_rc(tid * 16 + i * 8192, R, C); const int Rb = Epi::PERM ? ((R & ~31) + perm32(R & 31)) : R;
        const int Ra = Epi::APERM ? ((R & 64) + 4 * (R & 15) + ((R >> 4) & 3)) : R;
        voffA0[i] = (unsigned)(Ra * g.lda + C) * 2u; voffB0[i] = (unsigned)(Rb * g.ldb + C) * 2u; }
    const __amdgpu_buffer_rsrc_t rsA = __builtin_amdgcn_make_buffer_rsrc((void*)g.A, 0, 0x7fffffff, 0x00020000), rsB = __builtin_amdgcn_make_buffer_rsrc((void*)g.Bt, 0, 0x7fffffff, 0x00020000);
    const unsigned ldsw = (unsigned)wid * 1024u;
    const int aoff = lds_byte(wr * 64 + fr, fq * 8), boff = lds_byte(wc * 32 + fr, fq * 8);
#define PG8_SA(b, h) (((b) * 2 + (h)) * HTB)
#define PG8_SB(b, h) ((4 + (b) * 2 + (h)) * HTB)
#define PG8_STAGE(rs, bufoff, off, voff) do { _Pragma("unroll") for (int _i = 0; _i < 2; ++_i) \
        __builtin_amdgcn_raw_ptr_buffer_load_lds(rs, (LAS void*)(lds + (bufoff) + ldsw + _i * 8192), 16, (voff)[_i], (unsigned)(off), 0, 0); } while (0)
#define PG8_LDA(dst, b, h) do { _Pragma("unroll") for (int m = 0; m < 4; ++m) _Pragma("unroll") for (int k = 0; k < 2; ++k) dst[m][k] = *(const LAS bf16x8*)(lds + PG8_SA(b, h) + aoff + m * 2048 + k * 1024); } while (0)
#define PG8_LDB(dst, b, h) do { _Pragma("unroll") for (int n = 0; n < 2; ++n) _Pragma("unroll") for (int k = 0; k < 2; ++k) dst[n][k] = *(const LAS bf16x8*)(lds + PG8_SB(b, h) + boff + n * 2048 + k * 1024); } while (0)
#define PG8_CH(bj, Bf, m, n) do { _Pragma("unroll") for (int k = 0; k < 2; ++k) acc[ai_][bj][m][n] = __builtin_amdgcn_mfma_f32_16x16x32_bf16(Bf[n][k], At[m][k], acc[ai_][bj][m][n], 0, 0, 0); __builtin_amdgcn_sched_barrier(0); } while (0)
#define PG8_MMA2(ai, B0) do { constexpr int ai_ = ai; __builtin_amdgcn_s_setprio(1); \
          \
        PG8_CH(0, B0, 0, 0); PG8_CH(0, B0, 0, 1); PG8_CH(1, B1, 0, 0); PG8_CH(1, B1, 0, 1); \
        PG8_CH(1, B1, 1, 1); PG8_CH(1, B1, 1, 0); PG8_CH(0, B0, 1, 1); PG8_CH(0, B0, 1, 0); \
        PG8_CH(0, B0, 2, 0); PG8_CH(0, B0, 2, 1); PG8_CH(1, B1, 2, 0); PG8_CH(1, B1, 2, 1); \
        PG8_CH(1, B1, 3, 1); PG8_CH(1, B1, 3, 0); PG8_CH(0, B0, 3, 1); PG8_CH(0, B0, 3, 0); \
        __builtin_amdgcn_s_setprio(PG8_LOADPRIO); } while (0)
#define PG8_WAIT_V(n) asm volatile("s_waitcnt vmcnt(" #n ")" ::: "memory")
#define PG8_WAIT_VL(n) __builtin_amdgcn_s_waitcnt(0x0070 | (n))
#define PG8_BAR __builtin_amdgcn_s_barrier()
#define PG8_SCHED __builtin_amdgcn_sched_barrier(0)
#define PG8_ITER(oA1, oA2, oB2, oB3, lastrd) do { \
            PG8_LDB(B1, 0, 1); PG8_SCHED; PG8_LDA(At, 0, 0); PG8_STAGE(rsA, PG8_SA(1, 0), oA1, voffA0); PG8_STAGE(rsA, PG8_SA(1, 1), (oA1) + hstepA, voffA0); \
            PG8_WAIT_VL(6); PG8_BAR; PG8_MMA2(0, B0e); PG8_BAR; PG8_SCHED; \
            PG8_LDA(At, 0, 1); PG8_LDB(B0o, 1, 0); PG8_STAGE(rsB, PG8_SB(0, 0), oB2, voffB0); PG8_STAGE(rsB, PG8_SB(0, 1), (oB2) + hstepB, voffB0); \
            PG8_WAIT_VL(6); PG8_BAR; PG8_MMA2(1, B0e); PG8_BAR; PG8_SCHED; \
            PG8_LDB(B1, 1, 1); PG8_SCHED; PG8_LDA(At, 1, 0); PG8_STAGE(rsA, PG8_SA(0, 0), oA2, voffA0); PG8_STAGE(rsA, PG8_SA(0, 1), (oA2) + hstepA, voffA0); \
            PG8_WAIT_VL(6); PG8_BAR; PG8_MMA2(0, B0o); PG8_BAR; PG8_SCHED; \
            PG8_LDA(At, 1, 1); if (lastrd) { PG8_LDB(B0e, 0, 0); } PG8_STAGE(rsB, PG8_SB(1, 0), oB3, voffB0); PG8_STAGE(rsB, PG8_SB(1, 1), (oB3) + hstepB, voffB0); \
            PG8_WAIT_VL(6); PG8_BAR; PG8_MMA2(1, B0o); PG8_BAR; PG8_SCHED; } while (0)
    Unit cur, nxt; int ui = 0;
    if (!S.next(0, cur)) return;
    f32x4 acc[2][2][4][2];
#pragma unroll
    for (int a = 0; a < 2; ++a)
#pragma unroll
        for (int b = 0; b < 2; ++b)
#pragma unroll
            for (int m = 0; m < 4; ++m)
#pragma unroll
                for (int n = 0; n < 2; ++n) acc[a][b][m][n] = (f32x4){0.f, 0.f, 0.f, 0.f};
    bf16x8 At[4][2], B0e[2][2], B0o[2][2], B1[2][2];
    unsigned cA = (unsigned)cur.pm * 2 * hstepA + (unsigned)((cur.pn >> g.agrp_shift) * g.agrp_stride) * 2; unsigned cB = (unsigned)cur.pn * 2 * hstepB;
    if constexpr (Sched::SPLIT) { nt = cur.nkt; cA += (unsigned)cur.kt0 * kstep; cB += (unsigned)cur.kt0 * kstep; }
    E.unit_begin(cur, 0, wid, lane);
    PG8_STAGE(rsB, PG8_SB(0, 0), cB, voffB0); PG8_STAGE(rsB, PG8_SB(0, 1), cB + hstepB, voffB0); PG8_STAGE(rsA, PG8_SA(0, 0), cA, voffA0); PG8_STAGE(rsA, PG8_SA(0, 1), cA + hstepA, voffA0);
    if (wr == 1) PG8_BAR;
    PG8_STAGE(rsB, PG8_SB(1, 0), cB + kstep, voffB0); PG8_STAGE(rsB, PG8_SB(1, 1), cB + kstep + hstepB, voffB0);
    PG8_WAIT_V(6); PG8_BAR; PG8_BAR;
    PG8_LDB(B0e, 0, 0);
    for (;;) {
        const bool has_next = S.next(ui + 1, nxt);
        unsigned nko = 0; if constexpr (Sched::SPLIT) nko = has_next ? (unsigned)nxt.kt0 * kstep : 0;
        const unsigned nA = has_next ? (unsigned)nxt.pm * 2 * hstepA + (unsigned)((nxt.pn >> g.agrp_shift) * g.agrp_stride) * 2 + nko : cA; const unsigned nB = has_next ? (unsigned)nxt.pn * 2 * hstepB + nko : cB;
        unsigned oA = cA + kstep, oB = cB + 2 * kstep;
        for (int t = 0; t < nt; t += 2) {
            const bool last = (t == nt - 2);
            const unsigned a2 = last ? nA : oA + kstep, b2 = last ? nB : oB;
            PG8_ITER(oA, a2, b2, b2 + kstep, !last); oA += 2 * kstep; oB += 2 * kstep; }
        if (wr == 0) PG8_BAR;
        E(acc, cur, ui, wr, wc, fr, fq);
        if (!has_next) break;
        { f32x2 z2 = (f32x2){0.f, 0.f}; asm volatile("" : "+v"(z2));
#pragma unroll
        for (int a = 0; a < 2; ++a)
#pragma unroll
            for (int b = 0; b < 2; ++b)
#pragma unroll
                for (int m = 0; m < 4; ++m)
#pragma unroll
                    for (int n = 0; n < 2; ++n) acc[a][b][m][n] = __builtin_shufflevector(z2, z2, 0, 1, 0, 1); }
        cur = nxt; cA = nA; cB = nB; ++ui; if constexpr (Sched::SPLIT) nt = cur.nkt;
        if (wr == 1) PG8_BAR;
        E.unit_begin(cur, ui, wid, lane);
        PG8_LDB(B0e, 0, 0);
    }
    PG8_WAIT_V(0);
    PG8_BAR;
#undef PG8_SA
#undef PG8_SB
#undef PG8_STAGE
#undef PG8_LDA
#undef PG8_LDB
#undef PG8_MMA2
#undef PG8_CH
#undef PG8_WAIT_V
#undef PG8_WAIT_VL
#undef PG8_BAR
#undef PG8_SCHED
#undef PG8_ITER
}

struct EpiProj {
    static constexpr bool PERM = true, APERM = false;
    bf16* O; int ldc;
    __device__ __forceinline__ void unit_begin(const Unit&, int, int, int) const {}
    __device__ __forceinline__ void operator()(const f32x4 (&acc)[2][2][4][2], const Unit& u, int, int wr, int wc, int fr, int fq) const {
        asm volatile("" : "+v"(fr), "+v"(fq));
        const int row0 = u.pm * BM + wr * 64 + fr, col0 = u.pn * BM + wc * 32 + 8 * fq; const float sc = u.pn < 8 ? 0.0625f : 1.f;
#pragma unroll
        for (int ai = 0; ai < 2; ++ai)
#pragma unroll
            for (int m = 0; m < 4; ++m) { bf16* rowp = O + (size_t)(row0 + ai * HALF + m * 16) * ldc + col0;
#pragma unroll
                for (int bj = 0; bj < 2; ++bj) { const f32x4 v0 = acc[ai][bj][m][0] * sc, v1 = acc[ai][bj][m][1] * sc;
                    u32x4 w; w.x = cvt_pk_bf16(v0[0], v0[1]); w.y = cvt_pk_bf16(v0[2], v0[3]); w.z = cvt_pk_bf16(v1[0], v1[1]); w.w = cvt_pk_bf16(v1[2], v1[3]);
                    *(u32x4*)(rowp + bj * HALF) = w; } }
    }
};

struct EpiNull {
    static constexpr bool PERM = false, APERM = false;
    __device__ __forceinline__ void unit_begin(const Unit&, int, int, int) const {}
    __device__ __forceinline__ void operator()(const f32x4 (&acc)[2][2][4][2], const Unit&, int, int, int, int, int) const {
#pragma unroll
        for (int ai = 0; ai < 2; ++ai)
#pragma unroll
            for (int bj = 0; bj < 2; ++bj)
#pragma unroll
                for (int m = 0; m < 4; ++m)
#pragma unroll
                    for (int n = 0; n < 2; ++n) asm volatile("" :: "v"(acc[ai][bj][m][n]));
    }
};
template <bool BASE_F32> struct EpiResid {
    static constexpr bool PERM = true, APERM = false;
    const void* base; const float* ginv_src; const float* colscale; bf16* O; const float* gA; float* rss;
    __device__ __forceinline__ void unit_begin(const Unit&, int, int, int) const {}
    __device__ __forceinline__ void operator()(const f32x4 (&acc)[2][2][4][2], const Unit& u, int, int wr, int wc, int fr, int fq) const {
        asm volatile("" : "+v"(fr), "+v"(fq));
        const int row0 = u.pm * BM + wr * 64 + fr, col0 = u.pn * BM + wc * 32 + 8 * fq;
        f32x4 cs[2][2], gv[2][2], gi[2][2];
#pragma unroll
        for (int bj = 0; bj < 2; ++bj)
#pragma unroll
            for (int n = 0; n < 2; ++n) { const int cc = col0 + bj * HALF + 4 * n;
                cs[bj][n] = colscale ? *(const f32x4*)(colscale + cc) : (f32x4){1.f, 1.f, 1.f, 1.f};
                gv[bj][n] = gA ? *(const f32x4*)(gA + cc) : (f32x4){1.f, 1.f, 1.f, 1.f};
                if (ginv_src) { const f32x4 t = *(const f32x4*)(ginv_src + cc); gi[bj][n] = (f32x4){1.0f / t[0], 1.0f / t[1], 1.0f / t[2], 1.0f / t[3]}; } else gi[bj][n] = (f32x4){1.f, 1.f, 1.f, 1.f}; }
#pragma unroll
        for (int ai = 0; ai < 2; ++ai) {
            f32x4 pb[4][2][2]; u32x4 pw[4][2];
#pragma unroll
            for (int m = 0; m < 4; ++m) { const size_t off = (size_t)(row0 + ai * HALF + m * 16) * D + col0;
#pragma unroll
                for (int bj = 0; bj < 2; ++bj) {
                    if (BASE_F32) { pb[m][bj][0] = __builtin_nontemporal_load((const f32x4*)((const float*)base + off + bj * HALF)); pb[m][bj][1] = __builtin_nontemporal_load((const f32x4*)((const float*)base + off + bj * HALF + 4)); }
                    else pw[m][bj] = *(const u32x4*)((const bf16*)base + off + bj * HALF); } }
#pragma unroll
            for (int m = 0; m < 4; ++m) { const int r = row0 + ai * HALF + m * 16; const size_t off = (size_t)r * D + col0; float ss = 0.f;
#pragma unroll
                for (int bj = 0; bj < 2; ++bj) { f32x4 b0, b1;
                    if (BASE_F32) { b0 = pb[m][bj][0]; b1 = pb[m][bj][1]; }
                    else { const u32x4 w = pw[m][bj];
                        b0 = (f32x4){bf2f(w.x & 0xffffu), bf2f(w.x >> 16), bf2f(w.y & 0xffffu), bf2f(w.y >> 16)}; b1 = (f32x4){bf2f(w.z & 0xffffu), bf2f(w.z >> 16), bf2f(w.w & 0xffffu), bf2f(w.w >> 16)}; }
                    const f32x4 v0 = b0 * gi[bj][0] + acc[ai][bj][m][0] * cs[bj][0], v1 = b1 * gi[bj][1] + acc[ai][bj][m][1] * cs[bj][1];
                    ss += ((v0[0] * v0[0] + v0[1] * v0[1]) + (v0[2] * v0[2] + v0[3] * v0[3])) + ((v1[0] * v1[0] + v1[1] * v1[1]) + (v1[2] * v1[2] + v1[3] * v1[3]));
                    const f32x4 a0 = v0 * gv[bj][0], a1 = v1 * gv[bj][1];
                    u32x4 w; w.x = cvt_pk_bf16(a0[0], a0[1]); w.y = cvt_pk_bf16(a0[2], a0[3]); w.z = cvt_pk_bf16(a1[0], a1[1]); w.w = cvt_pk_bf16(a1[2], a1[3]);
                    *(u32x4*)(O + off + bj * HALF) = w; }
                ss += __shfl_xor(ss, 16); ss += __shfl_xor(ss, 32);
                if (fq == 0) rss[(size_t)r * 64 + u.pn * 4 + wc] = ss; }
            asm volatile("" ::: "memory");
        }
    }
};

__device__ __forceinline__ float dpp_shr1(float old, float src) { return __builtin_bit_cast(float, __builtin_amdgcn_update_dpp(__builtin_bit_cast(int, old), __builtin_bit_cast(int, src), 0x111, 0xf, 0xf, false)); }
__device__ __forceinline__ float dpp_shr2(float old, float src) { return __builtin_bit_cast(float, __builtin_amdgcn_update_dpp(__builtin_bit_cast(int, old), __builtin_bit_cast(int, src), 0x112, 0xf, 0xf, false)); }
__device__ __forceinline__ float dpp_ror1(float src) { return __builtin_bit_cast(float, __builtin_amdgcn_mov_dpp(__builtin_bit_cast(int, src), 0x121, 0xf, 0xf, true)); }
__device__ __forceinline__ float dpp_ror2(float src) { return __builtin_bit_cast(float, __builtin_amdgcn_mov_dpp(__builtin_bit_cast(int, src), 0x122, 0xf, 0xf, true)); }
__device__ __forceinline__ float silu_f(float x) { return x * __builtin_amdgcn_rcpf(1.0f + __builtin_amdgcn_exp2f(-1.44269504089f * x)); }
template <int KIND  > struct EpiFfn1T {
    static constexpr bool PERM = true, APERM = true;
    bf16* O; const float* convp; float* halo; LAS unsigned char* lds; float* part; unsigned* flag; unsigned epoch;
    __device__ __forceinline__ void unit_begin(const Unit& u, int ui, int wid, int lane) const {
        if (wid < 4)
            __builtin_amdgcn_global_load_lds((const unsigned*)((const char*)convp + (size_t)u.pn * 4096 + wid * 1024 + lane * 16), (LAS unsigned*)(lds + CONVP_OFF + (ui & 1) * 4096 + wid * 1024), 16, 0, 0);
    }
    __device__ __forceinline__ void operator()(f32x4 (&acc)[2][2][4][2], const Unit& u, int ui, int wr, int wc, int fr, int fq) const {
        asm volatile("" : "+v"(fr), "+v"(fq));
        const int wid = wr * 4 + wc;
        if constexpr (KIND == 2) {
            const __amdgpu_buffer_rsrc_t rsrc = __builtin_amdgcn_make_buffer_rsrc((void*)part, 0, 262144, 0x00020000);
            const int voff = (wid * 64 + fq * 16 + fr) * 16;
#pragma unroll
            for (int ai = 0; ai < 2; ++ai)
#pragma unroll
                for (int bj = 0; bj < 2; ++bj)
#pragma unroll
                    for (int m = 0; m < 4; ++m)
#pragma unroll
                        for (int n = 0; n < 2; ++n) __builtin_amdgcn_raw_buffer_store_b128(__builtin_bit_cast(u32x4, acc[ai][bj][m][n]), rsrc, voff + (((ai * 2 + bj) * 4 + m) * 2 + n) * 8192, 0, 16);
            asm volatile("s_waitcnt vmcnt(0)" ::: "memory"); __builtin_amdgcn_s_barrier(); asm volatile("" ::: "memory");
            if (wid == 0 && fq == 0 && fr == 0) __hip_atomic_store(flag, epoch, __ATOMIC_RELAXED, __HIP_MEMORY_SCOPE_AGENT);
            return;
        }
        if constexpr (KIND == 1) {
            if (wid == 0) { unsigned sp = 0;
                while ((unsigned)__builtin_amdgcn_readfirstlane(__hip_atomic_load(flag, __ATOMIC_RELAXED, __HIP_MEMORY_SCOPE_AGENT)) < epoch) { __builtin_amdgcn_s_sleep(2); if (++sp > (1u << 22)) break; }
                __builtin_amdgcn_fence(__ATOMIC_ACQUIRE, "agent"); asm volatile("s_waitcnt vmcnt(0)" ::: "memory"); }
            asm volatile("" ::: "memory"); __builtin_amdgcn_s_barrier(); asm volatile("" ::: "memory");
            const f32x4* pp = (const f32x4*)part + (wid * 64 + fq * 16 + fr);
#pragma unroll
            for (int ai = 0; ai < 2; ++ai)
#pragma unroll
                for (int bj = 0; bj < 2; ++bj) {
                    f32x4 t8[4][2];
#pragma unroll
                    for (int m = 0; m < 4; ++m)
#pragma unroll
                        for (int n = 0; n < 2; ++n) t8[m][n] = pp[(((ai * 2 + bj) * 4 + m) * 2 + n) * 512];
#pragma unroll
                    for (int m = 0; m < 4; ++m)
#pragma unroll
                        for (int n = 0; n < 2; ++n) acc[ai][bj][m][n] += t8[m][n];
                    asm volatile("" : "+v"(acc[ai][bj][0][0]), "+v"(acc[ai][bj][0][1]), "+v"(acc[ai][bj][1][0]), "+v"(acc[ai][bj][1][1]), "+v"(acc[ai][bj][2][0]), "+v"(acc[ai][bj][2][1]), "+v"(acc[ai][bj][3][0]), "+v"(acc[ai][bj][3][1]) :: "memory"); }
            asm volatile("" : "+v"(fr), "+v"(fq));
        }
        const LAS float* rstd = (const LAS float*)(lds + RSTD_OFF);
        const LAS float* cp = (const LAS float*)(lds + CONVP_OFF + (ui & 1) * 4096);
        LAS float* ex = (LAS float*)(lds + EXCH_OFF);
#pragma unroll
        for (int ai = 0; ai < 2; ++ai) { const f32x4 rs4 = *(const LAS f32x4*)(rstd + ai * HALF + wr * 64 + 4 * fr);
#pragma unroll
            for (int m = 0; m < 4; ++m)
#pragma unroll
                for (int bj = 0; bj < 2; ++bj)
#pragma unroll
                    for (int n = 0; n < 2; ++n) acc[ai][bj][m][n] *= rs4[m]; }
        if (fr == 15) {
#pragma unroll
            for (int ai = 0; ai < 2; ++ai)
#pragma unroll
                for (int bj = 0; bj < 2; ++bj)
#pragma unroll
                    for (int n = 0; n < 2; ++n) { *(LAS f32x4*)(ex + ((wid * 2 + ai) * 2 + 0) * 64 + (bj * 2 + n) * 16 + fq * 4) = acc[ai][bj][2][n]; *(LAS f32x4*)(ex + ((wid * 2 + ai) * 2 + 1) * 64 + (bj * 2 + n) * 16 + fq * 4) = acc[ai][bj][3][n]; }
        }
        {
            const int colb = u.pn * BM + wc * 32 + 8 * fq;
            if (wr == 0 && fr == 0) {
#pragma unroll
                for (int rr = 0; rr < 2; ++rr)
#pragma unroll
                    for (int bj = 0; bj < 2; ++bj)
#pragma unroll
                        for (int n = 0; n < 2; ++n) *(f32x4*)(halo + ((size_t)u.pm * 4 + rr) * NFF1 + colb + bj * HALF + 4 * n) = acc[0][bj][rr][n];
            }
            if (wr == 1 && fr == 15) {
#pragma unroll
                for (int rr = 0; rr < 2; ++rr)
#pragma unroll
                    for (int bj = 0; bj < 2; ++bj)
#pragma unroll
                        for (int n = 0; n < 2; ++n) *(f32x4*)(halo + ((size_t)u.pm * 4 + 2 + rr) * NFF1 + colb + bj * HALF + 4 * n) = acc[1][bj][2 + rr][n];
            }
        }
        LDS_WAIT(); __builtin_amdgcn_s_barrier(); asm volatile("" ::: "memory");
        const int row0 = u.pm * BM + wr * 64 + 4 * fr, colo = u.pn * HALF + wc * 32 + 8 * fq;
        u32x2 hold[2][4];
        f32x2 kone = (f32x2){1.0f, 1.0f}; asm volatile("" : "+v"(kone));
#pragma unroll
        for (int n = 0; n < 2; ++n) {
            f32x4 pw[4][2];
#pragma unroll
            for (int p = 0; p < 4; ++p)
#pragma unroll
                for (int bj = 0; bj < 2; ++bj) pw[p][bj] = *(const LAS f32x4*)(cp + p * 256 + bj * HALF + wc * 32 + 8 * fq + 4 * n);
#pragma unroll
            for (int ai = 0; ai < 2; ++ai) {
                const int swv = (ai == 1 && wr == 0) ? wid + 4 : wid - 4, sai = (ai == 1 && wr == 1) ? 1 : 0; const bool have = !(ai == 0 && wr == 0);
                f32x4 pm1[2], pm2[2];
#pragma unroll
                for (int bj = 0; bj < 2; ++bj) {
                    f32x4 e0 = (f32x4){0.f, 0.f, 0.f, 0.f}, e1 = e0;
                    if (have) { e0 = *(const LAS f32x4*)(ex + ((swv * 2 + sai) * 2 + 0) * 64 + (bj * 2 + n) * 16 + fq * 4); e1 = *(const LAS f32x4*)(ex + ((swv * 2 + sai) * 2 + 1) * 64 + (bj * 2 + n) * 16 + fq * 4); }
#pragma unroll
                    for (int i = 0; i < 4; ++i) { pm1[bj][i] = dpp_shr1(e1[i], acc[ai][bj][3][n][i]); pm2[bj][i] = dpp_shr1(e0[i], acc[ai][bj][2][n][i]); }
                }
#pragma unroll
                for (int m = 0; m < 4; ++m) {
                    f32x4 hc[2];
#pragma unroll
                    for (int bj = 0; bj < 2; ++bj) {
                        const f32x4 cur = acc[ai][bj][m][n];
                        const f32x4 h1 = m == 0 ? pm1[bj] : acc[ai][bj][m == 0 ? 0 : m - 1][n];
                        const f32x4 h2 = m == 0 ? pm2[bj] : (m == 1 ? pm1[bj] : acc[ai][bj][m < 2 ? 0 : m - 2][n]);
                        hc[bj] = pw[3][bj] + pw[0][bj] * h2 + pw[1][bj] * h1 + pw[2][bj] * cur;
                    }
                    const f32x2 e01 = (f32x2){__builtin_amdgcn_exp2f(hc[0][0]), __builtin_amdgcn_exp2f(hc[0][1])}, e23 = (f32x2){__builtin_amdgcn_exp2f(hc[0][2]), __builtin_amdgcn_exp2f(hc[0][3])};
                    const f32x2 d01 = e01 + kone, d23 = e23 + kone;
                    const f32x4 r = (f32x4){__builtin_amdgcn_rcpf(d01[0]), __builtin_amdgcn_rcpf(d01[1]), __builtin_amdgcn_rcpf(d23[0]), __builtin_amdgcn_rcpf(d23[1])};
                    const f32x4 o = (hc[0] * hc[1]) * r;
                    u32x2 w; w.x = cvt_pk_bf16(o[0], o[1]); w.y = cvt_pk_bf16(o[2], o[3]);
                    if (n == 0) hold[ai][m] = w;
                    else *(u32x4*)(O + (size_t)(row0 + ai * HALF + m) * KFF2 + colo) = (u32x4){hold[ai][m].x, hold[ai][m].y, w.x, w.y};
                }
            }
        }
    }
};
}

#define XB_TMO      128
#define XB_XCNT(j)  (256  + 64 * (j))
#define XB_XSUB(j)  (1280 + 64 * (j))
#define XB_XGEN(j)  (2304 + 64 * (j))
#define XB_TOP      3328
#define XB_TOPGEN   3392
#define XCD_BAR_WORDS 3456
#define XB_SPIN_CAP (1u << 18)
__device__ __forceinline__ unsigned xb_ld(unsigned* p)              { return __hip_atomic_load(p, __ATOMIC_RELAXED, __HIP_MEMORY_SCOPE_AGENT); }
__device__ __forceinline__ unsigned xb_add(unsigned* p, unsigned v) { return __hip_atomic_fetch_add(p, v, __ATOMIC_RELAXED, __HIP_MEMORY_SCOPE_AGENT); }
__device__ __forceinline__ unsigned xb_xcc_id() { return (unsigned)__builtin_amdgcn_s_getreg((3 << 11) | 20) & 0xFu; }
#define XB_SPIN(cond, bar) do { unsigned _sp = 0; while (cond) { __builtin_amdgcn_s_sleep(1); \
    if ((++_sp & 255u) == 0u) { if (xb_ld(&(bar)[XB_TMO])) break; if (_sp > XB_SPIN_CAP) { atomicAdd(&(bar)[XB_TMO], 1u); break; } } } } while (0)
struct XcdBarrier { unsigned* bar; unsigned x; volatile LAS unsigned* st; };
__device__ __forceinline__ XcdBarrier xcd_barrier_post(unsigned* bar, volatile LAS unsigned* st) {
    XcdBarrier b; b.bar = bar; b.x = xb_xcc_id(); b.st = st;
    if (threadIdx.x == 0) (void)xb_add(&bar[XB_XCNT(b.x)], 1u);
    return b;
}
__device__ __forceinline__ void xcd_barrier_complete(unsigned* bar, unsigned x, unsigned& nloc, unsigned& nx) {
    const unsigned G = gridDim.x * gridDim.y * gridDim.z;
    unsigned sum, cnt, mine, sp = 0u;
    for (;;) {
        sum = 0u; cnt = 0u; mine = 0u;
#pragma unroll
        for (unsigned j = 0; j < 16; ++j) { const unsigned c = xb_ld(&bar[XB_XCNT(j)]); sum += c; cnt += (c > 0u) ? 1u : 0u; mine = (j == x) ? c : mine; }
        if (sum == G) break;
        __builtin_amdgcn_s_sleep(1);
        if ((++sp & 255u) == 0u) { if (xb_ld(&bar[XB_TMO])) break; if (sp > XB_SPIN_CAP) { atomicAdd(&bar[XB_TMO], 1u); break; } }
    }
    nloc = mine > 0u ? mine : 1u; nx = cnt > 0u ? cnt : 1u;
}
__device__ __forceinline__ void xcd_barrier(const XcdBarrier& b) {
    asm volatile("s_waitcnt vmcnt(0)" ::: "memory");
    __syncthreads();
    if (threadIdx.x == 0) {
        unsigned* bar = b.bar;
        __builtin_amdgcn_s_waitcnt(0);
        unsigned nloc = b.st[0], nx = b.st[1];
        if (nloc == 0u) { xcd_barrier_complete(bar, b.x, nloc, nx); b.st[0] = nloc; b.st[1] = nx; }
        const unsigned old = xb_add(&bar[XB_XSUB(b.x)], 1u);
        const unsigned gen = old / nloc;
        if (old + 1u == (gen + 1u) * nloc) {
            __builtin_amdgcn_fence(__ATOMIC_RELEASE, "agent");
            asm volatile("s_waitcnt vmcnt(0)" ::: "memory");
            const unsigned og = xb_add(&bar[XB_TOP], 1u);
            const unsigned tg = og / nx;
            if (og + 1u == (tg + 1u) * nx) xb_add(&bar[XB_TOPGEN], 1u);
            else XB_SPIN(xb_ld(&bar[XB_TOPGEN]) == tg, bar);
            __builtin_amdgcn_fence(__ATOMIC_ACQUIRE, "agent");
            xb_add(&bar[XB_XGEN(b.x)], 1u);
            asm volatile("s_waitcnt vmcnt(0)" ::: "memory");
        } else {
            XB_SPIN(xb_ld(&bar[XB_XGEN(b.x)]) == gen, bar);
            __builtin_amdgcn_fence(__ATOMIC_ACQUIRE, "agent");
            asm volatile("s_waitcnt vmcnt(0)" ::: "memory");
        }
    }
    __syncthreads();
}

constexpr int NWAVES = 8;
#define WSP(T, off) ((T*)(F.ws + (off)))
struct Args { const float* in[16]; float* out; unsigned char* ws; int ph_lo, ph_hi, li, pad; };
struct Frame {
    LAS unsigned char* lds; int tid, lane, wave, vcu, G;
    unsigned char* ws; float* out;
};
__device__ __forceinline__ float wave_sum(float v) {
#pragma unroll
    for (int o = 1; o < 64; o <<= 1) v += __shfl_xor(v, o);
    return v;
}

constexpr int CV_NB1 = DFF2 / 64, CV_W1 = (D / 32) * CV_NB1, CV_KB2 = DFF / 32, CV_TOTAL = CV_W1 + CV_KB2 * (D / 64);
static_assert(DFF % 64 == 0 && DFF2 % 64 == 0 && DFF % 32 == 0 && D / 32 == 128, "SCANCVT block shapes");
struct CvBlk { const float* src; bf16* dst; unsigned lds; };
__device__ __forceinline__ CvBlk cv_decode(const float* w1src, const float* w2src, unsigned char* ws, int id, int lane) {
    CvBlk b;
    if (id < CV_W1) { const int kb = id & (D / 32 - 1), nb = id >> 7, n = 64 * nb + lane;        const int f0 = n < DFF ? n : n - DFF; const int rowdst = 256 * (f0 >> 7) + (n < DFF ? 0 : 128) + (f0 & 127);
        b.src = w1src + (size_t)D * DFF2 + (size_t)(32 * kb) * DFF2 + n; b.dst = (bf16*)(ws + WS_W1) + (size_t)NFF1 * D + (size_t)rowdst * D + 32 * kb; b.lds = (unsigned)DFF2; }
    else { const int id2 = id - CV_W1, kb = id2 >> 6, nb = id2 & 63, n = 64 * nb + lane;
        b.src = w2src + (size_t)DFF * D + (size_t)(32 * kb) * D + n; b.dst = (bf16*)(ws + WS_W2) + (size_t)D * KFF2 + (size_t)n * KFF2 + 32 * kb; b.lds = (unsigned)D; }
    return b;
}
__device__ __forceinline__ void cv_load(const CvBlk& b, float (&v)[32]) {
#pragma unroll
    for (int i = 0; i < 32; ++i) v[i] = __builtin_nontemporal_load(b.src + (size_t)i * b.lds);
}
__device__ __forceinline__ void cv_store(const CvBlk& b, const float (&v)[32]) {
#pragma unroll
    for (int q = 0; q < 4; ++q) { u32x4 o; o.x = cvt_pk_bf16(v[8 * q], v[8 * q + 1]); o.y = cvt_pk_bf16(v[8 * q + 2], v[8 * q + 3]); o.z = cvt_pk_bf16(v[8 * q + 4], v[8 * q + 5]); o.w = cvt_pk_bf16(v[8 * q + 6], v[8 * q + 7]);
        *(u32x4*)(b.dst + 8 * q) = o; }
}

__device__ __forceinline__ void tr_item(const float* W, size_t ldw, int k0, int n0, bf16* WT, size_t ldt, int rowdst, LAS float* scr, int lane) {
#pragma unroll 8
    for (int i = 0; i < 32; ++i) { const int kk = 2 * i + (lane >> 5); scr[kk * 33 + (lane & 31)] = __builtin_nontemporal_load(W + (size_t)(k0 + kk) * ldw + n0 + (lane & 31)); }
    LDS_WAIT(); asm volatile("" ::: "memory");
    const int c = lane & 7;
#pragma unroll
    for (int j = 0; j < 4; ++j) { const int n = (lane >> 3) + 8 * j; const LAS float* s = scr + (8 * c) * 33 + n;
        u32x4 o; o.x = pk2(s[0 * 33], s[1 * 33]); o.y = pk2(s[2 * 33], s[3 * 33]); o.z = pk2(s[4 * 33], s[5 * 33]); o.w = pk2(s[6 * 33], s[7 * 33]);
        *(u32x4*)(WT + (size_t)(rowdst + n) * ldt + k0 + 8 * c) = o; }
    LDS_WAIT(); asm volatile("" ::: "memory");
}
__device__ __forceinline__ void rms_row_to_bf16(const float* xrow, const float* g, bf16* orow, int lane) {
    const f32x4* xr = (const f32x4*)xrow + lane; const f32x4* gr = (const f32x4*)g + lane;
    f32x4 v[16]; float s = 0.f;
#pragma unroll
    for (int j = 0; j < 16; ++j) { v[j] = __builtin_nontemporal_load(xr + 64 * j); s += (v[j][0] * v[j][0] + v[j][1] * v[j][1]) + (v[j][2] * v[j][2] + v[j][3] * v[j][3]); }
    const float rstd = 1.0f / sqrtf(wave_sum(s) * (1.f / D) + EPS);
    u32x2* o8 = (u32x2*)orow + lane;
#pragma unroll
    for (int j = 0; j < 16; ++j) { const f32x4 gg = gr[64 * j]; u32x2 w; w.x = pk2(v[j][0] * rstd * gg[0], v[j][1] * rstd * gg[1]); w.y = pk2(v[j][2] * rstd * gg[2], v[j][3] * rstd * gg[3]); o8[64 * j] = w; }
}
__device__ __forceinline__ void p0_prologue(Frame& F, const Args& args) {
    LAS float* scr = (LAS float*)(F.lds + RING_OFF + F.wave * 16384);
    const int gw = F.vcu * NWAVES + F.wave, NGW = F.G * NWAVES;
    constexpr int I_P = 64 * 384, I_O = 64 * 128, I_1 = 64 * 684, I_2 = 171 * 128, I_G = 16 * 32;
    constexpr int NITEMS = I_P + I_O + I_1 + I_2 + 4 * I_G;
    for (int it = gw; it < NITEMS; it += NGW) {
        int r = it + I_P; if (r >= NITEMS) r -= NITEMS;
        if (r < I_P) { const int kb = r / 384, nb = r % 384; tr_item(args.in[2], PROJ_W, 64 * kb, 32 * nb, WSP(bf16, WS_WP), D, 32 * nb, scr, F.lane); continue; } r -= I_P;
        if (r < I_O) { const int kb = r / 128, nb = r % 128; tr_item(args.in[6], D, 64 * kb, 32 * nb, WSP(bf16, WS_WO), D, 32 * nb, scr, F.lane); continue; } r -= I_O;
        if (r < I_1) { const int l = 0; const int kb = r / 684, nb = r % 684; const int n0 = 32 * nb; const int f0 = n0 < DFF ? n0 : n0 - DFF;
            const int rowdst = 256 * (f0 >> 7) + (n0 < DFF ? 0 : 128) + (f0 & 127);
            tr_item(args.in[11] + (size_t)l * D * DFF2, DFF2, 64 * kb, n0, WSP(bf16, WS_W1) + (size_t)l * NFF1 * D, D, rowdst, scr, F.lane); continue; } r -= I_1;
        if (r < I_2) { const int l = 0; const int kb = r / 128, nb = r % 128;
            tr_item(args.in[14] + (size_t)l * DFF * D, D, 64 * kb, 32 * nb, WSP(bf16, WS_W2) + (size_t)l * D * KFF2, KFF2, 32 * nb, scr, F.lane); continue; } r -= I_2;
        { const int gidx = r / I_G; r -= gidx * I_G; const int kb = r / 32, nb = r % 32;
            tr_item(args.in[8] + (size_t)gidx * 1024 * 1024, 1024, 64 * kb, 32 * nb, WSP(bf16, WS_WPOOL) + (size_t)gidx * 1024 * 1024, 1024, 32 * nb, scr, F.lane); }
    }
    {
        const int scan_blocks = ((256 + F.G - 1) / F.G) * (SEQ / 64) * NGW;
        for (int id = scan_blocks + gw; id < CV_TOTAL; id += NGW) { float v[32]; const CvBlk b = cv_decode(args.in[11], args.in[14], F.ws, id, F.lane); cv_load(b, v); cv_store(b, v); }
    }
    const int gt = F.vcu * (NWAVES * 64) + F.tid, NGT = F.G * NWAVES * 64;
    for (int i = gt; i < 2 * 128 * (D / 8); i += NGT) { const int l = i / (128 * (D / 8)), rr = (i / (D / 8)) % 128, c8 = i % (D / 8); const int row = 85 * 256 + (rr < 64 ? 64 + rr : 192 + (rr - 64));
        *(u32x4*)(WSP(bf16, WS_W1) + ((size_t)l * NFF1 + row) * D + 8 * c8) = (u32x4){0u, 0u, 0u, 0u}; }
    for (int i = gt; i < 2 * D * 8; i += NGT) { const int l = i / (D * 8), row = (i / 8) % D, c8 = i % 8; *(u32x4*)(WSP(bf16, WS_W2) + ((size_t)l * D + row) * KFF2 + DFF + 8 * c8) = (u32x4){0u, 0u, 0u, 0u}; }
    for (int i = gt; i < 2 * FT * 4 * 256; i += NGT) { const int cc = i & 255, p = (i >> 8) & 3, j = (i >> 10) % FT, l = i / (FT * 1024); const int f = 128 * j + (cc & 127); const int col = cc < 128 ? f : DFF + f;
        float v = 0.f; if (f < DFF) v = p < 3 ? args.in[12][((size_t)l * 3 + p) * DFF2 + col] : args.in[13][(size_t)l * DFF2 + col];
        WSP(float, WS_CONVP)[i] = v * (cc < 128 ? -1.44269504089f : -0.69314718056f); }
    for (int i = gt; i < 16 * D; i += NGT) { const int c = i & 15, k = i >> 4; WSP(bf16, WS_WG)[(size_t)c * D + k] = (bf16)f2bf(args.in[2][(size_t)k * PROJ_W + NPROJ + c]); }
    for (int m = gw; m < M; m += NGW) rms_row_to_bf16(args.in[0] + (size_t)m * D, args.in[1], WSP(bf16, WS_XA) + (size_t)m * D, F.lane);
}

__device__ __forceinline__ float softcap15(float a) { return 15.0f * tanhf(a * (1.0f / 15.0f)); }
__device__ __forceinline__ void p1_gates(Frame& F, const Args& args) {
    const int gw = F.vcu * NWAVES + F.wave, NGW = F.G * NWAVES; const int fr = F.lane & 15, fq = F.lane >> 4;
    for (int rb = gw; rb < M / 16; rb += NGW) {
        const bf16* ap = WSP(bf16, WS_XA) + (size_t)(rb * 16 + fr) * D + 8 * fq; const bf16* bp = WSP(bf16, WS_WG) + (size_t)fr * D + 8 * fq;
        f32x4 acc = (f32x4){0.f, 0.f, 0.f, 0.f};
#pragma unroll 16
        for (int k = 0; k < D; k += 32) { const bf16x8 a = *(const bf16x8*)(ap + k); const bf16x8 b = *(const bf16x8*)(bp + k); acc = __builtin_amdgcn_mfma_f32_16x16x32_bf16(a, b, acc, 0, 0, 0); }
        const int c = fr; const float bias = c < 8 ? args.in[3][c] : args.in[4][c - 8];
#pragma unroll
        for (int r = 0; r < 4; ++r) { const float z = softcap15(acc[r] + bias); float o = z;
            if (c >= 8) o = fminf(z, 0.f) - log1pf(expf(-fabsf(z)));
            WSP(float, WS_GATES)[(size_t)(rb * 16 + 4 * fq + r) * 16 + c] = o; }
    }
}

__device__ __forceinline__ float row_sum16(float x) {
    x += __builtin_bit_cast(float, __builtin_amdgcn_update_dpp(0, __builtin_bit_cast(int, x), 0x128, 0xf, 0xf, false));
    x += __builtin_bit_cast(float, __builtin_amdgcn_update_dpp(0, __builtin_bit_cast(int, x), 0x124, 0xf, 0xf, false));
    x += __builtin_bit_cast(float, __builtin_amdgcn_update_dpp(0, __builtin_bit_cast(int, x), 0x122, 0xf, 0xf, false));
    x += __builtin_bit_cast(float, __builtin_amdgcn_update_dpp(0, __builtin_bit_cast(int, x), 0x121, 0xf, 0xf, false));
    return x;
}
__device__ __forceinline__ float wave_scan_add(float x, int lane) {
#define SC_STEP(ctrl) x += __builtin_bit_cast(float, __builtin_amdgcn_update_dpp(0, __builtin_bit_cast(int, x), ctrl, 0xf, 0xf, true))
    SC_STEP(0x111); SC_STEP(0x112); SC_STEP(0x114); SC_STEP(0x118);
#undef SC_STEP
    const float t0 = __builtin_bit_cast(float, __builtin_amdgcn_readlane(__builtin_bit_cast(int, x), 15)), t1 = __builtin_bit_cast(float, __builtin_amdgcn_readlane(__builtin_bit_cast(int, x), 31)), t2 = __builtin_bit_cast(float, __builtin_amdgcn_readlane(__builtin_bit_cast(int, x), 47));
    const int g = lane >> 4; return x + (g >= 1 ? t0 : 0.f) + (g >= 2 ? t1 : 0.f) + (g >= 3 ? t2 : 0.f);
}
__device__ __forceinline__ float wave_scan_max(float x, int lane) {
    const int ninf = (int)0xff800000u;
#define SC_STEP(ctrl) x = fmaxf(x, __builtin_bit_cast(float, __builtin_amdgcn_update_dpp(ninf, __builtin_bit_cast(int, x), ctrl, 0xf, 0xf, false)))
    SC_STEP(0x111); SC_STEP(0x112); SC_STEP(0x114); SC_STEP(0x118);
#undef SC_STEP
    const float t0 = __builtin_bit_cast(float, __builtin_amdgcn_readlane(__builtin_bit_cast(int, x), 15)), t1 = __builtin_bit_cast(float, __builtin_amdgcn_readlane(__builtin_bit_cast(int, x), 31)), t2 = __builtin_bit_cast(float, __builtin_amdgcn_readlane(__builtin_bit_cast(int, x), 47));
    const int g = lane >> 4; const float ninff = __builtin_bit_cast(float, ninf);
    return fmaxf(fmaxf(x, g >= 1 ? t0 : ninff), fmaxf(g >= 2 ? t1 : ninff, g >= 3 ? t2 : ninff));
}
typedef short v4i16_t __attribute__((ext_vector_type(4)));
__device__ __forceinline__ v4i16_t tr16(const LAS unsigned char* p) { return __builtin_amdgcn_ds_read_tr16_b64_v4i16((LAS v4i16_t*)p); }
__device__ __forceinline__ bf16x8 cat8(v4i16_t a, v4i16_t b) { return (bf16x8){a[0], a[1], a[2], a[3], b[0], b[1], b[2], b[3]}; }
constexpr int SC_QS = 0, SC_KS = 33792, SC_VS = 67584, SC_VW = 84992, SC_SS = 102400, SC_HS = 111616, SC_FA = 129024;
static_assert(SC_FA + 8192 <= LDSCTL_OFF, "scan LDS map");
__device__ __forceinline__ void p2_scan(Frame& F, const Args& args) {
    LAS unsigned char* L = F.lds;
    LAS float* fa = (LAS float*)(L + SC_FA);
    LAS float *sA = fa, *sM = fa + 64, *sWi = fa + 128, *sEi = fa + 192, *sKw = fa + 256, *sInv = fa + 320, *rsp = fa + 384  , *qnp = fa + 640  , *sn = fa + 1152  , *ssp = fa + 1408  , *scal = fa + 1920;
    const int tid0 = F.tid, w = F.wave;
    const bf16* PROJ = WSP(bf16, WS_PROJ); bf16* HB = WSP(bf16, WS_HB); float* SSg = WSP(float, WS_SS); const float* GATES = WSP(float, WS_GATES);
    const __amdgpu_buffer_rsrc_t rsP = __builtin_amdgcn_make_buffer_rsrc((void*)PROJ, 0, 0x7fffffff, 0x00020000), rsH = __builtin_amdgcn_make_buffer_rsrc((void*)HB, 0, 0x7fffffff, 0x00020000);
#define SC_LDQ(i, soff) __builtin_bit_cast(u32x4, __builtin_amdgcn_raw_buffer_load_b128(rsP, (unsigned)((((tid + 512 * (i)) >> 5) * NPROJ + ((tid + 512 * (i)) & 31) * 8) * 2), (soff), 0))
#define SC_LDV(i, soff) __builtin_bit_cast(u32x4, __builtin_amdgcn_raw_buffer_load_b128(rsP, (unsigned)((((tid + 512 * (i)) >> 4) * NPROJ + ((tid + 512 * (i)) & 15) * 8) * 2), (soff), 2))
    int cvid = F.vcu * NWAVES + F.wave;
    for (int item = F.vcu; item < 256; item += F.G) {
        const int bh = item >> 2, es = item & 3, b = bh >> 3, h = bh & 7;
        f32x4 C[16];
#pragma unroll
        for (int i = 0; i < 16; ++i) C[i] = (f32x4){0.f, 0.f, 0.f, 0.f};
        __syncthreads();
        if (tid0 < 256) sn[tid0] = 0.f;
        if (tid0 == 0) scal[0] = 0.f;
        u32x4 qv[4], kv[4], vv[2]; float ig_n, lf_n;
        { const size_t row0 = (size_t)b * SEQ; const int tid = tid0; ig_n = GATES[(row0 + (tid & 63)) * 16 + h]; lf_n = GATES[(row0 + (tid & 63)) * 16 + 8 + h];
#pragma unroll
            for (int i = 0; i < 4; ++i) { const unsigned so = (unsigned)((row0 * NPROJ + h * DQK) * 2); qv[i] = SC_LDQ(i, so); kv[i] = SC_LDQ(i, so + QKW * 2); }
#pragma unroll
            for (int i = 0; i < 2; ++i) vv[i] = SC_LDV(i, (unsigned)((row0 * NPROJ + 2 * QKW + h * DV + es * 128) * 2)); }
        for (int c = 0; c <= SEQ / 64; ++c) {
            const size_t row0 = (size_t)b * SEQ + 64 * c;
            int tid = tid0; asm volatile("" : "+v"(tid));
            const int lane = tid & 63, fr = lane & 15, fq = lane >> 4, tq = fr >> 2, tp = fr & 3;
            __syncthreads();
            if (c > 0) {
                const size_t prow0 = row0 - 64;
#pragma unroll
                for (int i = 0; i < 2; ++i) { const int p = tid + 512 * i, row = p >> 4, cc = p & 15; __builtin_amdgcn_raw_buffer_store_b128(*(const LAS u32x4*)(L + SC_HS + row * 272 + cc * 16), rsH, (unsigned)((row * D + cc * 8) * 2), (unsigned)((prow0 * D + h * DV + es * 128) * 2), 0); }
                if (tid < 64) { float q = 0.f;
#pragma unroll
                    for (int p = 0; p < 8; ++p) q += ssp[p * 64 + tid];
                    SSg[(prow0 + tid) * 32 + h * 4 + es] = q; }
                if (tid == 0) scal[0] = scal[2];
            }
            if (c == SEQ / 64) break;
#pragma unroll
            for (int i = 0; i < 4; ++i) { const int p = tid + 512 * i, row = p >> 5, cc = p & 31; *(LAS u32x4*)(L + SC_QS + row * 528 + cc * 16) = qv[i]; *(LAS u32x4*)(L + SC_KS + row * 528 + cc * 16) = kv[i]; }
#pragma unroll
            for (int i = 0; i < 2; ++i) { const int p = tid + 512 * i, row = p >> 4, cc = p & 15; *(LAS u32x4*)(L + SC_VS + row * 272 + cc * 16) = vv[i]; }
            const float ig = ig_n, lf = lf_n;
            if (c + 1 < SEQ / 64) {
                const size_t nrow0 = row0 + 64; ig_n = GATES[(nrow0 + lane) * 16 + h]; lf_n = GATES[(nrow0 + lane) * 16 + 8 + h];
#pragma unroll
                for (int i = 0; i < 4; ++i) { const unsigned so = (unsigned)((nrow0 * NPROJ + h * DQK) * 2); qv[i] = SC_LDQ(i, so); kv[i] = SC_LDQ(i, so + QKW * 2); }
#pragma unroll
                for (int i = 0; i < 2; ++i) vv[i] = SC_LDV(i, (unsigned)((nrow0 * NPROJ + 2 * QKW + h * DV + es * 128) * 2));
            }
            float cv[32]; CvBlk cvb; const bool cvon = cvid < CV_TOTAL;
            if (cvon) { cvb = cv_decode(args.in[11], args.in[14], F.ws, cvid, tid & 63); cv_load(cvb, cv); }
            cvid += F.G * NWAVES;
            LDS_WAIT(); __builtin_amdgcn_s_barrier(); asm volatile("" ::: "memory");
            if (w == 0) {
                const float bs = wave_scan_add(lf, lane);
                const float a = ig - bs; const float pm = wave_scan_max(a, lane);
                const float mprev = scal[0]; const float Mt = fmaxf(mprev, pm);
                const float M63 = __builtin_bit_cast(float, __builtin_amdgcn_readlane(__builtin_bit_cast(int, Mt), 63)), b63 = __builtin_bit_cast(float, __builtin_amdgcn_readlane(__builtin_bit_cast(int, bs), 63));
                sA[lane] = a; sM[lane] = Mt; sWi[lane] = __expf(mprev - Mt); sEi[lane] = __expf(-(bs + Mt)); sKw[lane] = __expf(a - M63);
                if (lane == 0) { scal[1] = __expf(mprev - M63); scal[2] = b63 + M63; }
            }
            { const int t = tid & 63; float s = 0.f;
#pragma unroll
                for (int j = 0; j < 4; ++j) { const int d0 = w * 32 + 8 * j; const u32x4 q = *(const LAS u32x4*)(L + SC_QS + t * 528 + d0 * 2); const LAS float* np = sn + d0;
                    s += bf2f(q.x & 0xffffu) * np[0] + bf2f(q.x >> 16) * np[1] + bf2f(q.y & 0xffffu) * np[2] + bf2f(q.y >> 16) * np[3] + bf2f(q.z & 0xffffu) * np[4] + bf2f(q.z >> 16) * np[5] + bf2f(q.w & 0xffffu) * np[6] + bf2f(q.w >> 16) * np[7]; }
                qnp[w * 64 + t] = s; }
            const int tr = w >> 1, tc0 = (w & 1) * 2; f32x4 s0 = (f32x4){0.f, 0.f, 0.f, 0.f}, s1 = s0;
#pragma unroll
            for (int kk = 0; kk < 8; ++kk) { const bf16x8 a = *(const LAS bf16x8*)(L + SC_QS + (16 * tr + fr) * 528 + (32 * kk + 8 * fq) * 2);
                const bf16x8 b0 = *(const LAS bf16x8*)(L + SC_KS + (16 * tc0 + fr) * 528 + (32 * kk + 8 * fq) * 2); const bf16x8 b1 = *(const LAS bf16x8*)(L + SC_KS + (16 * tc0 + 16 + fr) * 528 + (32 * kk + 8 * fq) * 2);
                s0 = __builtin_amdgcn_mfma_f32_16x16x32_bf16(a, b0, s0, 0, 0, 0); s1 = __builtin_amdgcn_mfma_f32_16x16x32_bf16(a, b1, s1, 0, 0, 0); }
            __syncthreads();
#pragma unroll
            for (int q = 0; q < 2; ++q) { const int tc = tc0 + q, sidx = 16 * tc + fr; const float as = sA[sidx];
#pragma unroll
                for (int r = 0; r < 4; ++r) { const int t = 16 * tr + 4 * fq + r; const float e = __expf(fminf(as - sM[t], 0.f)); const float wgt = (sidx <= t) ? e : 0.f; const float v = (q == 0 ? s0[r] : s1[r]) * wgt;
                    *(LAS unsigned short*)(L + SC_SS + (t * 72 + sidx) * 2) = (unsigned short)cvt_pk_bf16(v, v);
                    rsp[t * 4 + tc] = row_sum16(v); } }
#pragma unroll
            for (int i = 0; i < 2; ++i) { const int p = tid + 512 * i, row = p >> 4, cc = p & 15; const float kw = sKw[row]; const u32x4 v = *(const LAS u32x4*)(L + SC_VS + row * 272 + cc * 16); u32x4 o;
                o.x = cvt_pk_bf16(kw * bf2f(v.x & 0xffffu), kw * bf2f(v.x >> 16)); o.y = cvt_pk_bf16(kw * bf2f(v.y & 0xffffu), kw * bf2f(v.y >> 16));
                o.z = cvt_pk_bf16(kw * bf2f(v.z & 0xffffu), kw * bf2f(v.z >> 16)); o.w = cvt_pk_bf16(kw * bf2f(v.w & 0xffffu), kw * bf2f(v.w >> 16));
                *(LAS u32x4*)(L + SC_VW + row * 272 + cc * 16) = o; }
            __syncthreads();
            if (tid < 64) { const int t = tid; float qn = 0.f;
#pragma unroll
                for (int p = 0; p < 8; ++p) qn += qnp[p * 64 + t];
                const float den = sWi[t] * qn + ((rsp[t * 4 + 0] + rsp[t * 4 + 1]) + (rsp[t * 4 + 2] + rsp[t * 4 + 3]));
                sInv[t] = 1.0f / fmaxf(fabsf(den), sEi[t]); }
            f32x4 nacc[4];
#pragma unroll
            for (int tt = 0; tt < 4; ++tt) nacc[tt] = (f32x4){0.f, 0.f, 0.f, 0.f};
#pragma unroll
            for (int kk = 0; kk < 8; ++kk) {
                u32x4 bw; bw.x = cvt_pk_bf16(C[2 * kk][0], C[2 * kk][1]); bw.y = cvt_pk_bf16(C[2 * kk][2], C[2 * kk][3]); bw.z = cvt_pk_bf16(C[2 * kk + 1][0], C[2 * kk + 1][1]); bw.w = cvt_pk_bf16(C[2 * kk + 1][2], C[2 * kk + 1][3]);
                const bf16x8 bq = __builtin_bit_cast(bf16x8, bw);
#pragma unroll
                for (int tt = 0; tt < 4; ++tt) { const bf16x8 a = *(const LAS bf16x8*)(L + SC_QS + (16 * tt + fr) * 528 + (32 * kk + 8 * fq) * 2);
                    nacc[tt] = __builtin_amdgcn_mfma_f32_16x16x32_bf16(a, bq, nacc[tt], 0, 0, 0); }
            }
#pragma unroll
            for (int tt = 0; tt < 4; ++tt)
#pragma unroll
                for (int r = 0; r < 4; ++r) nacc[tt][r] *= sWi[16 * tt + 4 * fq + r];
#pragma unroll
            for (int kk = 0; kk < 2; ++kk) { const LAS unsigned char* vp = L + SC_VS + (32 * kk + 8 * fq + tq) * 272 + (16 * w + 4 * tp) * 2;
                const bf16x8 bv = cat8(tr16(vp), tr16(vp + 4 * 272));
#pragma unroll
                for (int tt = 0; tt < 4; ++tt) { const bf16x8 as = *(const LAS bf16x8*)(L + SC_SS + ((16 * tt + fr) * 72 + 32 * kk + 8 * fq) * 2);
                    nacc[tt] = __builtin_amdgcn_mfma_f32_16x16x32_bf16(as, bv, nacc[tt], 0, 0, 0); } }
            __syncthreads();
#pragma unroll
            for (int tt = 0; tt < 4; ++tt)
#pragma unroll
                for (int r = 0; r < 4; ++r) { const int t = 16 * tt + 4 * fq + r; const float hv = nacc[tt][r] * sInv[t];
                    *(LAS unsigned short*)(L + SC_HS + t * 272 + (16 * w + fr) * 2) = (unsigned short)cvt_pk_bf16(hv, hv);
                    ssp[w * 64 + t] = row_sum16(hv * hv); }
            const float aprev = scal[1];
#pragma unroll
            for (int i = 0; i < 16; ++i) C[i] *= aprev;
            f32x4 ninc0 = (f32x4){0.f, 0.f, 0.f, 0.f}, ninc1 = ninc0;
#pragma unroll
            for (int kk = 0; kk < 2; ++kk) { const LAS unsigned char* vp = L + SC_VW + (32 * kk + 8 * fq + tq) * 272 + (16 * w + 4 * tp) * 2;
                const bf16x8 bvw = cat8(tr16(vp), tr16(vp + 4 * 272));
                u32x4 kn; { const LAS float* kp = sKw + 32 * kk + 8 * fq; kn.x = cvt_pk_bf16(kp[0], kp[1]); kn.y = cvt_pk_bf16(kp[2], kp[3]); kn.z = cvt_pk_bf16(kp[4], kp[5]); kn.w = cvt_pk_bf16(kp[6], kp[7]); }
                const bf16x8 bn = __builtin_bit_cast(bf16x8, kn);
                const LAS unsigned char* kp0 = L + SC_KS + (32 * kk + 8 * fq + tq) * 528 + (8 * tp) * 2;
#pragma unroll
                for (int T = 0; T < 16; ++T) { const LAS unsigned char* kp = kp0 + (32 * (T >> 1) + 4 * (T & 1)) * 2;
                    const bf16x8 ak = cat8(tr16(kp), tr16(kp + 4 * 528));
                    C[T] = __builtin_amdgcn_mfma_f32_16x16x32_bf16(ak, bvw, C[T], 0, 0, 0); }
                { const LAS unsigned char* kp = kp0 + (32 * w) * 2; const bf16x8 a0 = cat8(tr16(kp), tr16(kp + 4 * 528)), a1 = cat8(tr16(kp + 8), tr16(kp + 8 + 4 * 528));
                    ninc0 = __builtin_amdgcn_mfma_f32_16x16x32_bf16(a0, bn, ninc0, 0, 0, 0); ninc1 = __builtin_amdgcn_mfma_f32_16x16x32_bf16(a1, bn, ninc1, 0, 0, 0); } }
            {
#pragma unroll
                for (int r = 0; r < 4; ++r) { const int d0 = 32 * w + 8 * fq + r; const float n0 = aprev * sn[d0] + ninc0[r], n1 = aprev * sn[d0 + 4] + ninc1[r]; sn[d0] = n0; sn[d0 + 4] = n1; } }
            if (cvon) cv_store(cvb, cv);
        }
    }
    __syncthreads();
#undef SC_LDQ
#undef SC_LDV
}

__device__ __forceinline__ void p3_headnorm(Frame& F, const Args& args) {
    const int gw = F.vcu * NWAVES + F.wave, NGW = F.G * NWAVES;
    for (int m = gw; m < M; m += NGW) {
        u32x4 hva[8], ova[8];
#pragma unroll
        for (int j = 0; j < 8; ++j) { const int col = 512 * j + 8 * F.lane; hva[j] = __builtin_nontemporal_load((const u32x4*)(WSP(bf16, WS_HB) + (size_t)m * D + col)); ova[j] = __builtin_nontemporal_load((const u32x4*)(WSP(bf16, WS_PROJ) + (size_t)m * NPROJ + 2 * QKW + VW + col)); }
#pragma unroll
        for (int j = 0; j < 8; ++j) {
            const f32x4 s4 = *(const f32x4*)(WSP(float, WS_SS) + (size_t)m * 32 + 4 * j); const float r = 1.0f / sqrtf(((s4[0] + s4[1]) + (s4[2] + s4[3])) * (1.f / DV) + EPS);
            const int col = 512 * j + 8 * F.lane;
            const u32x4 hv = hva[j]; const u32x4 ov = ova[j];
            const f32x4 g0 = *(const f32x4*)(args.in[5] + col), g1 = *(const f32x4*)(args.in[5] + col + 4);
            const unsigned hw[4] = {hv.x, hv.y, hv.z, hv.w}, ow[4] = {ov.x, ov.y, ov.z, ov.w}; const float gg[8] = {g0[0], g0[1], g0[2], g0[3], g1[0], g1[1], g1[2], g1[3]}; unsigned res[4];
#pragma unroll
            for (int q = 0; q < 4; ++q) { const float h0 = bf2f(hw[q] & 0xffffu), h1 = bf2f(hw[q] >> 16), o0 = bf2f(ow[q] & 0xffffu), o1 = bf2f(ow[q] >> 16);
                const float y0 = h0 * r * gg[2 * q] / (1.0f + __expf(-o0)), y1 = h1 * r * gg[2 * q + 1] / (1.0f + __expf(-o1)); res[q] = pk2(y0, y1); }
            *(u32x4*)(WSP(bf16, WS_XB) + (size_t)m * D + col) = (u32x4){res[0], res[1], res[2], res[3]};
        }
    }
}

__device__ __forceinline__ void rstd_to_lds(Frame& F, int pm) {
    __syncthreads();
    if (F.tid < 256) { const f32x4* p = (const f32x4*)(WSP(float, WS_RSS) + (size_t)(pm * 256 + F.tid) * 64); float s = 0.f;
#pragma unroll
        for (int j = 0; j < 16; ++j) { const f32x4 v = p[j]; s += (v[0] + v[1]) + (v[2] + v[3]); }
        ((LAS float*)(F.lds + RSTD_OFF))[F.tid] = 1.0f / sqrtf(s * (1.f / D) + EPS); }
    VM_WAIT(); LDS_WAIT();
    __syncthreads();
}

__device__ __forceinline__ void p6_fixup(Frame& F, int layer, bf16* __restrict__ GATED) {
    const int gt = F.vcu * (NWAVES * 64) + F.tid, NGT = F.G * NWAVES * 64;
    const float* __restrict__ cpl = WSP(float, WS_CONVP) + (size_t)layer * FT * 1024; const float* __restrict__ HALO = WSP(float, WS_HALO);
    for (int i = gt; i < 64 * FT * 128; i += NGT) { const int ci = i & 127, pn = (i >> 7) % FT, pm = i / (FT * 128); if ((pm & 7) == 0) continue;
        float hc[2][2];
#pragma unroll
        for (int bj = 0; bj < 2; ++bj) { const int col = 256 * pn + 128 * bj + ci; const float* cp = cpl + (size_t)pn * 1024 + 128 * bj + ci;
            const float w0 = cp[0], w1 = cp[256], w2 = cp[512], cb = cp[768];
            const float hm2 = HALO[((size_t)(pm - 1) * 4 + 2) * NFF1 + col], hm1 = HALO[((size_t)(pm - 1) * 4 + 3) * NFF1 + col], h0 = HALO[((size_t)pm * 4 + 0) * NFF1 + col], h1 = HALO[((size_t)pm * 4 + 1) * NFF1 + col];
            hc[bj][0] = cb + w0 * hm2 + w1 * hm1 + w2 * h0; hc[bj][1] = cb + w0 * hm1 + w1 * h0 + w2 * h1; }
#pragma unroll
        for (int rr = 0; rr < 2; ++rr) GATED[(size_t)(pm * 256 + rr) * KFF2 + 128 * pn + ci] = (bf16)f2bf(hc[0][rr] * hc[1][rr] * __builtin_amdgcn_rcpf(1.0f + __builtin_amdgcn_exp2f(hc[0][rr])));
    }
}

__device__ __forceinline__ f32x2 ld_bf2(const bf16* p) { const unsigned w = *(const unsigned*)p; return (f32x2){bf2f(w & 0xffffu), bf2f(w >> 16)}; }
template <int W> __device__ __forceinline__ void pool_cols(const bf16* xb, const LAS float* rs, const f32x2 g, bf16* ob, int tb) {
    f32x2 prev[16], cur[16]; unsigned raw[16];
#pragma unroll
    for (int i = 0; i < 16; ++i) { if (tb == 0) prev[i] = (f32x2){0.f, 0.f}; else prev[i] = ld_bf2(xb + (size_t)i * D) * rs[i] * g; }
#pragma unroll
    for (int i = 0; i < 16; ++i) raw[i] = *(const unsigned*)(xb + (size_t)(16 + i) * D);
#pragma unroll 1
    for (int blk = 0; blk < 4; ++blk) {
#pragma unroll
        for (int i = 0; i < 16; ++i) cur[i] = (f32x2){bf2f(raw[i] & 0xffffu), bf2f(raw[i] >> 16)} * rs[16 + 16 * blk + i] * g;
        if (blk < 3) {
#pragma unroll
            for (int i = 0; i < 16; ++i) raw[i] = *(const unsigned*)(xb + (size_t)(32 + 16 * blk + i) * D); }
#pragma unroll
        for (int i = 0; i < 16; ++i) { f32x2 s = cur[i];
#pragma unroll
            for (int j = 1; j < W; ++j) s += (i - j >= 0) ? cur[(i - j) & 15] : prev[(16 + i - j) & 15];
            const int t = 64 * tb + 16 * blk + i; const float inv = 1.0f / (float)((t + 1) < W ? (t + 1) : W);
            const f32x2 o = s * inv - cur[i];
            *(unsigned*)(ob + (size_t)(16 * blk + i) * D) = pk2(o[0], o[1]); }
#pragma unroll
        for (int i = 0; i < 16; ++i) prev[i] = cur[i];
    }
}
__device__ __forceinline__ void p8_pool(Frame& F, const Args& args) {
    LAS float* rs = (LAS float*)(F.lds);
    for (int item = F.vcu; item < 256; item += F.G) {
        const int b = item >> 5, tb = item & 31; const size_t r0 = (size_t)b * SEQ + 64 * tb;
        __syncthreads();
        if (F.tid < 80) { float v = 0.f; if (tb > 0 || F.tid >= 16) { const f32x4* p = (const f32x4*)(WSP(float, WS_RSS) + (r0 - 16 + F.tid) * 64); float s = 0.f;
#pragma unroll
                for (int j = 0; j < 16; ++j) { const f32x4 q = p[j]; s += (q[0] + q[1]) + (q[2] + q[3]); }
                v = 1.0f / sqrtf(s * (1.f / D) + EPS); }
            rs[F.tid] = v; }
        __syncthreads();
#pragma unroll 1
        for (int part = 0; part < 4; ++part) { const int q = F.tid + 512 * part, col = 2 * q, grp = part;
            const f32x2 g = *(const f32x2*)(args.in[7] + col); const bf16* xb = WSP(bf16, WS_XA) + (r0 - 16) * D + col; bf16* ob = WSP(bf16, WS_XB) + r0 * D + col;
            if (grp == 0) pool_cols<2>(xb, rs, g, ob, tb); else if (grp == 1) pool_cols<4>(xb, rs, g, ob, tb); else if (grp == 2) pool_cols<8>(xb, rs, g, ob, tb); else pool_cols<16>(xb, rs, g, ob, tb); }
    }
    __syncthreads();
}

__device__ __forceinline__ void p13_final(Frame& F, const Args& args) {
    const int gw = F.vcu * NWAVES + F.wave, NGW = F.G * NWAVES;
    for (int m = gw; m < M; m += NGW) {
        const float rstd = 1.0f / sqrtf(wave_sum(WSP(float, WS_RSS)[(size_t)m * 64 + F.lane]) * (1.f / D) + EPS);
        const u32x4* xr = (const u32x4*)(WSP(bf16, WS_XA) + (size_t)m * D) + F.lane; f32x4* orow = (f32x4*)(F.out + (size_t)m * D) + 2 * F.lane; const f32x4* gr = (const f32x4*)args.in[15] + 2 * F.lane;
        u32x4 xw[8];
#pragma unroll
        for (int j = 0; j < 8; ++j) xw[j] = __builtin_nontemporal_load(xr + 64 * j);
#pragma unroll
        for (int j = 0; j < 8; ++j) { const u32x4 w = xw[j]; const f32x4 g0 = gr[128 * j], g1 = gr[128 * j + 1];
            __builtin_nontemporal_store((f32x4){bf2f(w.x & 0xffffu), bf2f(w.x >> 16), bf2f(w.y & 0xffffu), bf2f(w.y >> 16)} * rstd * g0, orow + 128 * j);
            __builtin_nontemporal_store((f32x4){bf2f(w.z & 0xffffu), bf2f(w.z >> 16), bf2f(w.w & 0xffffu), bf2f(w.w >> 16)} * rstd * g1, orow + 128 * j + 1); }
    }
}

__global__ void __launch_bounds__(NWAVES * 64, 2) fwd(Args args) {
    extern __shared__ __attribute__((aligned(16))) unsigned char lds[];
    Frame F;
    F.lds = (LAS unsigned char*)lds;
    F.tid = threadIdx.x; F.lane = F.tid & 63; F.wave = __builtin_amdgcn_readfirstlane(F.tid >> 6);
    F.G = gridDim.x; { const int bx = blockIdx.x; F.vcu = (F.G % 8 == 0) ? (bx % 8) * (F.G / 8) + bx / 8 : bx; }
    unsigned char* ws = args.ws; F.ws = ws; F.out = args.out;
    gu32* ctl = (gu32*)(ws + WS_CTL);
    for (int u = F.tid; u < (LDS_BYTES - LDSCTL_OFF) / 4; u += NWAVES * 64) ((LAS unsigned*)(F.lds + LDSCTL_OFF))[u] = 0u;
    __syncthreads();
    XcdBarrier bar; bar.bar = (unsigned*)(ctl + CW_BAR); bar.x = 0; bar.st = nullptr;
    if (MK_N_LAUNCHES == 1) bar = xcd_barrier_post((unsigned*)(ctl + CW_BAR), (volatile LAS unsigned*)(F.lds + MISC_OFF));
#define GRID_BAR() do { if (MK_N_LAUNCHES == 1) xcd_barrier(bar); } while (0)
    const int lo = args.ph_lo, hi = args.ph_hi;
#ifndef PHASE_MASK
#define PHASE_MASK 0x3fff
#endif
#define IN(k) ((((PHASE_MASK) >> (k)) & 1) && lo <= (k) && (k) < hi)
#define BOTH(k) (IN(k) && IN((k) + 1))
    bf16* GATED = WSP(bf16, WS_PROJ);
    const int c = (int)blockIdx.x;

    if (IN(0)) { p0_prologue(F, args); if (BOTH(0)) GRID_BAR(); }
    if (IN(1)) {
        pg8::Gemm g{WSP(bf16, WS_XA), WSP(bf16, WS_WP), D, D, D, 0, 0}; pg8::RowOrder S; S.init(NPROJ / 256, c);
        pg8::EpiProj E{WSP(bf16, WS_PROJ), NPROJ};
        pg8::gemm_phase(F.lds + RING_OFF, g, S, E);
        p1_gates(F, args);
        if (BOTH(1)) GRID_BAR();
    }
    if (IN(2)) { p2_scan(F, args); if (BOTH(2)) GRID_BAR(); }
    if (IN(3)) { p3_headnorm(F, args); if (BOTH(3)) GRID_BAR(); }
    if (IN(4)) {
        pg8::Gemm g{WSP(bf16, WS_XB), WSP(bf16, WS_WO), D, D, D, 0, 0}; pg8::RowOrder S; S.init(D / 256, c);
        pg8::EpiResid<true> E{args.in[0], nullptr, nullptr, WSP(bf16, WS_XA), args.in[10], WSP(float, WS_RSS)};
        pg8::gemm_phase(F.lds + RING_OFF, g, S, E);
        if (BOTH(4)) GRID_BAR();
    }
    if (IN(5)) {
        pg8::Gemm g{WSP(bf16, WS_XA), WSP(bf16, WS_W1), D, D, D, 0, 0}; pg8::RowOrder S; S.init(FT - 2, c);
        rstd_to_lds(F, S.pm);
        float* part = WSP(float, WS_PART) + (size_t)(c & 127) * 65536; unsigned* sflag = (unsigned*)(ctl + CW_SPLIT + 64 * (c & 127));
        { pg8::EpiFfn1T<0> E{GATED, WSP(float, WS_CONVP), WSP(float, WS_HALO), F.lds, part, sflag, 1u};
          pg8::gemm_phase(F.lds + RING_OFF, g, S, E); }
        pg8::TailOrder T; T.init(c);
        if (T.pn0 < 2) { pg8::EpiFfn1T<1> E{GATED, WSP(float, WS_CONVP), WSP(float, WS_HALO), F.lds, part, sflag, 1u}; pg8::gemm_phase(F.lds + RING_OFF, g, T, E); }
        else { pg8::EpiFfn1T<2> E{GATED, WSP(float, WS_CONVP), WSP(float, WS_HALO), F.lds, part, sflag, 1u}; pg8::gemm_phase(F.lds + RING_OFF, g, T, E); }
        if (BOTH(5)) GRID_BAR();
    }
    if (IN(6)) { p6_fixup(F, 0, GATED); if (BOTH(6)) GRID_BAR(); }
    if (IN(7)) {
        pg8::Gemm g{GATED, WSP(bf16, WS_W2), KFF2, KFF2, KFF2, 0, 0}; pg8::WideOrder S; S.init(D / 256, c);
        pg8::EpiResid<false> E{WSP(bf16, WS_XA), args.in[10], nullptr, WSP(bf16, WS_XA), nullptr, WSP(float, WS_RSS)};
        pg8::gemm_phase(F.lds + RING_OFF, g, S, E);
        if (BOTH(7)) GRID_BAR();
    }
    if (IN(8)) { p8_pool(F, args); if (BOTH(8)) GRID_BAR(); }
    if (IN(9)) {
        pg8::Gemm g{WSP(bf16, WS_XB), WSP(bf16, WS_WPOOL), D, 1024, 1024, 2, 1024}; pg8::RowOrder S; S.init(D / 256, c);
        pg8::EpiResid<false> E{WSP(bf16, WS_XA), nullptr, args.in[9], WSP(bf16, WS_XA), args.in[10] + D, WSP(float, WS_RSS)};
        pg8::gemm_phase(F.lds + RING_OFF, g, S, E);
        if (BOTH(9)) GRID_BAR();
    }
    if (IN(10)) {
        pg8::Gemm g{WSP(bf16, WS_XA), WSP(bf16, WS_W1) + (size_t)NFF1 * D, D, D, D, 0, 0}; pg8::RowOrder S; S.init(FT - 2, c);
        rstd_to_lds(F, S.pm);
        float* part = WSP(float, WS_PART) + (size_t)(c & 127) * 65536; unsigned* sflag = (unsigned*)(ctl + CW_SPLIT + 64 * (c & 127));
        { pg8::EpiFfn1T<0> E{GATED, WSP(float, WS_CONVP) + (size_t)FT * 1024, WSP(float, WS_HALO), F.lds, part, sflag, 2u};
          pg8::gemm_phase(F.lds + RING_OFF, g, S, E); }
        pg8::TailOrder T; T.init(c);
        if (T.pn0 < 2) { pg8::EpiFfn1T<1> E{GATED, WSP(float, WS_CONVP) + (size_t)FT * 1024, WSP(float, WS_HALO), F.lds, part, sflag, 2u}; pg8::gemm_phase(F.lds + RING_OFF, g, T, E); }
        else { pg8::EpiFfn1T<2> E{GATED, WSP(float, WS_CONVP) + (size_t)FT * 1024, WSP(float, WS_HALO), F.lds, part, sflag, 2u}; pg8::gemm_phase(F.lds + RING_OFF, g, T, E); }
        if (BOTH(10)) GRID_BAR();
    }
    if (IN(11)) { p6_fixup(F, 1, GATED); if (BOTH(11)) GRID_BAR(); }
    if (IN(12)) {
        pg8::Gemm g{GATED, WSP(bf16, WS_W2) + (size_t)D * KFF2, KFF2, KFF2, KFF2, 0, 0}; pg8::WideOrder S; S.init(D / 256, c);
        pg8::EpiResid<false> E{WSP(bf16, WS_XA), args.in[10] + D, nullptr, WSP(bf16, WS_XA), nullptr, WSP(float, WS_RSS)};
        pg8::gemm_phase(F.lds + RING_OFF, g, S, E);
        if (BOTH(12)) GRID_BAR();
    }
    if (IN(13)) { p13_final(F, args); }
#undef IN
#undef BOTH
}

extern "C" void kernel_launch(void* const* d_in, const int* in_sizes, int n_in, void* d_out, int out_size, void* d_ws, size_t ws_size, hipStream_t stream) {
    static int grid = 0;
    if (grid == 0) {
        if (n_in != 16 || out_size != M * D || ws_size < WS_END2) { fprintf(stderr, "kernel_launch: unexpected shapes (n_in %d, out %d, ws %zu, need %zu)\n", n_in, out_size, ws_size, (size_t)WS_END2); grid = -1; return; }
        if (hipFuncSetAttribute((const void*)fwd, hipFuncAttributeMaxDynamicSharedMemorySize, LDS_BYTES) != hipSuccess) { fprintf(stderr, "kernel_launch: hipFuncSetAttribute failed\n"); grid = -1; return; }
        int per_cu = 0;
        if (hipOccupancyMaxActiveBlocksPerMultiprocessor(&per_cu, (const void*)fwd, NWAVES * 64, LDS_BYTES) != hipSuccess || per_cu < 1) fprintf(stderr, "kernel_launch: occupancy query reports %d\n", per_cu);
        (void)hipGetLastError();
        grid = 256;
    }
    if (grid < 0) return;
    (void)hipMemsetAsync((char*)d_ws + WS_CTL, 0, CTL_ZERO_BYTES, stream);
    Args a{};
    for (int i = 0; i < 16; ++i) a.in[i] = (const float*)d_in[i];
    a.out = (float*)d_out; a.ws = (unsigned char*)d_ws;
    if (MK_N_LAUNCHES == 1) { a.ph_lo = 0; a.ph_hi = NPHASE; a.li = 0; hipLaunchKernelGGL(fwd, dim3(grid), dim3(NWAVES * 64), LDS_BYTES, stream, a); }
    else for (int p = 0; p < NPHASE; ++p) { a.ph_lo = p; a.ph_hi = p + 1; a.li = p; hipLaunchKernelGGL(fwd, dim3(grid), dim3(NWAVES * 64), LDS_BYTES, stream, a); }
}
```

```cpp
#include <hip/hip_runtime.h>
#include <cstdio>
#include <cstdint>

#ifndef MK_N_LAUNCHES
#define MK_N_LAUNCHES 1
#endif

#define GAS __attribute__((address_space(1)))
#define LAS __attribute__((address_space(3)))
typedef unsigned short bf16;
typedef short bf16x8 __attribute__((ext_vector_type(8)));
typedef short bf16x4 __attribute__((ext_vector_type(4)));
typedef float f32x4 __attribute__((ext_vector_type(4)));
typedef float f32x2 __attribute__((ext_vector_type(2)));
typedef unsigned u32x4 __attribute__((ext_vector_type(4)));
typedef unsigned u32x2 __attribute__((ext_vector_type(2)));
typedef GAS unsigned gu32;

constexpr int D = 4096, BATCH = 8, SEQ = 2048, M = BATCH * SEQ;
constexpr int NH = 8, DQK = 256, DV = 512, QKW = 2048, VW = 4096;
constexpr int NPROJ = 12288, PROJ_W = 12304;
constexpr int DFF = 10944, DFF2 = 21888, FT = 86, NFF1 = FT * 256  , KFF2 = FT * 128  ;
constexpr float EPS = 1e-6f;
constexpr int NPHASE = 14;

constexpr size_t MiB = 1u << 20;
constexpr size_t WS_CTL = 0, CTL_ZERO_BYTES = 131072;
constexpr size_t WS_WP = 2 * MiB;
constexpr size_t WS_WG = WS_WP + (size_t)NPROJ * D * 2;
constexpr size_t WS_WO = WS_WG + 1 * MiB;
constexpr size_t WS_W1 = WS_WO + (size_t)D * D * 2;
constexpr size_t WS_W2 = WS_W1 + 2 * (size_t)NFF1 * D * 2;
constexpr size_t WS_WPOOL = WS_W2 + 2 * (size_t)D * KFF2 * 2;
constexpr size_t WS_CONVP = WS_WPOOL + 4 * (size_t)1024 * 1024 * 2;
constexpr size_t WS_XA = WS_CONVP + 1 * MiB;
constexpr size_t WS_XB = WS_XA + (size_t)M * D * 2;
constexpr size_t WS_PROJ = WS_XB + (size_t)M * D * 2;
constexpr size_t WS_HB = WS_PROJ + (size_t)M * NPROJ * 2;
constexpr size_t WS_SS = WS_HB + (size_t)M * D * 2;
constexpr size_t WS_GATES = WS_SS + (size_t)M * 32 * 4;
constexpr size_t WS_RSS = WS_GATES + (size_t)M * 16 * 4;
constexpr size_t WS_HALO = WS_RSS + (size_t)M * 64 * 4;
constexpr size_t WS_END = WS_HALO + (size_t)64 * 4 * NFF1 * 4;
constexpr size_t WS_PART = WS_END, WS_END2 = WS_PART + (size_t)128 * 65536 * 4;
static_assert((size_t)M * KFF2 * 2 <= (size_t)M * NPROJ * 2, "GATED overlays PROJ");

constexpr int CW_TMO = 0, CW_BAR = 4096, CW_SPLIT = 8192;
static_assert((CW_BAR + 3456) <= CW_SPLIT && (CW_SPLIT + 64 * 128) * 4 <= (int)CTL_ZERO_BYTES, "control words inside the memset region");

constexpr int RING_OFF = 0, RING_BYTES = 131072;
constexpr int RSTD_OFF = 131072;
constexpr int CONVP_OFF = RSTD_OFF + 1024;
constexpr int EXCH_OFF = CONVP_OFF + 8192;
constexpr int LDSCTL_OFF = EXCH_OFF + 8192;
constexpr int MISC_OFF = LDSCTL_OFF + 64;
constexpr int LDS_BYTES = LDSCTL_OFF + 512;
static_assert(LDS_BYTES <= 160 * 1024, "LDS");

#define RLX_AGENT __ATOMIC_RELAXED, __HIP_MEMORY_SCOPE_AGENT
#define LDS_WAIT() asm volatile("s_waitcnt lgkmcnt(0)" ::: "memory")
#define VM_WAIT() asm volatile("s_waitcnt vmcnt(0)" ::: "memory")
__device__ __forceinline__ unsigned f2bf(float f) { unsigned u = __builtin_bit_cast(unsigned, f); return (u + 0x7fffu + ((u >> 16) & 1u)) >> 16; }
__device__ __forceinline__ unsigned pk2(float lo, float hi) { return f2bf(lo) | (f2bf(hi) << 16); }
__device__ __forceinline__ float bf2f(unsigned b) { return __builtin_bit_cast(float, b << 16); }
__device__ __forceinline__ unsigned cvt_pk_bf16(float lo, float hi) { unsigned r; asm volatile("v_cvt_pk_bf16_f32 %0, %1, %2" : "=v"(r) : "v"(lo), "v"(hi)); return r; }

#ifndef PG8_BAL
#define PG8_BAL 1
#endif
#ifndef PG8_LOADPRIO
#define PG8_LOADPRIO 1
#endif
namespace pg8 {
constexpr int BM = 256, BK = 64, HALF = 128, HTB = HALF * BK * 2, STAGE_BYTES = 8 * HTB;
__host__ __device__ __forceinline__ int lds_byte(int r, int c) { const int st = (r >> 4) * 2 + (c >> 5), rr = r & 15, cc = c & 31, ob = rr * 64 + cc * 2; return st * 1024 + (ob ^ (((ob >> 9) & 1) << 5)); }
__host__ __device__ __forceinline__ void stage_rc(int b, int& R, int& C) { const int st = b / 1024, sb = b % 1024, swz = sb ^ (((sb >> 9) & 1) << 5); R = (st >> 1) * 16 + swz / 64; C = (st & 1) * 32 + (swz % 64) / 2; }
__host__ __device__ __forceinline__ int perm32(int rho) { const int n = rho >> 4, i = rho & 15; return 8 * (i >> 2) + 4 * n + (i & 3); }

struct Unit { int pm, pn; int kt0, nkt; };
struct Gemm { const bf16* A; const bf16* Bt; int lda, ldb, K; int agrp_shift, agrp_stride; };

struct RowOrder {
    static constexpr bool SPLIT = false;
    int pm, pn0, nN;
    __device__ __forceinline__ void init(int nN_, int c) { const int x = c & 7, j = c >> 3; pm = 8 * x + (j & 7); pn0 = j >> 3; nN = nN_; }
    __device__ __forceinline__ bool next(int i, Unit& u) const { const int pn = 4 * i + pn0; u.pm = pm; u.pn = pn; return pn < nN; }
};

struct WideOrder {
    static constexpr bool SPLIT = false;
    int x, j;
    __device__ __forceinline__ void init(int, int c) { x = c & 7; j = c >> 3; }
    __device__ __forceinline__ bool next(int i, Unit& u) const { u.pm = 8 * x + 4 * (i >> 1) + (j & 3); u.pn = 8 * (i & 1) + (j >> 2); return i < 4; }
};
struct TailOrder {
    static constexpr bool SPLIT = true;
    int pm, pn0;
    __device__ __forceinline__ void init(int c) { const int x = c & 7, j = c >> 3; pm = 8 * x + (j & 7); pn0 = j >> 3; }
    __device__ __forceinline__ bool next(int i, Unit& u) const { u.pm = pm; u.pn = 84 + (pn0 & 1); u.kt0 = pn0 < 2 ? 0 : 32; u.nkt = 32; return i == 0; }
};
template <class Epi, class Sched, int PV = 0>
__device__ __forceinline__ void gemm_phase(LAS unsigned char* lds, const Gemm g, const Sched& S, Epi& E) {
    const int tid = threadIdx.x, wid = __builtin_amdgcn_readfirstlane(tid >> 6), lane = tid & 63, wr = wid >> 2, wc = wid & 3, fr = lane & 15, fq = lane >> 4;
    int nt = g.K / BK;
    const unsigned kstep = (unsigned)(BK * 2);
    const unsigned hstepA = (unsigned)HALF * g.lda * 2, hstepB = (unsigned)HALF * g.ldb * 2;
    unsigned voffA0[2], voffB0[2];
#pragma unroll
    for (int i = 0; i < 2; ++i) { int R, C; stage_rc(tid * 16 + i * 8192, R, C); const int Rb = Epi::PERM ? ((R & ~31) + perm32(R & 31)) : R;
        const int Ra = Epi::APERM ? ((R & 64) + 4 * (R & 15) + ((R >> 4) & 3)) : R;
        voffA0[i] = (unsigned)(Ra * g.lda + C) * 2u; voffB0[i] = (unsigned)(Rb * g.ldb + C) * 2u; }
    const __amdgpu_buffer_rsrc_t rsA = __builtin_amdgcn_make_buffer_rsrc((void*)g.A, 0, 0x7fffffff, 0x00020000), rsB = __builtin_amdgcn_make_buffer_rsrc((void*)g.Bt, 0, 0x7fffffff, 0x00020000);
    const unsigned ldsw = (unsigned)wid * 1024u;
    const int aoff = lds_byte(wr * 64 + fr, fq * 8), boff = lds_byte(wc * 32 + fr, fq * 8);
#define PG8_SA(b, h) (((b) * 2 + (h)) * HTB)
#define PG8_SB(b, h) ((4 + (b) * 2 + (h)) * HTB)
#define PG8_STAGE(rs, bufoff, off, voff) do { _Pragma("unroll") for (int _i = 0; _i < 2; ++_i) \
        __builtin_amdgcn_raw_ptr_buffer_load_lds(rs, (LAS void*)(lds + (bufoff) + ldsw + _i * 8192), 16, (voff)[_i], (unsigned)(off), 0, 0); } while (0)
#define PG8_LDA(dst, b, h) do { _Pragma("unroll") for (int m = 0; m < 4; ++m) _Pragma("unroll") for (int k = 0; k < 2; ++k) dst[m][k] = *(const LAS bf16x8*)(lds + PG8_SA(b, h) + aoff + m * 2048 + k * 1024); } while (0)
#define PG8_LDB(dst, b, h) do { _Pragma("unroll") for (int n = 0; n < 2; ++n) _Pragma("unroll") for (int k = 0; k < 2; ++k) dst[n][k] = *(const LAS bf16x8*)(lds + PG8_SB(b, h) + boff + n * 2048 + k * 1024); } while (0)
#define PG8_CH(bj, Bf, m, n) do { _Pragma("unroll") for (int k = 0; k < 2; ++k) acc[ai_][bj][m][n] = __builtin_amdgcn_mfma_f32_16x16x32_bf16(Bf[n][k], At[m][k], acc[ai_][bj][m][n], 0, 0, 0); __builtin_amdgcn_sched_barrier(0); } while (0)
#define PG8_MMA2(ai, B0) do { constexpr int ai_ = ai; __builtin_amdgcn_s_setprio(1); \
          \
        PG8_CH(0, B0, 0, 0); PG8_CH(0, B0, 0, 1); PG8_CH(1, B1, 0, 0); PG8_CH(1, B1, 0, 1); \
        PG8_CH(1, B1, 1, 1); PG8_CH(1, B1, 1, 0); PG8_CH(0, B0, 1, 1); PG8_CH(0, B0, 1, 0); \
        PG8_CH(0, B0, 2, 0); PG8_CH(0, B0, 2, 1); PG8_CH(1, B1, 2, 0); PG8_CH(1, B1, 2, 1); \
        PG8_CH(1, B1, 3, 1); PG8_CH(1, B1, 3, 0); PG8_CH(0, B0, 3, 1); PG8_CH(0, B0, 3, 0); \
        __builtin_amdgcn_s_setprio(PG8_LOADPRIO); } while (0)
#define PG8_WAIT_V(n) asm volatile("s_waitcnt vmcnt(" #n ")" ::: "memory")
#define PG8_WAIT_VL(n) __builtin_amdgcn_s_waitcnt(0x0070 | (n))
#define PG8_BAR __builtin_amdgcn_s_barrier()
#define PG8_SCHED __builtin_amdgcn_sched_barrier(0)
#define PG8_ITER(oA1, oA2, oB2, oB3, lastrd) do { \
            PG8_LDB(B1, 0, 1); PG8_SCHED; PG8_LDA(At, 0, 0); PG8_STAGE(rsA, PG8_SA(1, 0), oA1, voffA0); PG8_STAGE(rsA, PG8_SA(1, 1), (oA1) + hstepA, voffA0); \
            PG8_WAIT_VL(6); PG8_BAR; PG8_MMA2(0, B0e); PG8_BAR; PG8_SCHED; \
            PG8_LDA(At, 0, 1); PG8_LDB(B0o, 1, 0); PG8_STAGE(rsB, PG8_SB(0, 0), oB2, voffB0); PG8_STAGE(rsB, PG8_SB(0, 1), (oB2) + hstepB, voffB0); \
            PG8_WAIT_VL(6); PG8_BAR; PG8_MMA2(1, B0e); PG8_BAR; PG8_SCHED; \
            PG8_LDB(B1, 1, 1); PG8_SCHED; PG8_LDA(At, 1, 0); PG8_STAGE(rsA, PG8_SA(0, 0), oA2, voffA0); PG8_STAGE(rsA, PG8_SA(0, 1), (oA2) + hstepA, voffA0); \
            PG8_WAIT_VL(6); PG8_BAR; PG8_MMA2(0, B0o); PG8_BAR; PG8_SCHED; \
            PG8_LDA(At, 1, 1); if (lastrd) { PG8_LDB(B0e, 0, 0); } PG8_STAGE(rsB, PG8_SB(1, 0), oB3, voffB0); PG8_STAGE(rsB, PG8_SB(1, 1), (oB3) + hstepB, voffB0); \
            PG8_WAIT_VL(6); PG8_BAR; PG8_MMA2(1, B0o); PG8_BAR; PG8_SCHED; } while (0)
    Unit cur, nxt; int ui = 0;
    if (!S.next(0, cur)) return;
    f32x4 acc[2][2][4][2];
#pragma unroll
    for (int a = 0; a < 2; ++a)
#pragma unroll
        for (int b = 0; b < 2; ++b)
#pragma unroll
            for (int m = 0; m < 4; ++m)
#pragma unroll
                for (int n = 0; n < 2; ++n) acc[a][b][m][n] = (f32x4){0.f, 0.f, 0.f, 0.f};
    bf16x8 At[4][2], B0e[2][2], B0o[2][2], B1[2][2];
    unsigned cA = (unsigned)cur.pm * 2 * hstepA + (unsigned)((cur.pn >> g.agrp_shift) * g.agrp_stride) * 2; unsigned cB = (unsigned)cur.pn * 2 * hstepB;
    if constexpr (Sched::SPLIT) { nt = cur.nkt; cA += (unsigned)cur.kt0 * kstep; cB += (unsigned)cur.kt0 * kstep; }
    E.unit_begin(cur, 0, wid, lane);
    PG8_STAGE(rsB, PG8_SB(0, 0), cB, voffB0); PG8_STAGE(rsB, PG8_SB(0, 1), cB + hstepB, voffB0); PG8_STAGE(rsA, PG8_SA(0, 0), cA, voffA0); PG8_STAGE(rsA, PG8_SA(0, 1), cA + hstepA, voffA0);
    if (wr == 1) PG8_BAR;
    PG8_STAGE(rsB, PG8_SB(1, 0), cB + kstep, voffB0); PG8_STAGE(rsB, PG8_SB(1, 1), cB + kstep + hstepB, voffB0);
    PG8_WAIT_V(6); PG8_BAR; PG8_BAR;
    PG8_LDB(B0e, 0, 0);
    for (;;) {
        const bool has_next = S.next(ui + 1, nxt);
        unsigned nko = 0; if constexpr (Sched::SPLIT) nko = has_next ? (unsigned)nxt.kt0 * kstep : 0;
        const unsigned nA = has_next ? (unsigned)nxt.pm * 2 * hstepA + (unsigned)((nxt.pn >> g.agrp_shift) * g.agrp_stride) * 2 + nko : cA; const unsigned nB = has_next ? (unsigned)nxt.pn * 2 * hstepB + nko : cB;
        unsigned oA = cA + kstep, oB = cB + 2 * kstep;
        for (int t = 0; t < nt; t += 2) {
            const bool last = (t == nt - 2);
            const unsigned a2 = last ? nA : oA + kstep, b2 = last ? nB : oB;
            PG8_ITER(oA, a2, b2, b2 + kstep, !last); oA += 2 * kstep; oB += 2 * kstep; }
        if (wr == 0) PG8_BAR;
        E(acc, cur, ui, wr, wc, fr, fq);
        if (!has_next) break;
        { f32x2 z2 = (f32x2){0.f, 0.f}; asm volatile("" : "+v"(z2));
#pragma unroll
        for (int a = 0; a < 2; ++a)
#pragma unroll
            for (int b = 0; b < 2; ++b)
#pragma unroll
                for (int m = 0; m < 4; ++m)
#pragma unroll
                    for (int n = 0; n < 2; ++n) acc[a][b][m][n] = __builtin_shufflevector(z2, z2, 0, 1, 0, 1); }
        cur = nxt; cA = nA; cB = nB; ++ui; if constexpr (Sched::SPLIT) nt = cur.nkt;
        if (wr == 1) PG8_BAR;
        E.unit_begin(cur, ui, wid, lane);
        PG8_LDB(B0e, 0, 0);
    }
    PG8_WAIT_V(0);
    PG8_BAR;
#undef PG8_SA
#undef PG8_SB
#undef PG8_STAGE
#undef PG8_LDA
#undef PG8_LDB
#undef PG8_MMA2
#undef PG8_CH
#undef PG8_WAIT_V
#undef PG8_WAIT_VL
#undef PG8_BAR
#undef PG8_SCHED
#undef PG8_ITER
}

struct EpiProj {
    static constexpr bool PERM = true, APERM = false;
    bf16* O; int ldc;
    __device__ __forceinline__ void unit_begin(const Unit&, int, int, int) const {}
    __device__ __forceinline__ void operator()(const f32x4 (&acc)[2][2][4][2], const Unit& u, int, int wr, int wc, int fr, int fq) const {
        asm volatile("" : "+v"(fr), "+v"(fq));
        const int row0 = u.pm * BM + wr * 64 + fr, col0 = u.pn * BM + wc * 32 + 8 * fq; const float sc = u.pn < 8 ? 0.0625f : 1.f;
#pragma unroll
        for (int ai = 0; ai < 2; ++ai)
#pragma unroll
            for (int m = 0; m < 4; ++m) { bf16* rowp = O + (size_t)(row0 + ai * HALF + m * 16) * ldc + col0;
#pragma unroll
                for (int bj = 0; bj < 2; ++bj) { const f32x4 v0 = acc[ai][bj][m][0] * sc, v1 = acc[ai][bj][m][1] * sc;
                    u32x4 w; w.x = cvt_pk_bf16(v0[0], v0[1]); w.y = cvt_pk_bf16(v0[2], v0[3]); w.z = cvt_pk_bf16(v1[0], v1[1]); w.w = cvt_pk_bf16(v1[2], v1[3]);
                    *(u32x4*)(rowp + bj * HALF) = w; } }
    }
};

struct EpiNull {
    static constexpr bool PERM = false, APERM = false;
    __device__ __forceinline__ void unit_begin(const Unit&, int, int, int) const {}
    __device__ __forceinline__ void operator()(const f32x4 (&acc)[2][2][4][2], const Unit&, int, int, int, int, int) const {
#pragma unroll
        for (int ai = 0; ai < 2; ++ai)
#pragma unroll
            for (int bj = 0; bj < 2; ++bj)
#pragma unroll
                for (int m = 0; m < 4; ++m)
#pragma unroll
                    for (int n = 0; n < 2; ++n) asm volatile("" :: "v"(acc[ai][bj][m][n]));
    }
};
template <bool BASE_F32> struct EpiResid {
    static constexpr bool PERM = true, APERM = false;
    const void* base; const float* ginv_src; const float* colscale; bf16* O; const float* gA; float* rss;
    __device__ __forceinline__ void unit_begin(const Unit&, int, int, int) const {}
    __device__ __forceinline__ void operator()(const f32x4 (&acc)[2][2][4][2], const Unit& u, int, int wr, int wc, int fr, int fq) const {
        asm volatile("" : "+v"(fr), "+v"(fq));
        const int row0 = u.pm * BM + wr * 64 + fr, col0 = u.pn * BM + wc * 32 + 8 * fq;
        f32x4 cs[2][2], gv[2][2], gi[2][2];
#pragma unroll
        for (int bj = 0; bj < 2; ++bj)
#pragma unroll
            for (int n = 0; n < 2; ++n) { const int cc = col0 + bj * HALF + 4 * n;
                cs[bj][n] = colscale ? *(const f32x4*)(colscale + cc) : (f32x4){1.f, 1.f, 1.f, 1.f};
                gv[bj][n] = gA ? *(const f32x4*)(gA + cc) : (f32x4){1.f, 1.f, 1.f, 1.f};
                if (ginv_src) { const f32x4 t = *(const f32x4*)(ginv_src + cc); gi[bj][n] = (f32x4){1.0f / t[0], 1.0f / t[1], 1.0f / t[2], 1.0f / t[3]}; } else gi[bj][n] = (f32x4){1.f, 1.f, 1.f, 1.f}; }
#pragma unroll
        for (int ai = 0; ai < 2; ++ai) {
            f32x4 pb[4][2][2]; u32x4 pw[4][2];
#pragma unroll
            for (int m = 0; m < 4; ++m) { const size_t off = (size_t)(row0 + ai * HALF + m * 16) * D + col0;
#pragma unroll
                for (int bj = 0; bj < 2; ++bj) {
                    if (BASE_F32) { pb[m][bj][0] = __builtin_nontemporal_load((const f32x4*)((const float*)base + off + bj * HALF)); pb[m][bj][1] = __builtin_nontemporal_load((const f32x4*)((const float*)base + off + bj * HALF + 4)); }
                    else pw[m][bj] = *(const u32x4*)((const bf16*)base + off + bj * HALF); } }
#pragma unroll
            for (int m = 0; m < 4; ++m) { const int r = row0 + ai * HALF + m * 16; const size_t off = (size_t)r * D + col0; float ss = 0.f;
#pragma unroll
                for (int bj = 0; bj < 2; ++bj) { f32x4 b0, b1;
                    if (BASE_F32) { b0 = pb[m][bj][0]; b1 = pb[m][bj][1]; }
                    else { const u32x4 w = pw[m][bj];
                        b0 = (f32x4){bf2f(w.x & 0xffffu), bf2f(w.x >> 16), bf2f(w.y & 0xffffu), bf2f(w.y >> 16)}; b1 = (f32x4){bf2f(w.z & 0xffffu), bf2f(w.z >> 16), bf2f(w.w & 0xffffu), bf2f(w.w >> 16)}; }
                    const f32x4 v0 = b0 * gi[bj][0] + acc[ai][bj][m][0] * cs[bj][0], v1 = b1 * gi[bj][1] + acc[ai][bj][m][1] * cs[bj][1];
                    ss += ((v0[0] * v0[0] + v0[1] * v0[1]) + (v0[2] * v0[2] + v0[3] * v0[3])) + ((v1[0] * v1[0] + v1[1] * v1[1]) + (v1[2] * v1[2] + v1[3] * v1[3]));
                    const f32x4 a0 = v0 * gv[bj][0], a1 = v1 * gv[bj][1];
                    u32x4 w; w.x = cvt_pk_bf16(a0[0], a0[1]); w.y = cvt_pk_bf16(a0[2], a0[3]); w.z = cvt_pk_bf16(a1[0], a1[1]); w.w = cvt_pk_bf16(a1[2], a1[3]);
                    *(u32x4*)(O + off + bj * HALF) = w; }
                ss += __shfl_xor(ss, 16); ss += __shfl_xor(ss, 32);
                if (fq == 0) rss[(size_t)r * 64 + u.pn * 4 + wc] = ss; }
            asm volatile("" ::: "memory");
        }
    }
};

__device__ __forceinline__ float dpp_shr1(float old, float src) { return __builtin_bit_cast(float, __builtin_amdgcn_update_dpp(__builtin_bit_cast(int, old), __builtin_bit_cast(int, src), 0x111, 0xf, 0xf, false)); }
__device__ __forceinline__ float dpp_shr2(float old, float src) { return __builtin_bit_cast(float, __builtin_amdgcn_update_dpp(__builtin_bit_cast(int, old), __builtin_bit_cast(int, src), 0x112, 0xf, 0xf, false)); }
__device__ __forceinline__ float dpp_ror1(float src) { return __builtin_bit_cast(float, __builtin_amdgcn_mov_dpp(__builtin_bit_cast(int, src), 0x121, 0xf, 0xf, true)); }
__device__ __forceinline__ float dpp_ror2(float src) { return __builtin_bit_cast(float, __builtin_amdgcn_mov_dpp(__builtin_bit_cast(int, src), 0x122, 0xf, 0xf, true)); }
__device__ __forceinline__ float silu_f(float x) { return x * __builtin_amdgcn_rcpf(1.0f + __builtin_amdgcn_exp2f(-1.44269504089f * x)); }
template <int KIND  > struct EpiFfn1T {
    static constexpr bool PERM = true, APERM = true;
    bf16* O; const float* convp; float* halo; LAS unsigned char* lds; float* part; unsigned* flag; unsigned epoch;
    __device__ __forceinline__ void unit_begin(const Unit& u, int ui, int wid, int lane) const {
        if (wid < 4)
            __builtin_amdgcn_global_load_lds((const unsigned*)((const char*)convp + (size_t)u.pn * 4096 + wid * 1024 + lane * 16), (LAS unsigned*)(lds + CONVP_OFF + (ui & 1) * 4096 + wid * 1024), 16, 0, 0);
    }
    __device__ __forceinline__ void operator()(f32x4 (&acc)[2][2][4][2], const Unit& u, int ui, int wr, int wc, int fr, int fq) const {
        asm volatile("" : "+v"(fr), "+v"(fq));
        const int wid = wr * 4 + wc;
        if constexpr (KIND == 2) {
            const __amdgpu_buffer_rsrc_t rsrc = __builtin_amdgcn_make_buffer_rsrc((void*)part, 0, 262144, 0x00020000);
            const int voff = (wid * 64 + fq * 16 + fr) * 16;
#pragma unroll
            for (int ai = 0; ai < 2; ++ai)
#pragma unroll
                for (int bj = 0; bj < 2; ++bj)
#pragma unroll
                    for (int m = 0; m < 4; ++m)
#pragma unroll
                        for (int n = 0; n < 2; ++n) __builtin_amdgcn_raw_buffer_store_b128(__builtin_bit_cast(u32x4, acc[ai][bj][m][n]), rsrc, voff + (((ai * 2 + bj) * 4 + m) * 2 + n) * 8192, 0, 16);
            asm volatile("s_waitcnt vmcnt(0)" ::: "memory"); __builtin_amdgcn_s_barrier(); asm volatile("" ::: "memory");
            if (wid == 0 && fq == 0 && fr == 0) __hip_atomic_store(flag, epoch, __ATOMIC_RELAXED, __HIP_MEMORY_SCOPE_AGENT);
            return;
        }
        if constexpr (KIND == 1) {
            if (wid == 0) { unsigned sp = 0;
                while ((unsigned)__builtin_amdgcn_readfirstlane(__hip_atomic_load(flag, __ATOMIC_RELAXED, __HIP_MEMORY_SCOPE_AGENT)) < epoch) { __builtin_amdgcn_s_sleep(2); if (++sp > (1u << 22)) break; }
                __builtin_amdgcn_fence(__ATOMIC_ACQUIRE, "agent"); asm volatile("s_waitcnt vmcnt(0)" ::: "memory"); }
            asm volatile("" ::: "memory"); __builtin_amdgcn_s_barrier(); asm volatile("" ::: "memory");
            const f32x4* pp = (const f32x4*)part + (wid * 64 + fq * 16 + fr);
#pragma unroll
            for (int ai = 0; ai < 2; ++ai)
#pragma unroll
                for (int bj = 0; bj < 2; ++bj) {
                    f32x4 t8[4][2];
#pragma unroll
                    for (int m = 0; m < 4; ++m)
#pragma unroll
                        for (int n = 0; n < 2; ++n) t8[m][n] = pp[(((ai * 2 + bj) * 4 + m) * 2 + n) * 512];
#pragma unroll
                    for (int m = 0; m < 4; ++m)
#pragma unroll
                        for (int n = 0; n < 2; ++n) acc[ai][bj][m][n] += t8[m][n];
                    asm volatile("" : "+v"(acc[ai][bj][0][0]), "+v"(acc[ai][bj][0][1]), "+v"(acc[ai][bj][1][0]), "+v"(acc[ai][bj][1][1]), "+v"(acc[ai][bj][2][0]), "+v"(acc[ai][bj][2][1]), "+v"(acc[ai][bj][3][0]), "+v"(acc[ai][bj][3][1]) :: "memory"); }
            asm volatile("" : "+v"(fr), "+v"(fq));
        }
        const LAS float* rstd = (const LAS float*)(lds + RSTD_OFF);
        const LAS float* cp = (const LAS float*)(lds + CONVP_OFF + (ui & 1) * 4096);
        LAS float* ex = (LAS float*)(lds + EXCH_OFF);
#pragma unroll
        for (int ai = 0; ai < 2; ++ai) { const f32x4 rs4 = *(const LAS f32x4*)(rstd + ai * HALF + wr * 64 + 4 * fr);
#pragma unroll
            for (int m = 0; m < 4; ++m)
#pragma unroll
                for (int bj = 0; bj < 2; ++bj)
#pragma unroll
                    for (int n = 0; n < 2; ++n) acc[ai][bj][m][n] *= rs4[m]; }
        if (fr == 15) {
#pragma unroll
            for (int ai = 0; ai < 2; ++ai)
#pragma unroll
                for (int bj = 0; bj < 2; ++bj)
#pragma unroll
                    for (int n = 0; n < 2; ++n) { *(LAS f32x4*)(ex + ((wid * 2 + ai) * 2 + 0) * 64 + (bj * 2 + n) * 16 + fq * 4) = acc[ai][bj][2][n]; *(LAS f32x4*)(ex + ((wid * 2 + ai) * 2 + 1) * 64 + (bj * 2 + n) * 16 + fq * 4) = acc[ai][bj][3][n]; }
        }
        {
            const int colb = u.pn * BM + wc * 32 + 8 * fq;
            if (wr == 0 && fr == 0) {
#pragma unroll
                for (int rr = 0; rr < 2; ++rr)
#pragma unroll
                    for (int bj = 0; bj < 2; ++bj)
#pragma unroll
                        for (int n = 0; n < 2; ++n) *(f32x4*)(halo + ((size_t)u.pm * 4 + rr) * NFF1 + colb + bj * HALF + 4 * n) = acc[0][bj][rr][n];
            }
            if (wr == 1 && fr == 15) {
#pragma unroll
                for (int rr = 0; rr < 2; ++rr)
#pragma unroll
                    for (int bj = 0; bj < 2; ++bj)
#pragma unroll
                        for (int n = 0; n < 2; ++n) *(f32x4*)(halo + ((size_t)u.pm * 4 + 2 + rr) * NFF1 + colb + bj * HALF + 4 * n) = acc[1][bj][2 + rr][n];
            }
        }
        LDS_WAIT(); __builtin_amdgcn_s_barrier(); asm volatile("" ::: "memory");
        const int row0 = u.pm * BM + wr * 64 + 4 * fr, colo = u.pn * HALF + wc * 32 + 8 * fq;
        u32x2 hold[2][4];
        f32x2 kone = (f32x2){1.0f, 1.0f}; asm volatile("" : "+v"(kone));
#pragma unroll
        for (int n = 0; n < 2; ++n) {
            f32x4 pw[4][2];
#pragma unroll
            for (int p = 0; p < 4; ++p)
#pragma unroll
                for (int bj = 0; bj < 2; ++bj) pw[p][bj] = *(const LAS f32x4*)(cp + p * 256 + bj * HALF + wc * 32 + 8 * fq + 4 * n);
#pragma unroll
            for (int ai = 0; ai < 2; ++ai) {
                const int swv = (ai == 1 && wr == 0) ? wid + 4 : wid - 4, sai = (ai == 1 && wr == 1) ? 1 : 0; const bool have = !(ai == 0 && wr == 0);
                f32x4 pm1[2], pm2[2];
#pragma unroll
                for (int bj = 0; bj < 2; ++bj) {
                    f32x4 e0 = (f32x4){0.f, 0.f, 0.f, 0.f}, e1 = e0;
                    if (have) { e0 = *(const LAS f32x4*)(ex + ((swv * 2 + sai) * 2 + 0) * 64 + (bj * 2 + n) * 16 + fq * 4); e1 = *(const LAS f32x4*)(ex + ((swv * 2 + sai) * 2 + 1) * 64 + (bj * 2 + n) * 16 + fq * 4); }
#pragma unroll
                    for (int i = 0; i < 4; ++i) { pm1[bj][i] = dpp_shr1(e1[i], acc[ai][bj][3][n][i]); pm2[bj][i] = dpp_shr1(e0[i], acc[ai][bj][2][n][i]); }
                }
#pragma unroll
                for (int m = 0; m < 4; ++m) {
                    f32x4 hc[2];
#pragma unroll
                    for (int bj = 0; bj < 2; ++bj) {
                        const f32x4 cur = acc[ai][bj][m][n];
                        const f32x4 h1 = m == 0 ? pm1[bj] : acc[ai][bj][m == 0 ? 0 : m - 1][n];
                        const f32x4 h2 = m == 0 ? pm2[bj] : (m == 1 ? pm1[bj] : acc[ai][bj][m < 2 ? 0 : m - 2][n]);
                        hc[bj] = pw[3][bj] + pw[0][bj] * h2 + pw[1][bj] * h1 + pw[2][bj] * cur;
                    }
                    const f32x2 e01 = (f32x2){__builtin_amdgcn_exp2f(hc[0][0]), __builtin_amdgcn_exp2f(hc[0][1])}, e23 = (f32x2){__builtin_amdgcn_exp2f(hc[0][2]), __builtin_amdgcn_exp2f(hc[0][3])};
                    const f32x2 d01 = e01 + kone, d23 = e23 + kone;
                    const f32x4 r = (f32x4){__builtin_amdgcn_rcpf(d01[0]), __builtin_amdgcn_rcpf(d01[1]), __builtin_amdgcn_rcpf(d23[0]), __builtin_amdgcn_rcpf(d23[1])};
                    const f32x4 o = (hc[0] * hc[1]) * r;
                    u32x2 w; w.x = cvt_pk_bf16(o[0], o[1]); w.y = cvt_pk_bf16(o[2], o[3]);
                    if (n == 0) hold[ai][m] = w;
                    else *(u32x4*)(O + (size_t)(row0 + ai * HALF + m) * KFF2 + colo) = (u32x4){hold[ai][m].x, hold[ai][m].y, w.x, w.y};
                }
            }
        }
    }
};
}

#define XB_TMO      128
#define XB_XCNT(j)  (256  + 64 * (j))
#define XB_XSUB(j)  (1280 + 64 * (j))
#define XB_XGEN(j)  (2304 + 64 * (j))
#define XB_TOP      3328
#define XB_TOPGEN   3392
#define XCD_BAR_WORDS 3456
#define XB_SPIN_CAP (1u << 18)
__device__ __forceinline__ unsigned xb_ld(unsigned* p)              { return __hip_atomic_load(p, __ATOMIC_RELAXED, __HIP_MEMORY_SCOPE_AGENT); }
__device__ __forceinline__ unsigned xb_add(unsigned* p, unsigned v) { return __hip_atomic_fetch_add(p, v, __ATOMIC_RELAXED, __HIP_MEMORY_SCOPE_AGENT); }
__device__ __forceinline__ unsigned xb_xcc_id() { return (unsigned)__builtin_amdgcn_s_getreg((3 << 11) | 20) & 0xFu; }
#define XB_SPIN(cond, bar) do { unsigned _sp = 0; while (cond) { __builtin_amdgcn_s_sleep(1); \
    if ((++_sp & 255u) == 0u) { if (xb_ld(&(bar)[XB_TMO])) break; if (_sp > XB_SPIN_CAP) { atomicAdd(&(bar)[XB_TMO], 1u); break; } } } } while (0)
struct XcdBarrier { unsigned* bar; unsigned x; volatile LAS unsigned* st; };
__device__ __forceinline__ XcdBarrier xcd_barrier_post(unsigned* bar, volatile LAS unsigned* st) {
    XcdBarrier b; b.bar = bar; b.x = xb_xcc_id(); b.st = st;
    if (threadIdx.x == 0) (void)xb_add(&bar[XB_XCNT(b.x)], 1u);
    return b;
}
__device__ __forceinline__ void xcd_barrier_complete(unsigned* bar, unsigned x, unsigned& nloc, unsigned& nx) {
    const unsigned G = gridDim.x * gridDim.y * gridDim.z;
    unsigned sum, cnt, mine, sp = 0u;
    for (;;) {
        sum = 0u; cnt = 0u; mine = 0u;
#pragma unroll
        for (unsigned j = 0; j < 16; ++j) { const unsigned c = xb_ld(&bar[XB_XCNT(j)]); sum += c; cnt += (c > 0u) ? 1u : 0u; mine = (j == x) ? c : mine; }
        if (sum == G) break;
        __builtin_amdgcn_s_sleep(1);
        if ((++sp & 255u) == 0u) { if (xb_ld(&bar[XB_TMO])) break; if (sp > XB_SPIN_CAP) { atomicAdd(&bar[XB_TMO], 1u); break; } }
    }
    nloc = mine > 0u ? mine : 1u; nx = cnt > 0u ? cnt : 1u;
}
__device__ __forceinline__ void xcd_barrier(const XcdBarrier& b) {
    asm volatile("s_waitcnt vmcnt(0)" ::: "memory");
    __syncthreads();
    if (threadIdx.x == 0) {
        unsigned* bar = b.bar;
        __builtin_amdgcn_s_waitcnt(0);
        unsigned nloc = b.st[0], nx = b.st[1];
        if (nloc == 0u) { xcd_barrier_complete(bar, b.x, nloc, nx); b.st[0] = nloc; b.st[1] = nx; }
        const unsigned old = xb_add(&bar[XB_XSUB(b.x)], 1u);
        const unsigned gen = old / nloc;
        if (old + 1u == (gen + 1u) * nloc) {
            __builtin_amdgcn_fence(__ATOMIC_RELEASE, "agent");
            asm volatile("s_waitcnt vmcnt(0)" ::: "memory");
            const unsigned og = xb_add(&bar[XB_TOP], 1u);
            const unsigned tg = og / nx;
            if (og + 1u == (tg + 1u) * nx) xb_add(&bar[XB_TOPGEN], 1u);
            else XB_SPIN(xb_ld(&bar[XB_TOPGEN]) == tg, bar);
            __builtin_amdgcn_fence(__ATOMIC_ACQUIRE, "agent");
            xb_add(&bar[XB_XGEN(b.x)], 1u);
            asm volatile("s_waitcnt vmcnt(0)" ::: "memory");
        } else {
            XB_SPIN(xb_ld(&bar[XB_XGEN(b.x)]) == gen, bar);
            __builtin_amdgcn_fence(__ATOMIC_ACQUIRE, "agent");
            asm volatile("s_waitcnt vmcnt(0)" ::: "memory");
        }
    }
    __syncthreads();
}

constexpr int NWAVES = 8;
#define WSP(T, off) ((T*)(F.ws + (off)))
struct Args { const float* in[16]; float* out; unsigned char* ws; int ph_lo, ph_hi, li, pad; };
struct Frame {
    LAS unsigned char* lds; int tid, lane, wave, vcu, G;
    unsigned char* ws; float* out;
};
__device__ __forceinline__ float wave_sum(float v) {
#pragma unroll
    for (int o = 1; o < 64; o <<= 1) v += __shfl_xor(v, o);
    return v;
}

constexpr int CV_NB1 = DFF2 / 64, CV_W1 = (D / 32) * CV_NB1, CV_KB2 = DFF / 32, CV_TOTAL = CV_W1 + CV_KB2 * (D / 64);
static_assert(DFF % 64 == 0 && DFF2 % 64 == 0 && DFF % 32 == 0 && D / 32 == 128, "SCANCVT block shapes");
struct CvBlk { const float* src; bf16* dst; unsigned lds; };
__device__ __forceinline__ CvBlk cv_decode(const float* w1src, const float* w2src, unsigned char* ws, int id, int lane) {
    CvBlk b;
    if (id < CV_W1) { const int kb = id & (D / 32 - 1), nb = id >> 7, n = 64 * nb + lane;        const int f0 = n < DFF ? n : n - DFF; const int rowdst = 256 * (f0 >> 7) + (n < DFF ? 0 : 128) + (f0 & 127);
        b.src = w1src + (size_t)D * DFF2 + (size_t)(32 * kb) * DFF2 + n; b.dst = (bf16*)(ws + WS_W1) + (size_t)NFF1 * D + (size_t)rowdst * D + 32 * kb; b.lds = (unsigned)DFF2; }
    else { const int id2 = id - CV_W1, kb = id2 >> 6, nb = id2 & 63, n = 64 * nb + lane;
        b.src = w2src + (size_t)DFF * D + (size_t)(32 * kb) * D + n; b.dst = (bf16*)(ws + WS_W2) + (size_t)D * KFF2 + (size_t)n * KFF2 + 32 * kb; b.lds = (unsigned)D; }
    return b;
}
__device__ __forceinline__ void cv_load(const CvBlk& b, float (&v)[32]) {
#pragma unroll
    for (int i = 0; i < 32; ++i) v[i] = __builtin_nontemporal_load(b.src + (size_t)i * b.lds);
}
__device__ __forceinline__ void cv_store(const CvBlk& b, const float (&v)[32]) {
#pragma unroll
    for (int q = 0; q < 4; ++q) { u32x4 o; o.x = cvt_pk_bf16(v[8 * q], v[8 * q + 1]); o.y = cvt_pk_bf16(v[8 * q + 2], v[8 * q + 3]); o.z = cvt_pk_bf16(v[8 * q + 4], v[8 * q + 5]); o.w = cvt_pk_bf16(v[8 * q + 6], v[8 * q + 7]);
        *(u32x4*)(b.dst + 8 * q) = o; }
}

__device__ __forceinline__ void tr_item(const float* W, size_t ldw, int k0, int n0, bf16* WT, size_t ldt, int rowdst, LAS float* scr, int lane) {
#pragma unroll 8
    for (int i = 0; i < 32; ++i) { const int kk = 2 * i + (lane >> 5); scr[kk * 33 + (lane & 31)] = __builtin_nontemporal_load(W + (size_t)(k0 + kk) * ldw + n0 + (lane & 31)); }
    LDS_WAIT(); asm volatile("" ::: "memory");
    const int c = lane & 7;
#pragma unroll
    for (int j = 0; j < 4; ++j) { const int n = (lane >> 3) + 8 * j; const LAS float* s = scr + (8 * c) * 33 + n;
        u32x4 o; o.x = pk2(s[0 * 33], s[1 * 33]); o.y = pk2(s[2 * 33], s[3 * 33]); o.z = pk2(s[4 * 33], s[5 * 33]); o.w = pk2(s[6 * 33], s[7 * 33]);
        *(u32x4*)(WT + (size_t)(rowdst + n) * ldt + k0 + 8 * c) = o; }
    LDS_WAIT(); asm volatile("" ::: "memory");
}
__device__ __forceinline__ void rms_row_to_bf16(const float* xrow, const float* g, bf16* orow, int lane) {
    const f32x4* xr = (const f32x4*)xrow + lane; const f32x4* gr = (const f32x4*)g + lane;
    f32x4 v[16]; float s = 0.f;
#pragma unroll
    for (int j = 0; j < 16; ++j) { v[j] = __builtin_nontemporal_load(xr + 64 * j); s += (v[j][0] * v[j][0] + v[j][1] * v[j][1]) + (v[j][2] * v[j][2] + v[j][3] * v[j][3]); }
    const float rstd = 1.0f / sqrtf(wave_sum(s) * (1.f / D) + EPS);
    u32x2* o8 = (u32x2*)orow + lane;
#pragma unroll
    for (int j = 0; j < 16; ++j) { const f32x4 gg = gr[64 * j]; u32x2 w; w.x = pk2(v[j][0] * rstd * gg[0], v[j][1] * rstd * gg[1]); w.y = pk2(v[j][2] * rstd * gg[2], v[j][3] * rstd * gg[3]); o8[64 * j] = w; }
}
__device__ __forceinline__ void p0_prologue(Frame& F, const Args& args) {
    LAS float* scr = (LAS float*)(F.lds + RING_OFF + F.wave * 16384);
    const int gw = F.vcu * NWAVES + F.wave, NGW = F.G * NWAVES;
    constexpr int I_P = 64 * 384, I_O = 64 * 128, I_1 = 64 * 684, I_2 = 171 * 128, I_G = 16 * 32;
    constexpr int NITEMS = I_P + I_O + I_1 + I_2 + 4 * I_G;
    for (int it = gw; it < NITEMS; it += NGW) {
        int r = it + I_P; if (r >= NITEMS) r -= NITEMS;
        if (r < I_P) { const int kb = r / 384, nb = r % 384; tr_item(args.in[2], PROJ_W, 64 * kb, 32 * nb, WSP(bf16, WS_WP), D, 32 * nb, scr, F.lane); continue; } r -= I_P;
        if (r < I_O) { const int kb = r / 128, nb = r % 128; tr_item(args.in[6], D, 64 * kb, 32 * nb, WSP(bf16, WS_WO), D, 32 * nb, scr, F.lane); continue; } r -= I_O;
        if (r < I_1) { const int l = 0; const int kb = r / 684, nb = r % 684; const int n0 = 32 * nb; const int f0 = n0 < DFF ? n0 : n0 - DFF;
            const int rowdst = 256 * (f0 >> 7) + (n0 < DFF ? 0 : 128) + (f0 & 127);
            tr_item(args.in[11] + (size_t)l * D * DFF2, DFF2, 64 * kb, n0, WSP(bf16, WS_W1) + (size_t)l * NFF1 * D, D, rowdst, scr, F.lane); continue; } r -= I_1;
        if (r < I_2) { const int l = 0; const int kb = r / 128, nb = r % 128;
            tr_item(args.in[14] + (size_t)l * DFF * D, D, 64 * kb, 32 * nb, WSP(bf16, WS_W2) + (size_t)l * D * KFF2, KFF2, 32 * nb, scr, F.lane); continue; } r -= I_2;
        { const int gidx = r / I_G; r -= gidx * I_G; const int kb = r / 32, nb = r % 32;
            tr_item(args.in[8] + (size_t)gidx * 1024 * 1024, 1024, 64 * kb, 32 * nb, WSP(bf16, WS_WPOOL) + (size_t)gidx * 1024 * 1024, 1024, 32 * nb, scr, F.lane); }
    }
    {
        const int scan_blocks = ((256 + F.G - 1) / F.G) * (SEQ / 64) * NGW;
        for (int id = scan_blocks + gw; id < CV_TOTAL; id += NGW) { float v[32]; const CvBlk b = cv_decode(args.in[11], args.in[14], F.ws, id, F.lane); cv_load(b, v); cv_store(b, v); }
    }
    const int gt = F.vcu * (NWAVES * 64) + F.tid, NGT = F.G * NWAVES * 64;
    for (int i = gt; i < 2 * 128 * (D / 8); i += NGT) { const int l = i / (128 * (D / 8)), rr = (i / (D / 8)) % 128, c8 = i % (D / 8); const int row = 85 * 256 + (rr < 64 ? 64 + rr : 192 + (rr - 64));
        *(u32x4*)(WSP(bf16, WS_W1) + ((size_t)l * NFF1 + row) * D + 8 * c8) = (u32x4){0u, 0u, 0u, 0u}; }
    for (int i = gt; i < 2 * D * 8; i += NGT) { const int l = i / (D * 8), row = (i / 8) % D, c8 = i % 8; *(u32x4*)(WSP(bf16, WS_W2) + ((size_t)l * D + row) * KFF2 + DFF + 8 * c8) = (u32x4){0u, 0u, 0u, 0u}; }
    for (int i = gt; i < 2 * FT * 4 * 256; i += NGT) { const int cc = i & 255, p = (i >> 8) & 3, j = (i >> 10) % FT, l = i / (FT * 1024); const int f = 128 * j + (cc & 127); const int col = cc < 128 ? f : DFF + f;
        float v = 0.f; if (f < DFF) v = p < 3 ? args.in[12][((size_t)l * 3 + p) * DFF2 + col] : args.in[13][(size_t)l * DFF2 + col];
        WSP(float, WS_CONVP)[i] = v * (cc < 128 ? -1.44269504089f : -0.69314718056f); }
    for (int i = gt; i < 16 * D; i += NGT) { const int c = i & 15, k = i >> 4; WSP(bf16, WS_WG)[(size_t)c * D + k] = (bf16)f2bf(args.in[2][(size_t)k * PROJ_W + NPROJ + c]); }
    for (int m = gw; m < M; m += NGW) rms_row_to_bf16(args.in[0] + (size_t)m * D, args.in[1], WSP(bf16, WS_XA) + (size_t)m * D, F.lane);
}

__device__ __forceinline__ float softcap15(float a) { return 15.0f * tanhf(a * (1.0f / 15.0f)); }
__device__ __forceinline__ void p1_gates(Frame& F, const Args& args) {
    const int gw = F.vcu * NWAVES + F.wave, NGW = F.G * NWAVES; const int fr = F.lane & 15, fq = F.lane >> 4;
    for (int rb = gw; rb < M / 16; rb += NGW) {
        const bf16* ap = WSP(bf16, WS_XA) + (size_t)(rb * 16 + fr) * D + 8 * fq; const bf16* bp = WSP(bf16, WS_WG) + (size_t)fr * D + 8 * fq;
        f32x4 acc = (f32x4){0.f, 0.f, 0.f, 0.f};
#pragma unroll 16
        for (int k = 0; k < D; k += 32) { const bf16x8 a = *(const bf16x8*)(ap + k); const bf16x8 b = *(const bf16x8*)(bp + k); acc = __builtin_amdgcn_mfma_f32_16x16x32_bf16(a, b, acc, 0, 0, 0); }
        const int c = fr; const float bias = c < 8 ? args.in[3][c] : args.in[4][c - 8];
#pragma unroll
        for (int r = 0; r < 4; ++r) { const float z = softcap15(acc[r] + bias); float o = z;
            if (c >= 8) o = fminf(z, 0.f) - log1pf(expf(-fabsf(z)));
            WSP(float, WS_GATES)[(size_t)(rb * 16 + 4 * fq + r) * 16 + c] = o; }
    }
}

__device__ __forceinline__ float row_sum16(float x) {
    x += __builtin_bit_cast(float, __builtin_amdgcn_update_dpp(0, __builtin_bit_cast(int, x), 0x128, 0xf, 0xf, false));
    x += __builtin_bit_cast(float, __builtin_amdgcn_update_dpp(0, __builtin_bit_cast(int, x), 0x124, 0xf, 0xf, false));
    x += __builtin_bit_cast(float, __builtin_amdgcn_update_dpp(0, __builtin_bit_cast(int, x), 0x122, 0xf, 0xf, false));
    x += __builtin_bit_cast(float, __builtin_amdgcn_update_dpp(0, __builtin_bit_cast(int, x), 0x121, 0xf, 0xf, false));
    return x;
}
__device__ __forceinline__ float wave_scan_add(float x, int lane) {
#define SC_STEP(ctrl) x += __builtin_bit_cast(float, __builtin_amdgcn_update_dpp(0, __builtin_bit_cast(int, x), ctrl, 0xf, 0xf, true))
    SC_STEP(0x111); SC_STEP(0x112); SC_STEP(0x114); SC_STEP(0x118);
#undef SC_STEP
    const float t0 = __builtin_bit_cast(float, __builtin_amdgcn_readlane(__builtin_bit_cast(int, x), 15)), t1 = __builtin_bit_cast(float, __builtin_amdgcn_readlane(__builtin_bit_cast(int, x), 31)), t2 = __builtin_bit_cast(float, __builtin_amdgcn_readlane(__builtin_bit_cast(int, x), 47));
    const int g = lane >> 4; return x + (g >= 1 ? t0 : 0.f) + (g >= 2 ? t1 : 0.f) + (g >= 3 ? t2 : 0.f);
}
__device__ __forceinline__ float wave_scan_max(float x, int lane) {
    const int ninf = (int)0xff800000u;
#define SC_STEP(ctrl) x = fmaxf(x, __builtin_bit_cast(float, __builtin_amdgcn_update_dpp(ninf, __builtin_bit_cast(int, x), ctrl, 0xf, 0xf, false)))
    SC_STEP(0x111); SC_STEP(0x112); SC_STEP(0x114); SC_STEP(0x118);
#undef SC_STEP
    const float t0 = __builtin_bit_cast(float, __builtin_amdgcn_readlane(__builtin_bit_cast(int, x), 15)), t1 = __builtin_bit_cast(float, __builtin_amdgcn_readlane(__builtin_bit_cast(int, x), 31)), t2 = __builtin_bit_cast(float, __builtin_amdgcn_readlane(__builtin_bit_cast(int, x), 47));
    const int g = lane >> 4; const float ninff = __builtin_bit_cast(float, ninf);
    return fmaxf(fmaxf(x, g >= 1 ? t0 : ninff), fmaxf(g >= 2 ? t1 : ninff, g >= 3 ? t2 : ninff));
}
typedef short v4i16_t __attribute__((ext_vector_type(4)));
__device__ __forceinline__ v4i16_t tr16(const LAS unsigned char* p) { return __builtin_amdgcn_ds_read_tr16_b64_v4i16((LAS v4i16_t*)p); }
__device__ __forceinline__ bf16x8 cat8(v4i16_t a, v4i16_t b) { return (bf16x8){a[0], a[1], a[2], a[3], b[0], b[1], b[2], b[3]}; }
constexpr int SC_QS = 0, SC_KS = 33792, SC_VS = 67584, SC_VW = 84992, SC_SS = 102400, SC_HS = 111616, SC_FA = 129024;
static_assert(SC_FA + 8192 <= LDSCTL_OFF, "scan LDS map");
__device__ __forceinline__ void p2_scan(Frame& F, const Args& args) {
    LAS unsigned char* L = F.lds;
    LAS float* fa = (LAS float*)(L + SC_FA);
    LAS float *sA = fa, *sM = fa + 64, *sWi = fa + 128, *sEi = fa + 192, *sKw = fa + 256, *sInv = fa + 320, *rsp = fa + 384  , *qnp = fa + 640  , *sn = fa + 1152  , *ssp = fa + 1408  , *scal = fa + 1920;
    const int tid0 = F.tid, w = F.wave;
    const bf16* PROJ = WSP(bf16, WS_PROJ); bf16* HB = WSP(bf16, WS_HB); float* SSg = WSP(float, WS_SS); const float* GATES = WSP(float, WS_GATES);
    const __amdgpu_buffer_rsrc_t rsP = __builtin_amdgcn_make_buffer_rsrc((void*)PROJ, 0, 0x7fffffff, 0x00020000), rsH = __builtin_amdgcn_make_buffer_rsrc((void*)HB, 0, 0x7fffffff, 0x00020000);
#define SC_LDQ(i, soff) __builtin_bit_cast(u32x4, __builtin_amdgcn_raw_buffer_load_b128(rsP, (unsigned)((((tid + 512 * (i)) >> 5) * NPROJ + ((tid + 512 * (i)) & 31) * 8) * 2), (soff), 0))
#define SC_LDV(i, soff) __builtin_bit_cast(u32x4, __builtin_amdgcn_raw_buffer_load_b128(rsP, (unsigned)((((tid + 512 * (i)) >> 4) * NPROJ + ((tid + 512 * (i)) & 15) * 8) * 2), (soff), 2))
    int cvid = F.vcu * NWAVES + F.wave;
    for (int item = F.vcu; item < 256; item += F.G) {
        const int bh = item >> 2, es = item & 3, b = bh >> 3, h = bh & 7;
        f32x4 C[16];
#pragma unroll
        for (int i = 0; i < 16; ++i) C[i] = (f32x4){0.f, 0.f, 0.f, 0.f};
        __syncthreads();
        if (tid0 < 256) sn[tid0] = 0.f;
        if (tid0 == 0) scal[0] = 0.f;
        u32x4 qv[4], kv[4], vv[2]; float ig_n, lf_n;
        { const size_t row0 = (size_t)b * SEQ; const int tid = tid0; ig_n = GATES[(row0 + (tid & 63)) * 16 + h]; lf_n = GATES[(row0 + (tid & 63)) * 16 + 8 + h];
#pragma unroll
            for (int i = 0; i < 4; ++i) { const unsigned so = (unsigned)((row0 * NPROJ + h * DQK) * 2); qv[i] = SC_LDQ(i, so); kv[i] = SC_LDQ(i, so + QKW * 2); }
#pragma unroll
            for (int i = 0; i < 2; ++i) vv[i] = SC_LDV(i, (unsigned)((row0 * NPROJ + 2 * QKW + h * DV + es * 128) * 2)); }
        for (int c = 0; c <= SEQ / 64; ++c) {
            const size_t row0 = (size_t)b * SEQ + 64 * c;
            int tid = tid0; asm volatile("" : "+v"(tid));
            const int lane = tid & 63, fr = lane & 15, fq = lane >> 4, tq = fr >> 2, tp = fr & 3;
            __syncthreads();
            if (c > 0) {
                const size_t prow0 = row0 - 64;
#pragma unroll
                for (int i = 0; i < 2; ++i) { const int p = tid + 512 * i, row = p >> 4, cc = p & 15; __builtin_amdgcn_raw_buffer_store_b128(*(const LAS u32x4*)(L + SC_HS + row * 272 + cc * 16), rsH, (unsigned)((row * D + cc * 8) * 2), (unsigned)((prow0 * D + h * DV + es * 128) * 2), 0); }
                if (tid < 64) { float q = 0.f;
#pragma unroll
                    for (int p = 0; p < 8; ++p) q += ssp[p * 64 + tid];
                    SSg[(prow0 + tid) * 32 + h * 4 + es] = q; }
                if (tid == 0) scal[0] = scal[2];
            }
            if (c == SEQ / 64) break;
#pragma unroll
            for (int i = 0; i < 4; ++i) { const int p = tid + 512 * i, row = p >> 5, cc = p & 31; *(LAS u32x4*)(L + SC_QS + row * 528 + cc * 16) = qv[i]; *(LAS u32x4*)(L + SC_KS + row * 528 + cc * 16) = kv[i]; }
#pragma unroll
            for (int i = 0; i < 2; ++i) { const int p = tid + 512 * i, row = p >> 4, cc = p & 15; *(LAS u32x4*)(L + SC_VS + row * 272 + cc * 16) = vv[i]; }
            const float ig = ig_n, lf = lf_n;
            if (c + 1 < SEQ / 64) {
                const size_t nrow0 = row0 + 64; ig_n = GATES[(nrow0 + lane) * 16 + h]; lf_n = GATES[(nrow0 + lane) * 16 + 8 + h];
#pragma unroll
                for (int i = 0; i < 4; ++i) { const unsigned so = (unsigned)((nrow0 * NPROJ + h * DQK) * 2); qv[i] = SC_LDQ(i, so); kv[i] = SC_LDQ(i, so + QKW * 2); }
#pragma unroll
                for (int i = 0; i < 2; ++i) vv[i] = SC_LDV(i, (unsigned)((nrow0 * NPROJ + 2 * QKW + h * DV + es * 128) * 2));
            }
            float cv[32]; CvBlk cvb; const bool cvon = cvid < CV_TOTAL;
            if (cvon) { cvb = cv_decode(args.in[11], args.in[14], F.ws, cvid, tid & 63); cv_load(cvb, cv); }
            cvid += F.G * NWAVES;
            LDS_WAIT(); __builtin_amdgcn_s_barrier(); asm volatile("" ::: "memory");
            if (w == 0) {
                const float bs = wave_scan_add(lf, lane);
                const float a = ig - bs; const float pm = wave_scan_max(a, lane);
                const float mprev = scal[0]; const float Mt = fmaxf(mprev, pm);
                const float M63 = __builtin_bit_cast(float, __builtin_amdgcn_readlane(__builtin_bit_cast(int, Mt), 63)), b63 = __builtin_bit_cast(float, __builtin_amdgcn_readlane(__builtin_bit_cast(int, bs), 63));
                sA[lane] = a; sM[lane] = Mt; sWi[lane] = __expf(mprev - Mt); sEi[lane] = __expf(-(bs + Mt)); sKw[lane] = __expf(a - M63);
                if (lane == 0) { scal[1] = __expf(mprev - M63); scal[2] = b63 + M63; }
            }
            { const int t = tid & 63; float s = 0.f;
#pragma unroll
                for (int j = 0; j < 4; ++j) { const int d0 = w * 32 + 8 * j; const u32x4 q = *(const LAS u32x4*)(L + SC_QS + t * 528 + d0 * 2); const LAS float* np = sn + d0;
                    s += bf2f(q.x & 0xffffu) * np[0] + bf2f(q.x >> 16) * np[1] + bf2f(q.y & 0xffffu) * np[2] + bf2f(q.y >> 16) * np[3] + bf2f(q.z & 0xffffu) * np[4] + bf2f(q.z >> 16) * np[5] + bf2f(q.w & 0xffffu) * np[6] + bf2f(q.w >> 16) * np[7]; }
                qnp[w * 64 + t] = s; }
            const int tr = w >> 1, tc0 = (w & 1) * 2; f32x4 s0 = (f32x4){0.f, 0.f, 0.f, 0.f}, s1 = s0;
#pragma unroll
            for (int kk = 0; kk < 8; ++kk) { const bf16x8 a = *(const LAS bf16x8*)(L + SC_QS + (16 * tr + fr) * 528 + (32 * kk + 8 * fq) * 2);
                const bf16x8 b0 = *(const LAS bf16x8*)(L + SC_KS + (16 * tc0 + fr) * 528 + (32 * kk + 8 * fq) * 2); const bf16x8 b1 = *(const LAS bf16x8*)(L + SC_KS + (16 * tc0 + 16 + fr) * 528 + (32 * kk + 8 * fq) * 2);
                s0 = __builtin_amdgcn_mfma_f32_16x16x32_bf16(a, b0, s0, 0, 0, 0); s1 = __builtin_amdgcn_mfma_f32_16x16x32_bf16(a, b1, s1, 0, 0, 0); }
            __syncthreads();
#pragma unroll
            for (int q = 0; q < 2; ++q) { const int tc = tc0 + q, sidx = 16 * tc + fr; const float as = sA[sidx];
#pragma unroll
                for (int r = 0; r < 4; ++r) { const int t = 16 * tr + 4 * fq + r; const float e = __expf(fminf(as - sM[t], 0.f)); const float wgt = (sidx <= t) ? e : 0.f; const float v = (q == 0 ? s0[r] : s1[r]) * wgt;
                    *(LAS unsigned short*)(L + SC_SS + (t * 72 + sidx) * 2) = (unsigned short)cvt_pk_bf16(v, v);
                    rsp[t * 4 + tc] = row_sum16(v); } }
#pragma unroll
            for (int i = 0; i < 2; ++i) { const int p = tid + 512 * i, row = p >> 4, cc = p & 15; const float kw = sKw[row]; const u32x4 v = *(const LAS u32x4*)(L + SC_VS + row * 272 + cc * 16); u32x4 o;
                o.x = cvt_pk_bf16(kw * bf2f(v.x & 0xffffu), kw * bf2f(v.x >> 16)); o.y = cvt_pk_bf16(kw * bf2f(v.y & 0xffffu), kw * bf2f(v.y >> 16));
                o.z = cvt_pk_bf16(kw * bf2f(v.z & 0xffffu), kw * bf2f(v.z >> 16)); o.w = cvt_pk_bf16(kw * bf2f(v.w & 0xffffu), kw * bf2f(v.w >> 16));
                *(LAS u32x4*)(L + SC_VW + row * 272 + cc * 16) = o; }
            __syncthreads();
            if (tid < 64) { const int t = tid; float qn = 0.f;
#pragma unroll
                for (int p = 0; p < 8; ++p) qn += qnp[p * 64 + t];
                const float den = sWi[t] * qn + ((rsp[t * 4 + 0] + rsp[t * 4 + 1]) + (rsp[t * 4 + 2] + rsp[t * 4 + 3]));
                sInv[t] = 1.0f / fmaxf(fabsf(den), sEi[t]); }
            f32x4 nacc[4];
#pragma unroll
            for (int tt = 0; tt < 4; ++tt) nacc[tt] = (f32x4){0.f, 0.f, 0.f, 0.f};
#pragma unroll
            for (int kk = 0; kk < 8; ++kk) {
                u32x4 bw; bw.x = cvt_pk_bf16(C[2 * kk][0], C[2 * kk][1]); bw.y = cvt_pk_bf16(C[2 * kk][2], C[2 * kk][3]); bw.z = cvt_pk_bf16(C[2 * kk + 1][0], C[2 * kk + 1][1]); bw.w = cvt_pk_bf16(C[2 * kk + 1][2], C[2 * kk + 1][3]);
                const bf16x8 bq = __builtin_bit_cast(bf16x8, bw);
#pragma unroll
                for (int tt = 0; tt < 4; ++tt) { const bf16x8 a = *(const LAS bf16x8*)(L + SC_QS + (16 * tt + fr) * 528 + (32 * kk + 8 * fq) * 2);
                    nacc[tt] = __builtin_amdgcn_mfma_f32_16x16x32_bf16(a, bq, nacc[tt], 0, 0, 0); }
            }
#pragma unroll
            for (int tt = 0; tt < 4; ++tt)
#pragma unroll
                for (int r = 0; r < 4; ++r) nacc[tt][r] *= sWi[16 * tt + 4 * fq + r];
#pragma unroll
            for (int kk = 0; kk < 2; ++kk) { const LAS unsigned char* vp = L + SC_VS + (32 * kk + 8 * fq + tq) * 272 + (16 * w + 4 * tp) * 2;
                const bf16x8 bv = cat8(tr16(vp), tr16(vp + 4 * 272));
#pragma unroll
                for (int tt = 0; tt < 4; ++tt) { const bf16x8 as = *(const LAS bf16x8*)(L + SC_SS + ((16 * tt + fr) * 72 + 32 * kk + 8 * fq) * 2);
                    nacc[tt] = __builtin_amdgcn_mfma_f32_16x16x32_bf16(as, bv, nacc[tt], 0, 0, 0); } }
            __syncthreads();
#pragma unroll
            for (int tt = 0; tt < 4; ++tt)
#pragma unroll
                for (int r = 0; r < 4; ++r) { const int t = 16 * tt + 4 * fq + r; const float hv = nacc[tt][r] * sInv[t];
                    *(LAS unsigned short*)(L + SC_HS + t * 272 + (16 * w + fr) * 2) = (unsigned short)cvt_pk_bf16(hv, hv);
                    ssp[w * 64 + t] = row_sum16(hv * hv); }
            const float aprev = scal[1];
#pragma unroll
            for (int i = 0; i < 16; ++i) C[i] *= aprev;
            f32x4 ninc0 = (f32x4){0.f, 0.f, 0.f, 0.f}, ninc1 = ninc0;
#pragma unroll
            for (int kk = 0; kk < 2; ++kk) { const LAS unsigned char* vp = L + SC_VW + (32 * kk + 8 * fq + tq) * 272 + (16 * w + 4 * tp) * 2;
                const bf16x8 bvw = cat8(tr16(vp), tr16(vp + 4 * 272));
                u32x4 kn; { const LAS float* kp = sKw + 32 * kk + 8 * fq; kn.x = cvt_pk_bf16(kp[0], kp[1]); kn.y = cvt_pk_bf16(kp[2], kp[3]); kn.z = cvt_pk_bf16(kp[4], kp[5]); kn.w = cvt_pk_bf16(kp[6], kp[7]); }
                const bf16x8 bn = __builtin_bit_cast(bf16x8, kn);
                const LAS unsigned char* kp0 = L + SC_KS + (32 * kk + 8 * fq + tq) * 528 + (8 * tp) * 2;
#pragma unroll
                for (int T = 0; T < 16; ++T) { const LAS unsigned char* kp = kp0 + (32 * (T >> 1) + 4 * (T & 1)) * 2;
                    const bf16x8 ak = cat8(tr16(kp), tr16(kp + 4 * 528));
                    C[T] = __builtin_amdgcn_mfma_f32_16x16x32_bf16(ak, bvw, C[T], 0, 0, 0); }
                { const LAS unsigned char* kp = kp0 + (32 * w) * 2; const bf16x8 a0 = cat8(tr16(kp), tr16(kp + 4 * 528)), a1 = cat8(tr16(kp + 8), tr16(kp + 8 + 4 * 528));
                    ninc0 = __builtin_amdgcn_mfma_f32_16x16x32_bf16(a0, bn, ninc0, 0, 0, 0); ninc1 = __builtin_amdgcn_mfma_f32_16x16x32_bf16(a1, bn, ninc1, 0, 0, 0); } }
            {
#pragma unroll
                for (int r = 0; r < 4; ++r) { const int d0 = 32 * w + 8 * fq + r; const float n0 = aprev * sn[d0] + ninc0[r], n1 = aprev * sn[d0 + 4] + ninc1[r]; sn[d0] = n0; sn[d0 + 4] = n1; } }
            if (cvon) cv_store(cvb, cv);
        }
    }
    __syncthreads();
#undef SC_LDQ
#undef SC_LDV
}

__device__ __forceinline__ void p3_headnorm(Frame& F, const Args& args) {
    const int gw = F.vcu * NWAVES + F.wave, NGW = F.G * NWAVES;
    for (int m = gw; m < M; m += NGW) {
        u32x4 hva[8], ova[8];
#pragma unroll
        for (int j = 0; j < 8; ++j) { const int col = 512 * j + 8 * F.lane; hva[j] = __builtin_nontemporal_load((const u32x4*)(WSP(bf16, WS_HB) + (size_t)m * D + col)); ova[j] = __builtin_nontemporal_load((const u32x4*)(WSP(bf16, WS_PROJ) + (size_t)m * NPROJ + 2 * QKW + VW + col)); }
#pragma unroll
        for (int j = 0; j < 8; ++j) {
            const f32x4 s4 = *(const f32x4*)(WSP(float, WS_SS) + (size_t)m * 32 + 4 * j); const float r = 1.0f / sqrtf(((s4[0] + s4[1]) + (s4[2] + s4[3])) * (1.f / DV) + EPS);
            const int col = 512 * j + 8 * F.lane;
            const u32x4 hv = hva[j]; const u32x4 ov = ova[j];
            const f32x4 g0 = *(const f32x4*)(args.in[5] + col), g1 = *(const f32x4*)(args.in[5] + col + 4);
            const unsigned hw[4] = {hv.x, hv.y, hv.z, hv.w}, ow[4] = {ov.x, ov.y, ov.z, ov.w}; const float gg[8] = {g0[0], g0[1], g0[2], g0[3], g1[0], g1[1], g1[2], g1[3]}; unsigned res[4];
#pragma unroll
            for (int q = 0; q < 4; ++q) { const float h0 = bf2f(hw[q] & 0xffffu), h1 = bf2f(hw[q] >> 16), o0 = bf2f(ow[q] & 0xffffu), o1 = bf2f(ow[q] >> 16);
                const float y0 = h0 * r * gg[2 * q] / (1.0f + __expf(-o0)), y1 = h1 * r * gg[2 * q + 1] / (1.0f + __expf(-o1)); res[q] = pk2(y0, y1); }
            *(u32x4*)(WSP(bf16, WS_XB) + (size_t)m * D + col) = (u32x4){res[0], res[1], res[2], res[3]};
        }
    }
}

__device__ __forceinline__ void rstd_to_lds(Frame& F, int pm) {
    __syncthreads();
    if (F.tid < 256) { const f32x4* p = (const f32x4*)(WSP(float, WS_RSS) + (size_t)(pm * 256 + F.tid) * 64); float s = 0.f;
#pragma unroll
        for (int j = 0; j < 16; ++j) { const f32x4 v = p[j]; s += (v[0] + v[1]) + (v[2] + v[3]); }
        ((LAS float*)(F.lds + RSTD_OFF))[F.tid] = 1.0f / sqrtf(s * (1.f / D) + EPS); }
    VM_WAIT(); LDS_WAIT();
    __syncthreads();
}

__device__ __forceinline__ void p6_fixup(Frame& F, int layer, bf16* __restrict__ GATED) {
    const int gt = F.vcu * (NWAVES * 64) + F.tid, NGT = F.G * NWAVES * 64;
    const float* __restrict__ cpl = WSP(float, WS_CONVP) + (size_t)layer * FT * 1024; const float* __restrict__ HALO = WSP(float, WS_HALO);
    for (int i = gt; i < 64 * FT * 128; i += NGT) { const int ci = i & 127, pn = (i >> 7) % FT, pm = i / (FT * 128); if ((pm & 7) == 0) continue;
        float hc[2][2];
#pragma unroll
        for (int bj = 0; bj < 2; ++bj) { const int col = 256 * pn + 128 * bj + ci; const float* cp = cpl + (size_t)pn * 1024 + 128 * bj + ci;
            const float w0 = cp[0], w1 = cp[256], w2 = cp[512], cb = cp[768];
            const float hm2 = HALO[((size_t)(pm - 1) * 4 + 2) * NFF1 + col], hm1 = HALO[((size_t)(pm - 1) * 4 + 3) * NFF1 + col], h0 = HALO[((size_t)pm * 4 + 0) * NFF1 + col], h1 = HALO[((size_t)pm * 4 + 1) * NFF1 + col];
            hc[bj][0] = cb + w0 * hm2 + w1 * hm1 + w2 * h0; hc[bj][1] = cb + w0 * hm1 + w1 * h0 + w2 * h1; }
#pragma unroll
        for (int rr = 0; rr < 2; ++rr) GATED[(size_t)(pm * 256 + rr) * KFF2 + 128 * pn + ci] = (bf16)f2bf(hc[0][rr] * hc[1][rr] * __builtin_amdgcn_rcpf(1.0f + __builtin_amdgcn_exp2f(hc[0][rr])));
    }
}

__device__ __forceinline__ f32x2 ld_bf2(const bf16* p) { const unsigned w = *(const unsigned*)p; return (f32x2){bf2f(w & 0xffffu), bf2f(w >> 16)}; }
template <int W> __device__ __forceinline__ void pool_cols(const bf16* xb, const LAS float* rs, const f32x2 g, bf16* ob, int tb) {
    f32x2 prev[16], cur[16]; unsigned raw[16];
#pragma unroll
    for (int i = 0; i < 16; ++i) { if (tb == 0) prev[i] = (f32x2){0.f, 0.f}; else prev[i] = ld_bf2(xb + (size_t)i * D) * rs[i] * g; }
#pragma unroll
    for (int i = 0; i < 16; ++i) raw[i] = *(const unsigned*)(xb + (size_t)(16 + i) * D);
#pragma unroll 1
    for (int blk = 0; blk < 4; ++blk) {
#pragma unroll
        for (int i = 0; i < 16; ++i) cur[i] = (f32x2){bf2f(raw[i] & 0xffffu), bf2f(raw[i] >> 16)} * rs[16 + 16 * blk + i] * g;
        if (blk < 3) {
#pragma unroll
            for (int i = 0; i < 16; ++i) raw[i] = *(const unsigned*)(xb + (size_t)(32 + 16 * blk + i) * D); }
#pragma unroll
        for (int i = 0; i < 16; ++i) { f32x2 s = cur[i];
#pragma unroll
            for (int j = 1; j < W; ++j) s += (i - j >= 0) ? cur[(i - j) & 15] : prev[(16 + i - j) & 15];
            const int t = 64 * tb + 16 * blk + i; const float inv = 1.0f / (float)((t + 1) < W ? (t + 1) : W);
            const f32x2 o = s * inv - cur[i];
            *(unsigned*)(ob + (size_t)(16 * blk + i) * D) = pk2(o[0], o[1]); }
#pragma unroll
        for (int i = 0; i < 16; ++i) prev[i] = cur[i];
    }
}
__device__ __forceinline__ void p8_pool(Frame& F, const Args& args) {
    LAS float* rs = (LAS float*)(F.lds);
    for (int item = F.vcu; item < 256; item += F.G) {
        const int b = item >> 5, tb = item & 31; const size_t r0 = (size_t)b * SEQ + 64 * tb;
        __syncthreads();
        if (F.tid < 80) { float v = 0.f; if (tb > 0 || F.tid >= 16) { const f32x4* p = (const f32x4*)(WSP(float, WS_RSS) + (r0 - 16 + F.tid) * 64); float s = 0.f;
#pragma unroll
                for (int j = 0; j < 16; ++j) { const f32x4 q = p[j]; s += (q[0] + q[1]) + (q[2] + q[3]); }
                v = 1.0f / sqrtf(s * (1.f / D) + EPS); }
            rs[F.tid] = v; }
        __syncthreads();
#pragma unroll 1
        for (int part = 0; part < 4; ++part) { const int q = F.tid + 512 * part, col = 2 * q, grp = part;
            const f32x2 g = *(const f32x2*)(args.in[7] + col); const bf16* xb = WSP(bf16, WS_XA) + (r0 - 16) * D + col; bf16* ob = WSP(bf16, WS_XB) + r0 * D + col;
            if (grp == 0) pool_cols<2>(xb, rs, g, ob, tb); else if (grp == 1) pool_cols<4>(xb, rs, g, ob, tb); else if (grp == 2) pool_cols<8>(xb, rs, g, ob, tb); else pool_cols<16>(xb, rs, g, ob, tb); }
    }
    __syncthreads();
}

__device__ __forceinline__ void p13_final(Frame& F, const Args& args) {
    const int gw = F.vcu * NWAVES + F.wave, NGW = F.G * NWAVES;
    for (int m = gw; m < M; m += NGW) {
        const float rstd = 1.0f / sqrtf(wave_sum(WSP(float, WS_RSS)[(size_t)m * 64 + F.lane]) * (1.f / D) + EPS);
        const u32x4* xr = (const u32x4*)(WSP(bf16, WS_XA) + (size_t)m * D) + F.lane; f32x4* orow = (f32x4*)(F.out + (size_t)m * D) + 2 * F.lane; const f32x4* gr = (const f32x4*)args.in[15] + 2 * F.lane;
        u32x4 xw[8];
#pragma unroll
        for (int j = 0; j < 8; ++j) xw[j] = __builtin_nontemporal_load(xr + 64 * j);
#pragma unroll
        for (int j = 0; j < 8; ++j) { const u32x4 w = xw[j]; const f32x4 g0 = gr[128 * j], g1 = gr[128 * j + 1];
            __builtin_nontemporal_store((f32x4){bf2f(w.x & 0xffffu), bf2f(w.x >> 16), bf2f(w.y & 0xffffu), bf2f(w.y >> 16)} * rstd * g0, orow + 128 * j);
            __builtin_nontemporal_store((f32x4){bf2f(w.z & 0xffffu), bf2f(w.z >> 16), bf2f(w.w & 0xffffu), bf2f(w.w >> 16)} * rstd * g1, orow + 128 * j + 1); }
    }
}

__global__ void __launch_bounds__(NWAVES * 64, 2) fwd(Args args) {
    extern __shared__ __attribute__((aligned(16))) unsigned char lds[];
    Frame F;
    F.lds = (LAS unsigned char*)lds;
    F.tid = threadIdx.x; F.lane = F.tid & 63; F.wave = __builtin_amdgcn_readfirstlane(F.tid >> 6);
    F.G = gridDim.x; { const int bx = blockIdx.x; F.vcu = (F.G % 8 == 0) ? (bx % 8) * (F.G / 8) + bx / 8 : bx; }
    unsigned char* ws = args.ws; F.ws = ws; F.out = args.out;
    gu32* ctl = (gu32*)(ws + WS_CTL);
    for (int u = F.tid; u < (LDS_BYTES - LDSCTL_OFF) / 4; u += NWAVES * 64) ((LAS unsigned*)(F.lds + LDSCTL_OFF))[u] = 0u;
    __syncthreads();
    XcdBarrier bar; bar.bar = (unsigned*)(ctl + CW_BAR); bar.x = 0; bar.st = nullptr;
    if (MK_N_LAUNCHES == 1) bar = xcd_barrier_post((unsigned*)(ctl + CW_BAR), (volatile LAS unsigned*)(F.lds + MISC_OFF));
#define GRID_BAR() do { if (MK_N_LAUNCHES == 1) xcd_barrier(bar); } while (0)
    const int lo = args.ph_lo, hi = args.ph_hi;
#ifndef PHASE_MASK
#define PHASE_MASK 0x3fff
#endif
#define IN(k) ((((PHASE_MASK) >> (k)) & 1) && lo <= (k) && (k) < hi)
#define BOTH(k) (IN(k) && IN((k) + 1))
    bf16* GATED = WSP(bf16, WS_PROJ);
    const int c = (int)blockIdx.x;

    if (IN(0)) { p0_prologue(F, args); if (BOTH(0)) GRID_BAR(); }
    if (IN(1)) {
        pg8::Gemm g{WSP(bf16, WS_XA), WSP(bf16, WS_WP), D, D, D, 0, 0}; pg8::RowOrder S; S.init(NPROJ / 256, c);
        pg8::EpiProj E{WSP(bf16, WS_PROJ), NPROJ};
        pg8::gemm_phase(F.lds + RING_OFF, g, S, E);
        p1_gates(F, args);
        if (BOTH(1)) GRID_BAR();
    }
    if (IN(2)) { p2_scan(F, args); if (BOTH(2)) GRID_BAR(); }
    if (IN(3)) { p3_headnorm(F, args); if (BOTH(3)) GRID_BAR(); }
    if (IN(4)) {
        pg8::Gemm g{WSP(bf16, WS_XB), WSP(bf16, WS_WO), D, D, D, 0, 0}; pg8::RowOrder S; S.init(D / 256, c);
        pg8::EpiResid<true> E{args.in[0], nullptr, nullptr, WSP(bf16, WS_XA), args.in[10], WSP(float, WS_RSS)};
        pg8::gemm_phase(F.lds + RING_OFF, g, S, E);
        if (BOTH(4)) GRID_BAR();
    }
    if (IN(5)) {
        pg8::Gemm g{WSP(bf16, WS_XA), WSP(bf16, WS_W1), D, D, D, 0, 0}; pg8::RowOrder S; S.init(FT - 2, c);
        rstd_to_lds(F, S.pm);
        float* part = WSP(float, WS_PART) + (size_t)(c & 127) * 65536; unsigned* sflag = (unsigned*)(ctl + CW_SPLIT + 64 * (c & 127));
        { pg8::EpiFfn1T<0> E{GATED, WSP(float, WS_CONVP), WSP(float, WS_HALO), F.lds, part, sflag, 1u};
          pg8::gemm_phase(F.lds + RING_OFF, g, S, E); }
        pg8::TailOrder T; T.init(c);
        if (T.pn0 < 2) { pg8::EpiFfn1T<1> E{GATED, WSP(float, WS_CONVP), WSP(float, WS_HALO), F.lds, part, sflag, 1u}; pg8::gemm_phase(F.lds + RING_OFF, g, T, E); }
        else { pg8::EpiFfn1T<2> E{GATED, WSP(float, WS_CONVP), WSP(float, WS_HALO), F.lds, part, sflag, 1u}; pg8::gemm_phase(F.lds + RING_OFF, g, T, E); }
        if (BOTH(5)) GRID_BAR();
    }
    if (IN(6)) { p6_fixup(F, 0, GATED); if (BOTH(6)) GRID_BAR(); }
    if (IN(7)) {
        pg8::Gemm g{GATED, WSP(bf16, WS_W2), KFF2, KFF2, KFF2, 0, 0}; pg8::WideOrder S; S.init(D / 256, c);
        pg8::EpiResid<false> E{WSP(bf16, WS_XA), args.in[10], nullptr, WSP(bf16, WS_XA), nullptr, WSP(float, WS_RSS)};
        pg8::gemm_phase(F.lds + RING_OFF, g, S, E);
        if (BOTH(7)) GRID_BAR();
    }
    if (IN(8)) { p8_pool(F, args); if (BOTH(8)) GRID_BAR(); }
    if (IN(9)) {
        pg8::Gemm g{WSP(bf16, WS_XB), WSP(bf16, WS_WPOOL), D, 1024, 1024, 2, 1024}; pg8::RowOrder S; S.init(D / 256, c);
        pg8::EpiResid<false> E{WSP(bf16, WS_XA), nullptr, args.in[9], WSP(bf16, WS_XA), args.in[10] + D, WSP(float, WS_RSS)};
        pg8::gemm_phase(F.lds + RING_OFF, g, S, E);
        if (BOTH(9)) GRID_BAR();
    }
    if (IN(10)) {
        pg8::Gemm g{WSP(bf16, WS_XA), WSP(bf16, WS_W1) + (size_t)NFF1 * D, D, D, D, 0, 0}; pg8::RowOrder S; S.init(FT - 2, c);
        rstd_to_lds(F, S.pm);
        float* part = WSP(float, WS_PART) + (size_t)(c & 127) * 65536; unsigned* sflag = (unsigned*)(ctl + CW_SPLIT + 64 * (c & 127));
        { pg8::EpiFfn1T<0> E{GATED, WSP(float, WS_CONVP) + (size_t)FT * 1024, WSP(float, WS_HALO), F.lds, part, sflag, 2u};
          pg8::gemm_phase(F.lds + RING_OFF, g, S, E); }
        pg8::TailOrder T; T.init(c);
        if (T.pn0 < 2) { pg8::EpiFfn1T<1> E{GATED, WSP(float, WS_CONVP) + (size_t)FT * 1024, WSP(float, WS_HALO), F.lds, part, sflag, 2u}; pg8::gemm_phase(F.lds + RING_OFF, g, T, E); }
        else { pg8::EpiFfn1T<2> E{GATED, WSP(float, WS_CONVP) + (size_t)FT * 1024, WSP(float, WS_HALO), F.lds, part, sflag, 2u}; pg8::gemm_phase(F.lds + RING_OFF, g, T, E); }
        if (BOTH(10)) GRID_BAR();
    }
    if (IN(11)) { p6_fixup(F, 1, GATED); if (BOTH(11)) GRID_BAR(); }
    if (IN(12)) {
        pg8::Gemm g{GATED, WSP(bf16, WS_W2) + (size_t)D * KFF2, KFF2, KFF2, KFF2, 0, 0}; pg8::WideOrder S; S.init(D / 256, c);
        pg8::EpiResid<false> E{WSP(bf16, WS_XA), args.in[10] + D, nullptr, WSP(bf16, WS_XA), nullptr, WSP(float, WS_RSS)};
        pg8::gemm_phase(F.lds + RING_OFF, g, S, E);
        if (BOTH(12)) GRID_BAR();
    }
    if (IN(13)) { p13_final(F, args); }
#undef IN
#undef BOTH
}

extern "C" void kernel_launch(void* const* d_in, const int* in_sizes, int n_in, void* d_out, int out_size, void* d_ws, size_t ws_size, hipStream_t stream) {
    static int grid = 0;
    if (grid == 0) {
        if (n_in != 16 || out_size != M * D || ws_size < WS_END2) { fprintf(stderr, "kernel_launch: unexpected shapes (n_in %d, out %d, ws %zu, need %zu)\n", n_in, out_size, ws_size, (size_t)WS_END2); grid = -1; return; }
        if (hipFuncSetAttribute((const void*)fwd, hipFuncAttributeMaxDynamicSharedMemorySize, LDS_BYTES) != hipSuccess) { fprintf(stderr, "kernel_launch: hipFuncSetAttribute failed\n"); grid = -1; return; }
        int per_cu = 0;
        if (hipOccupancyMaxActiveBlocksPerMultiprocessor(&per_cu, (const void*)fwd, NWAVES * 64, LDS_BYTES) != hipSuccess || per_cu < 1) fprintf(stderr, "kernel_launch: occupancy query reports %d\n", per_cu);
        (void)hipGetLastError();
        grid = 256;
    }
    if (grid < 0) return;
    (void)hipMemsetAsync((char*)d_ws + WS_CTL, 0, CTL_ZERO_BYTES, stream);
    Args a{};
    for (int i = 0; i < 16; ++i) a.in[i] = (const float*)d_in[i];
    a.out = (float*)d_out; a.ws = (unsigned char*)d_ws;
    if (MK_N_LAUNCHES == 1) { a.ph_lo = 0; a.ph_hi = NPHASE; a.li = 0; hipLaunchKernelGGL(fwd, dim3(grid), dim3(NWAVES * 64), LDS_BYTES, stream, a); }
    else for (int p = 0; p < NPHASE; ++p) { a.ph_lo = p; a.ph_hi = p + 1; a.li = p; hipLaunchKernelGGL(fwd, dim3(grid), dim3(NWAVES * 64), LDS_BYTES, stream, a); }
}
```

```cpp
#include <hip/hip_runtime.h>
#include <cstdio>
#include <cstdint>

#ifndef MK_N_LAUNCHES
#define MK_N_LAUNCHES 1
#endif

#define GAS __attribute__((address_space(1)))
#define LAS __attribute__((address_space(3)))
typedef unsigned short bf16;
typedef short bf16x8 __attribute__((ext_vector_type(8)));
typedef short bf16x4 __attribute__((ext_vector_type(4)));
typedef float f32x4 __attribute__((ext_vector_type(4)));
typedef float f32x2 __attribute__((ext_vector_type(2)));
typedef unsigned u32x4 __attribute__((ext_vector_type(4)));
typedef unsigned u32x2 __attribute__((ext_vector_type(2)));
typedef GAS unsigned gu32;

constexpr int D = 4096, BATCH = 8, SEQ = 2048, M = BATCH * SEQ;
constexpr int NH = 8, DQK = 256, DV = 512, QKW = 2048, VW = 4096;
constexpr int NPROJ = 12288, PROJ_W = 12304;
constexpr int DFF = 10944, DFF2 = 21888, FT = 86, NFF1 = FT * 256  , KFF2 = FT * 128  ;
constexpr float EPS = 1e-6f;
constexpr int NPHASE = 14;

constexpr size_t MiB = 1u << 20;
constexpr size_t WS_CTL = 0, CTL_ZERO_BYTES = 131072;
constexpr size_t WS_WP = 2 * MiB;
constexpr size_t WS_WG = WS_WP + (size_t)NPROJ * D * 2;
constexpr size_t WS_WO = WS_WG + 1 * MiB;
constexpr size_t WS_W1 = WS_WO + (size_t)D * D * 2;
constexpr size_t WS_W2 = WS_W1 + 2 * (size_t)NFF1 * D * 2;
constexpr size_t WS_WPOOL = WS_W2 + 2 * (size_t)D * KFF2 * 2;
constexpr size_t WS_CONVP = WS_WPOOL + 4 * (size_t)1024 * 1024 * 2;
constexpr size_t WS_XA = WS_CONVP + 1 * MiB;
constexpr size_t WS_XB = WS_XA + (size_t)M * D * 2;
constexpr size_t WS_PROJ = WS_XB + (size_t)M * D * 2;
constexpr size_t WS_HB = WS_PROJ + (size_t)M * NPROJ * 2;
constexpr size_t WS_SS = WS_HB + (size_t)M * D * 2;
constexpr size_t WS_GATES = WS_SS + (size_t)M * 32 * 4;
constexpr size_t WS_RSS = WS_GATES + (size_t)M * 16 * 4;
constexpr size_t WS_HALO = WS_RSS + (size_t)M * 64 * 4;
constexpr size_t WS_END = WS_HALO + (size_t)64 * 4 * NFF1 * 4;
constexpr size_t WS_PART = WS_END, WS_END2 = WS_PART + (size_t)128 * 65536 * 4;
constexpr size_t WS_RINV = (WS_END2 + 4095) & ~(size_t)4095, WS_END3 = WS_RINV + (size_t)M * 4;
static_assert((size_t)M * KFF2 * 2 <= (size_t)M * NPROJ * 2, "GATED overlays PROJ");

constexpr int CW_TMO = 0, CW_BAR = 4096, CW_SPLIT = 8192;
static_assert((CW_BAR + 3456) <= CW_SPLIT && (CW_SPLIT + 64 * 128) * 4 <= (int)CTL_ZERO_BYTES, "control words inside the memset region");

constexpr int RING_OFF = 0, RING_BYTES = 131072;
constexpr int RSTD_OFF = 131072;
constexpr int CONVP_OFF = RSTD_OFF + 1024;
constexpr int EXCH_OFF = CONVP_OFF + 8192;
constexpr int LDSCTL_OFF = EXCH_OFF + 8192;
constexpr int MISC_OFF = LDSCTL_OFF + 64;
constexpr int LDS_BYTES = LDSCTL_OFF + 512;
static_assert(LDS_BYTES <= 160 * 1024, "LDS");

#define RLX_AGENT __ATOMIC_RELAXED, __HIP_MEMORY_SCOPE_AGENT
#define LDS_WAIT() asm volatile("s_waitcnt lgkmcnt(0)" ::: "memory")
#define VM_WAIT() asm volatile("s_waitcnt vmcnt(0)" ::: "memory")
__device__ __forceinline__ unsigned f2bf(float f) { unsigned u = __builtin_bit_cast(unsigned, f); return (u + 0x7fffu + ((u >> 16) & 1u)) >> 16; }
__device__ __forceinline__ unsigned pk2(float lo, float hi) { return f2bf(lo) | (f2bf(hi) << 16); }
__device__ __forceinline__ float bf2f(unsigned b) { return __builtin_bit_cast(float, b << 16); }
__device__ __forceinline__ unsigned cvt_pk_bf16(float lo, float hi) { unsigned r; asm volatile("v_cvt_pk_bf16_f32 %0, %1, %2" : "=v"(r) : "v"(lo), "v"(hi)); return r; }

#ifndef PG8_BAL
#define PG8_BAL 1
#endif
#ifndef PG8_LOADPRIO
#define PG8_LOADPRIO 1
#endif
namespace pg8 {
constexpr int BM = 256, BK = 64, HALF = 128, HTB = HALF * BK * 2, STAGE_BYTES = 8 * HTB;
__host__ __device__ __forceinline__ int lds_byte(int r, int c) { const int st = (r >> 4) * 2 + (c >> 5), rr = r & 15, cc = c & 31, ob = rr * 64 + cc * 2; return st * 1024 + (ob ^ (((ob >> 9) & 1) << 5)); }
__host__ __device__ __forceinline__ void stage_rc(int b, int& R, int& C) { const int st = b / 1024, sb = b % 1024, swz = sb ^ (((sb >> 9) & 1) << 5); R = (st >> 1) * 16 + swz / 64; C = (st & 1) * 32 + (swz % 64) / 2; }
__host__ __device__ __forceinline__ int perm32(int rho) { const int n = rho >> 4, i = rho & 15; return 8 * (i >> 2) + 4 * n + (i & 3); }

struct Unit { int pm, pn; int kt0, nkt; };
struct Gemm { const bf16* A; const bf16* Bt; int lda, ldb, K; int agrp_shift, agrp_stride; };

struct RowOrder {
    static constexpr bool SPLIT = false;
    int pm, pn0, nN;
    __device__ __forceinline__ void init(int nN_, int c) { const int x = c & 7, j = c >> 3; pm = 8 * x + (j & 7); pn0 = j >> 3; nN = nN_; }
    __device__ __forceinline__ bool next(int i, Unit& u) const { const int pn = 4 * i + pn0; u.pm = pm; u.pn = pn; return pn < nN; }
};

struct WideOrder {
    static constexpr bool SPLIT = false;
    int x, j;
    __device__ __forceinline__ void init(int, int c) { x = c & 7; j = c >> 3; }
    __device__ __forceinline__ bool next(int i, Unit& u) const { u.pm = 8 * x + 4 * (i >> 1) + (j & 3); u.pn = 8 * (i & 1) + (j >> 2); return i < 4; }
};
struct TailOrder {
    static constexpr bool SPLIT = true;
    int pm, pn0;
    __device__ __forceinline__ void init(int c) { const int x = c & 7, j = c >> 3; pm = 8 * x + (j & 7); pn0 = j >> 3; }
    __device__ __forceinline__ bool next(int i, Unit& u) const { u.pm = pm; u.pn = 84 + (pn0 & 1); u.kt0 = pn0 < 2 ? 0 : 32; u.nkt = 32; return i == 0; }
};
template <class Epi, class Sched, int PV = 0>
__device__ __forceinline__ void gemm_phase(LAS unsigned char* lds, const Gemm g, const Sched& S, Epi& E) {
    const int tid = threadIdx.x, wid = __builtin_amdgcn_readfirstlane(tid >> 6), lane = tid & 63, wr = wid >> 2, wc = wid & 3, fr = lane & 15, fq = lane >> 4;
    int nt = g.K / BK;
    const unsigned kstep = (unsigned)(BK * 2);
    const unsigned hstepA = (unsigned)HALF * g.lda * 2, hstepB = (unsigned)HALF * g.ldb * 2;
    unsigned voffA0[2], voffB0[2];
#pragma unroll
    for (int i = 0; i < 2; ++i) { int R, C; stage_rc(tid * 16 + i * 8192, R, C); const int Rb = Epi::PERM ? ((R & ~31) + perm32(R & 31)) : R;
        const int Ra = Epi::APERM ? ((R & 64) + 4 * (R & 15) + ((R >> 4) & 3)) : R;
        voffA0[i] = (unsigned)(Ra * g.lda + C) * 2u; voffB0[i] = (unsigned)(Rb * g.ldb + C) * 2u; }
    const __amdgpu_buffer_rsrc_t rsA = __builtin_amdgcn_make_buffer_rsrc((void*)g.A, 0, 0x7fffffff, 0x00020000), rsB = __builtin_amdgcn_make_buffer_rsrc((void*)g.Bt, 0, 0x7fffffff, 0x00020000);
    const unsigned ldsw = (unsigned)wid * 1024u;
    const int aoff = lds_byte(wr * 64 + fr, fq * 8), boff = lds_byte(wc * 32 + fr, fq * 8);
#define PG8_SA(b, h) (((b) * 2 + (h)) * HTB)
#define PG8_SB(b, h) ((4 + (b) * 2 + (h)) * HTB)
#define PG8_STAGE(rs, bufoff, off, voff) do { _Pragma("unroll") for (int _i = 0; _i < 2; ++_i) \
        __builtin_amdgcn_raw_ptr_buffer_load_lds(rs, (LAS void*)(lds + (bufoff) + ldsw + _i * 8192), 16, (voff)[_i], (unsigned)(off), 0, 0); } while (0)
#define PG8_LDA(dst, b, h) do { _Pragma("unroll") for (int m = 0; m < 4; ++m) _Pragma("unroll") for (int k = 0; k < 2; ++k) dst[m][k] = *(const LAS bf16x8*)(lds + PG8_SA(b, h) + aoff + m * 2048 + k * 1024); } while (0)
#define PG8_LDB(dst, b, h) do { _Pragma("unroll") for (int n = 0; n < 2; ++n) _Pragma("unroll") for (int k = 0; k < 2; ++k) dst[n][k] = *(const LAS bf16x8*)(lds + PG8_SB(b, h) + boff + n * 2048 + k * 1024); } while (0)
#define PG8_CH(bj, Bf, m, n) do { _Pragma("unroll") for (int k = 0; k < 2; ++k) acc[ai_][bj][m][n] = __builtin_amdgcn_mfma_f32_16x16x32_bf16(Bf[n][k], At[m][k], acc[ai_][bj][m][n], 0, 0, 0); __builtin_amdgcn_sched_barrier(0); } while (0)
#define PG8_MMA2(ai, B0) do { constexpr int ai_ = ai; __builtin_amdgcn_s_setprio(1); \
          \
        PG8_CH(0, B0, 0, 0); PG8_CH(0, B0, 0, 1); PG8_CH(1, B1, 0, 0); PG8_CH(1, B1, 0, 1); \
        PG8_CH(1, B1, 1, 1); PG8_CH(1, B1, 1, 0); PG8_CH(0, B0, 1, 1); PG8_CH(0, B0, 1, 0); \
        PG8_CH(0, B0, 2, 0); PG8_CH(0, B0, 2, 1); PG8_CH(1, B1, 2, 0); PG8_CH(1, B1, 2, 1); \
        PG8_CH(1, B1, 3, 1); PG8_CH(1, B1, 3, 0); PG8_CH(0, B0, 3, 1); PG8_CH(0, B0, 3, 0); \
        __builtin_amdgcn_s_setprio(PG8_LOADPRIO); } while (0)
#define PG8_WAIT_V(n) asm volatile("s_waitcnt vmcnt(" #n ")" ::: "memory")
#define PG8_WAIT_VL(n) __builtin_amdgcn_s_waitcnt(0x0070 | (n))
#define PG8_BAR __builtin_amdgcn_s_barrier()
#define PG8_SCHED __builtin_amdgcn_sched_barrier(0)
#define PG8_ITER(oA1, oA2, oB2, oB3, lastrd) do { \
            PG8_LDB(B1, 0, 1); PG8_SCHED; PG8_LDA(At, 0, 0); PG8_STAGE(rsA, PG8_SA(1, 0), oA1, voffA0); PG8_STAGE(rsA, PG8_SA(1, 1), (oA1) + hstepA, voffA0); \
            PG8_WAIT_VL(6); PG8_BAR; PG8_MMA2(0, B0e); PG8_BAR; PG8_SCHED; \
            PG8_LDA(At, 0, 1); PG8_LDB(B0o, 1, 0); PG8_STAGE(rsB, PG8_SB(0, 0), oB2, voffB0); PG8_STAGE(rsB, PG8_SB(0, 1), (oB2) + hstepB, voffB0); \
            PG8_WAIT_VL(6); PG8_BAR; PG8_MMA2(1, B0e); PG8_BAR; PG8_SCHED; \
            PG8_LDB(B1, 1, 1); PG8_SCHED; PG8_LDA(At, 1, 0); PG8_STAGE(rsA, PG8_SA(0, 0), oA2, voffA0); PG8_STAGE(rsA, PG8_SA(0, 1), (oA2) + hstepA, voffA0); \
            PG8_WAIT_VL(6); PG8_BAR; PG8_MMA2(0, B0o); PG8_BAR; PG8_SCHED; \
            PG8_LDA(At, 1, 1); if (lastrd) { PG8_LDB(B0e, 0, 0); } PG8_STAGE(rsB, PG8_SB(1, 0), oB3, voffB0); PG8_STAGE(rsB, PG8_SB(1, 1), (oB3) + hstepB, voffB0); \
            PG8_WAIT_VL(6); PG8_BAR; PG8_MMA2(1, B0o); PG8_BAR; PG8_SCHED; } while (0)
    Unit cur, nxt; int ui = 0;
    if (!S.next(0, cur)) return;
    f32x4 acc[2][2][4][2];
#pragma unroll
    for (int a = 0; a < 2; ++a)
#pragma unroll
        for (int b = 0; b < 2; ++b)
#pragma unroll
            for (int m = 0; m < 4; ++m)
#pragma unroll
                for (int n = 0; n < 2; ++n) acc[a][b][m][n] = (f32x4){0.f, 0.f, 0.f, 0.f};
    bf16x8 At[4][2], B0e[2][2], B0o[2][2], B1[2][2];
    unsigned cA = (unsigned)cur.pm * 2 * hstepA + (unsigned)((cur.pn >> g.agrp_shift) * g.agrp_stride) * 2; unsigned cB = (unsigned)cur.pn * 2 * hstepB;
    if constexpr (Sched::SPLIT) { nt = cur.nkt; cA += (unsigned)cur.kt0 * kstep; cB += (unsigned)cur.kt0 * kstep; }
    E.unit_begin(cur, 0, wid, lane);
    PG8_STAGE(rsB, PG8_SB(0, 0), cB, voffB0); PG8_STAGE(rsB, PG8_SB(0, 1), cB + hstepB, voffB0); PG8_STAGE(rsA, PG8_SA(0, 0), cA, voffA0); PG8_STAGE(rsA, PG8_SA(0, 1), cA + hstepA, voffA0);
    if (wr == 1) PG8_BAR;
    PG8_STAGE(rsB, PG8_SB(1, 0), cB + kstep, voffB0); PG8_STAGE(rsB, PG8_SB(1, 1), cB + kstep + hstepB, voffB0);
    PG8_WAIT_V(6); PG8_BAR; PG8_BAR;
    PG8_LDB(B0e, 0, 0);
    for (;;) {
        const bool has_next = S.next(ui + 1, nxt);
        unsigned nko = 0; if constexpr (Sched::SPLIT) nko = has_next ? (unsigned)nxt.kt0 * kstep : 0;
        const unsigned nA = has_next ? (unsigned)nxt.pm * 2 * hstepA + (unsigned)((nxt.pn >> g.agrp_shift) * g.agrp_stride) * 2 + nko : cA; const unsigned nB = has_next ? (unsigned)nxt.pn * 2 * hstepB + nko : cB;
        unsigned oA = cA + kstep, oB = cB + 2 * kstep;
        for (int t = 0; t < nt; t += 2) {
            const bool last = (t == nt - 2);
            const unsigned a2 = last ? nA : oA + kstep, b2 = last ? nB : oB;
            PG8_ITER(oA, a2, b2, b2 + kstep, !last); oA += 2 * kstep; oB += 2 * kstep; }
        if (wr == 0) PG8_BAR;
        E(acc, cur, ui, wr, wc, fr, fq);
        if (!has_next) break;
        { f32x2 z2 = (f32x2){0.f, 0.f}; asm volatile("" : "+v"(z2));
#pragma unroll
        for (int a = 0; a < 2; ++a)
#pragma unroll
            for (int b = 0; b < 2; ++b)
#pragma unroll
                for (int m = 0; m < 4; ++m)
#pragma unroll
                    for (int n = 0; n < 2; ++n) acc[a][b][m][n] = __builtin_shufflevector(z2, z2, 0, 1, 0, 1); }
        cur = nxt; cA = nA; cB = nB; ++ui; if constexpr (Sched::SPLIT) nt = cur.nkt;
        if (wr == 1) PG8_BAR;
        E.unit_begin(cur, ui, wid, lane);
        PG8_LDB(B0e, 0, 0);
    }
    PG8_WAIT_V(0);
    PG8_BAR;
#undef PG8_SA
#undef PG8_SB
#undef PG8_STAGE
#undef PG8_LDA
#undef PG8_LDB
#undef PG8_MMA2
#undef PG8_CH
#undef PG8_WAIT_V
#undef PG8_WAIT_VL
#undef PG8_BAR
#undef PG8_SCHED
#undef PG8_ITER
}

struct EpiProj {
    static constexpr bool PERM = true, APERM = false;
    bf16* O; int ldc;
    __device__ __forceinline__ void unit_begin(const Unit&, int, int, int) const {}
    __device__ __forceinline__ void operator()(const f32x4 (&acc)[2][2][4][2], const Unit& u, int, int wr, int wc, int fr, int fq) const {
        asm volatile("" : "+v"(fr), "+v"(fq));
        const int row0 = u.pm * BM + wr * 64 + fr, col0 = u.pn * BM + wc * 32 + 8 * fq; const float sc = u.pn < 8 ? 0.0625f : 1.f;
#pragma unroll
        for (int ai = 0; ai < 2; ++ai)
#pragma unroll
            for (int m = 0; m < 4; ++m) { bf16* rowp = O + (size_t)(row0 + ai * HALF + m * 16) * ldc + col0;
#pragma unroll
                for (int bj = 0; bj < 2; ++bj) { const f32x4 v0 = acc[ai][bj][m][0] * sc, v1 = acc[ai][bj][m][1] * sc;
                    u32x4 w; w.x = cvt_pk_bf16(v0[0], v0[1]); w.y = cvt_pk_bf16(v0[2], v0[3]); w.z = cvt_pk_bf16(v1[0], v1[1]); w.w = cvt_pk_bf16(v1[2], v1[3]);
                    *(u32x4*)(rowp + bj * HALF) = w; } }
    }
};

struct EpiNull {
    static constexpr bool PERM = false, APERM = false;
    __device__ __forceinline__ void unit_begin(const Unit&, int, int, int) const {}
    __device__ __forceinline__ void operator()(const f32x4 (&acc)[2][2][4][2], const Unit&, int, int, int, int, int) const {
#pragma unroll
        for (int ai = 0; ai < 2; ++ai)
#pragma unroll
            for (int bj = 0; bj < 2; ++bj)
#pragma unroll
                for (int m = 0; m < 4; ++m)
#pragma unroll
                    for (int n = 0; n < 2; ++n) asm volatile("" :: "v"(acc[ai][bj][m][n]));
    }
};
template <bool BASE_F32> struct EpiResid {
    static constexpr bool PERM = true, APERM = false;
    const void* base; const float* ginv_src; const float* colscale; bf16* O; const float* gA; float* rss; const float* rowscale;
    __device__ __forceinline__ void unit_begin(const Unit&, int, int, int) const {}
    __device__ __forceinline__ void operator()(const f32x4 (&acc)[2][2][4][2], const Unit& u, int, int wr, int wc, int fr, int fq) const {
        asm volatile("" : "+v"(fr), "+v"(fq));
        const int row0 = u.pm * BM + wr * 64 + fr, col0 = u.pn * BM + wc * 32 + 8 * fq;
        f32x4 cs[2][2], gv[2][2], gi[2][2];
#pragma unroll
        for (int bj = 0; bj < 2; ++bj)
#pragma unroll
            for (int n = 0; n < 2; ++n) { const int cc = col0 + bj * HALF + 4 * n;
                cs[bj][n] = colscale ? *(const f32x4*)(colscale + cc) : (f32x4){1.f, 1.f, 1.f, 1.f};
                gv[bj][n] = gA ? *(const f32x4*)(gA + cc) : (f32x4){1.f, 1.f, 1.f, 1.f};
                if (ginv_src) { const f32x4 t = *(const f32x4*)(ginv_src + cc); gi[bj][n] = (f32x4){1.0f / t[0], 1.0f / t[1], 1.0f / t[2], 1.0f / t[3]}; } else gi[bj][n] = (f32x4){1.f, 1.f, 1.f, 1.f}; }
#pragma unroll
        for (int ai = 0; ai < 2; ++ai) {
            f32x4 pb[4][2][2]; u32x4 pw[4][2];
#pragma unroll
            for (int m = 0; m < 4; ++m) { const size_t off = (size_t)(row0 + ai * HALF + m * 16) * D + col0;
#pragma unroll
                for (int bj = 0; bj < 2; ++bj) {
                    if (BASE_F32) { pb[m][bj][0] = __builtin_nontemporal_load((const f32x4*)((const float*)base + off + bj * HALF)); pb[m][bj][1] = __builtin_nontemporal_load((const f32x4*)((const float*)base + off + bj * HALF + 4)); }
                    else pw[m][bj] = *(const u32x4*)((const bf16*)base + off + bj * HALF); } }
            float rsc[4];
#pragma unroll
            for (int m = 0; m < 4; ++m) rsc[m] = rowscale ? rowscale[row0 + ai * HALF + m * 16] : 1.0f;
#pragma unroll
            for (int m = 0; m < 4; ++m) { const int r = row0 + ai * HALF + m * 16; const size_t off = (size_t)r * D + col0; float ss = 0.f;
#pragma unroll
                for (int bj = 0; bj < 2; ++bj) { f32x4 b0, b1;
                    if (BASE_F32) { b0 = pb[m][bj][0]; b1 = pb[m][bj][1]; }
                    else { const u32x4 w = pw[m][bj];
                        b0 = (f32x4){bf2f(w.x & 0xffffu), bf2f(w.x >> 16), bf2f(w.y & 0xffffu), bf2f(w.y >> 16)}; b1 = (f32x4){bf2f(w.z & 0xffffu), bf2f(w.z >> 16), bf2f(w.w & 0xffffu), bf2f(w.w >> 16)}; }
                    const f32x4 v0 = b0 * (gi[bj][0] * rsc[m]) + acc[ai][bj][m][0] * cs[bj][0], v1 = b1 * (gi[bj][1] * rsc[m]) + acc[ai][bj][m][1] * cs[bj][1];
                    ss += ((v0[0] * v0[0] + v0[1] * v0[1]) + (v0[2] * v0[2] + v0[3] * v0[3])) + ((v1[0] * v1[0] + v1[1] * v1[1]) + (v1[2] * v1[2] + v1[3] * v1[3]));
                    const f32x4 a0 = v0 * gv[bj][0], a1 = v1 * gv[bj][1];
                    u32x4 w; w.x = cvt_pk_bf16(a0[0], a0[1]); w.y = cvt_pk_bf16(a0[2], a0[3]); w.z = cvt_pk_bf16(a1[0], a1[1]); w.w = cvt_pk_bf16(a1[2], a1[3]);
                    *(u32x4*)(O + off + bj * HALF) = w; }
                ss += __shfl_xor(ss, 16); ss += __shfl_xor(ss, 32);
                if (fq == 0) rss[(size_t)r * 64 + u.pn * 4 + wc] = ss; }
            asm volatile("" ::: "memory");
        }
    }
};

__device__ __forceinline__ float dpp_shr1(float old, float src) { return __builtin_bit_cast(float, __builtin_amdgcn_update_dpp(__builtin_bit_cast(int, old), __builtin_bit_cast(int, src), 0x111, 0xf, 0xf, false)); }
__device__ __forceinline__ float dpp_shr2(float old, float src) { return __builtin_bit_cast(float, __builtin_amdgcn_update_dpp(__builtin_bit_cast(int, old), __builtin_bit_cast(int, src), 0x112, 0xf, 0xf, false)); }
__device__ __forceinline__ float dpp_ror1(float src) { return __builtin_bit_cast(float, __builtin_amdgcn_mov_dpp(__builtin_bit_cast(int, src), 0x121, 0xf, 0xf, true)); }
__device__ __forceinline__ float dpp_ror2(float src) { return __builtin_bit_cast(float, __builtin_amdgcn_mov_dpp(__builtin_bit_cast(int, src), 0x122, 0xf, 0xf, true)); }
__device__ __forceinline__ float silu_f(float x) { return x * __builtin_amdgcn_rcpf(1.0f + __builtin_amdgcn_exp2f(-1.44269504089f * x)); }
template <int KIND  > struct EpiFfn1T {
    static constexpr bool PERM = true, APERM = true;
    bf16* O; const float* convp; float* halo; LAS unsigned char* lds; float* part; unsigned* flag; unsigned epoch;
    __device__ __forceinline__ void unit_begin(const Unit& u, int ui, int wid, int lane) const {
        if (wid < 4)
            __builtin_amdgcn_global_load_lds((const unsigned*)((const char*)convp + (size_t)u.pn * 4096 + wid * 1024 + lane * 16), (LAS unsigned*)(lds + CONVP_OFF + (ui & 1) * 4096 + wid * 1024), 16, 0, 0);
    }
    __device__ __forceinline__ void operator()(f32x4 (&acc)[2][2][4][2], const Unit& u, int ui, int wr, int wc, int fr, int fq) const {
        asm volatile("" : "+v"(fr), "+v"(fq));
        const int wid = wr * 4 + wc;
        if constexpr (KIND == 2) {
            const __amdgpu_buffer_rsrc_t rsrc = __builtin_amdgcn_make_buffer_rsrc((void*)part, 0, 262144, 0x00020000);
            const int voff = (wid * 64 + fq * 16 + fr) * 16;
#pragma unroll
            for (int ai = 0; ai < 2; ++ai)
#pragma unroll
                for (int bj = 0; bj < 2; ++bj)
#pragma unroll
                    for (int m = 0; m < 4; ++m)
#pragma unroll
                        for (int n = 0; n < 2; ++n) __builtin_amdgcn_raw_buffer_store_b128(__builtin_bit_cast(u32x4, acc[ai][bj][m][n]), rsrc, voff + (((ai * 2 + bj) * 4 + m) * 2 + n) * 8192, 0, 16);
            asm volatile("s_waitcnt vmcnt(0)" ::: "memory"); __builtin_amdgcn_s_barrier(); asm volatile("" ::: "memory");
            if (wid == 0 && fq == 0 && fr == 0) __hip_atomic_store(flag, epoch, __ATOMIC_RELAXED, __HIP_MEMORY_SCOPE_AGENT);
            return;
        }
        if constexpr (KIND == 1) {
            if (wid == 0) { unsigned sp = 0;
                while ((unsigned)__builtin_amdgcn_readfirstlane(__hip_atomic_load(flag, __ATOMIC_RELAXED, __HIP_MEMORY_SCOPE_AGENT)) < epoch) { __builtin_amdgcn_s_sleep(2); if (++sp > (1u << 22)) break; }
                __builtin_amdgcn_fence(__ATOMIC_ACQUIRE, "agent"); asm volatile("s_waitcnt vmcnt(0)" ::: "memory"); }
            asm volatile("" ::: "memory"); __builtin_amdgcn_s_barrier(); asm volatile("" ::: "memory");
            const f32x4* pp = (const f32x4*)part + (wid * 64 + fq * 16 + fr);
#pragma unroll
            for (int ai = 0; ai < 2; ++ai)
#pragma unroll
                for (int bj = 0; bj < 2; ++bj) {
                    f32x4 t8[4][2];
#pragma unroll
                    for (int m = 0; m < 4; ++m)
#pragma unroll
                        for (int n = 0; n < 2; ++n) t8[m][n] = pp[(((ai * 2 + bj) * 4 + m) * 2 + n) * 512];
#pragma unroll
                    for (int m = 0; m < 4; ++m)
#pragma unroll
                        for (int n = 0; n < 2; ++n) acc[ai][bj][m][n] += t8[m][n];
                    asm volatile("" : "+v"(acc[ai][bj][0][0]), "+v"(acc[ai][bj][0][1]), "+v"(acc[ai][bj][1][0]), "+v"(acc[ai][bj][1][1]), "+v"(acc[ai][bj][2][0]), "+v"(acc[ai][bj][2][1]), "+v"(acc[ai][bj][3][0]), "+v"(acc[ai][bj][3][1]) :: "memory"); }
            asm volatile("" : "+v"(fr), "+v"(fq));
        }
        const LAS float* rstd = (const LAS float*)(lds + RSTD_OFF);
        const LAS float* cp = (const LAS float*)(lds + CONVP_OFF + (ui & 1) * 4096);
        LAS float* ex = (LAS float*)(lds + EXCH_OFF);
#pragma unroll
        for (int ai = 0; ai < 2; ++ai) { const f32x4 rs4 = *(const LAS f32x4*)(rstd + ai * HALF + wr * 64 + 4 * fr);
#pragma unroll
            for (int m = 0; m < 4; ++m)
#pragma unroll
                for (int bj = 0; bj < 2; ++bj)
#pragma unroll
                    for (int n = 0; n < 2; ++n) acc[ai][bj][m][n] *= rs4[m]; }
        if (fr == 15) {
#pragma unroll
            for (int ai = 0; ai < 2; ++ai)
#pragma unroll
                for (int bj = 0; bj < 2; ++bj)
#pragma unroll
                    for (int n = 0; n < 2; ++n) { *(LAS f32x4*)(ex + ((wid * 2 + ai) * 2 + 0) * 64 + (bj * 2 + n) * 16 + fq * 4) = acc[ai][bj][2][n]; *(LAS f32x4*)(ex + ((wid * 2 + ai) * 2 + 1) * 64 + (bj * 2 + n) * 16 + fq * 4) = acc[ai][bj][3][n]; }
        }
        {
            const int colb = u.pn * BM + wc * 32 + 8 * fq;
            if (wr == 0 && fr == 0) {
#pragma unroll
                for (int rr = 0; rr < 2; ++rr)
#pragma unroll
                    for (int bj = 0; bj < 2; ++bj)
#pragma unroll
                        for (int n = 0; n < 2; ++n) *(f32x4*)(halo + ((size_t)u.pm * 4 + rr) * NFF1 + colb + bj * HALF + 4 * n) = acc[0][bj][rr][n];
            }
            if (wr == 1 && fr == 15) {
#pragma unroll
                for (int rr = 0; rr < 2; ++rr)
#pragma unroll
                    for (int bj = 0; bj < 2; ++bj)
#pragma unroll
                        for (int n = 0; n < 2; ++n) *(f32x4*)(halo + ((size_t)u.pm * 4 + 2 + rr) * NFF1 + colb + bj * HALF + 4 * n) = acc[1][bj][2 + rr][n];
            }
        }
        LDS_WAIT(); __builtin_amdgcn_s_barrier(); asm volatile("" ::: "memory");
        const int row0 = u.pm * BM + wr * 64 + 4 * fr, colo = u.pn * HALF + wc * 32 + 8 * fq;
        u32x2 hold[2][4];
        f32x2 kone = (f32x2){1.0f, 1.0f}; asm volatile("" : "+v"(kone));
#pragma unroll
        for (int n = 0; n < 2; ++n) {
            f32x4 pw[4][2];
#pragma unroll
            for (int p = 0; p < 4; ++p)
#pragma unroll
                for (int bj = 0; bj < 2; ++bj) pw[p][bj] = *(const LAS f32x4*)(cp + p * 256 + bj * HALF + wc * 32 + 8 * fq + 4 * n);
#pragma unroll
            for (int ai = 0; ai < 2; ++ai) {
                const int swv = (ai == 1 && wr == 0) ? wid + 4 : wid - 4, sai = (ai == 1 && wr == 1) ? 1 : 0; const bool have = !(ai == 0 && wr == 0);
                f32x4 pm1[2], pm2[2];
#pragma unroll
                for (int bj = 0; bj < 2; ++bj) {
                    f32x4 e0 = (f32x4){0.f, 0.f, 0.f, 0.f}, e1 = e0;
                    if (have) { e0 = *(const LAS f32x4*)(ex + ((swv * 2 + sai) * 2 + 0) * 64 + (bj * 2 + n) * 16 + fq * 4); e1 = *(const LAS f32x4*)(ex + ((swv * 2 + sai) * 2 + 1) * 64 + (bj * 2 + n) * 16 + fq * 4); }
#pragma unroll
                    for (int i = 0; i < 4; ++i) { pm1[bj][i] = dpp_shr1(e1[i], acc[ai][bj][3][n][i]); pm2[bj][i] = dpp_shr1(e0[i], acc[ai][bj][2][n][i]); }
                }
#pragma unroll
                for (int m = 0; m < 4; ++m) {
                    f32x4 hc[2];
#pragma unroll
                    for (int bj = 0; bj < 2; ++bj) {
                        const f32x4 cur = acc[ai][bj][m][n];
                        const f32x4 h1 = m == 0 ? pm1[bj] : acc[ai][bj][m == 0 ? 0 : m - 1][n];
                        const f32x4 h2 = m == 0 ? pm2[bj] : (m == 1 ? pm1[bj] : acc[ai][bj][m < 2 ? 0 : m - 2][n]);
                        hc[bj] = pw[3][bj] + pw[0][bj] * h2 + pw[1][bj] * h1 + pw[2][bj] * cur;
                    }
                    const f32x2 e01 = (f32x2){__builtin_amdgcn_exp2f(hc[0][0]), __builtin_amdgcn_exp2f(hc[0][1])}, e23 = (f32x2){__builtin_amdgcn_exp2f(hc[0][2]), __builtin_amdgcn_exp2f(hc[0][3])};
                    const f32x2 d01 = e01 + kone, d23 = e23 + kone;
                    const f32x4 r = (f32x4){__builtin_amdgcn_rcpf(d01[0]), __builtin_amdgcn_rcpf(d01[1]), __builtin_amdgcn_rcpf(d23[0]), __builtin_amdgcn_rcpf(d23[1])};
                    const f32x4 o = (hc[0] * hc[1]) * r;
                    u32x2 w; w.x = cvt_pk_bf16(o[0], o[1]); w.y = cvt_pk_bf16(o[2], o[3]);
                    if (n == 0) hold[ai][m] = w;
                    else *(u32x4*)(O + (size_t)(row0 + ai * HALF + m) * KFF2 + colo) = (u32x4){hold[ai][m].x, hold[ai][m].y, w.x, w.y};
                }
            }
        }
    }
};
}

#define XB_TMO      128
#define XB_XCNT(j)  (256  + 64 * (j))
#define XB_XSUB(j)  (1280 + 64 * (j))
#define XB_XGEN(j)  (2304 + 64 * (j))
#define XB_TOP      3328
#define XB_TOPGEN   3392
#define XCD_BAR_WORDS 3456
#define XB_SPIN_CAP (1u << 18)
__device__ __forceinline__ unsigned xb_ld(unsigned* p)              { return __hip_atomic_load(p, __ATOMIC_RELAXED, __HIP_MEMORY_SCOPE_AGENT); }
__device__ __forceinline__ unsigned xb_add(unsigned* p, unsigned v) { return __hip_atomic_fetch_add(p, v, __ATOMIC_RELAXED, __HIP_MEMORY_SCOPE_AGENT); }
__device__ __forceinline__ unsigned xb_xcc_id() { return (unsigned)__builtin_amdgcn_s_getreg((3 << 11) | 20) & 0xFu; }
#define XB_SPIN(cond, bar) do { unsigned _sp = 0; while (cond) { __builtin_amdgcn_s_sleep(1); \
    if ((++_sp & 255u) == 0u) { if (xb_ld(&(bar)[XB_TMO])) break; if (_sp > XB_SPIN_CAP) { atomicAdd(&(bar)[XB_TMO], 1u); break; } } } } while (0)
struct XcdBarrier { unsigned* bar; unsigned x; volatile LAS unsigned* st; };
__device__ __forceinline__ XcdBarrier xcd_barrier_post(unsigned* bar, volatile LAS unsigned* st) {
    XcdBarrier b; b.bar = bar; b.x = xb_xcc_id(); b.st = st;
    if (threadIdx.x == 0) (void)xb_add(&bar[XB_XCNT(b.x)], 1u);
    return b;
}
__device__ __forceinline__ void xcd_barrier_complete(unsigned* bar, unsigned x, unsigned& nloc, unsigned& nx) {
    const unsigned G = gridDim.x * gridDim.y * gridDim.z;
    unsigned sum, cnt, mine, sp = 0u;
    for (;;) {
        sum = 0u; cnt = 0u; mine = 0u;
#pragma unroll
        for (unsigned j = 0; j < 16; ++j) { const unsigned c = xb_ld(&bar[XB_XCNT(j)]); sum += c; cnt += (c > 0u) ? 1u : 0u; mine = (j == x) ? c : mine; }
        if (sum == G) break;
        __builtin_amdgcn_s_sleep(1);
        if ((++sp & 255u) == 0u) { if (xb_ld(&bar[XB_TMO])) break; if (sp > XB_SPIN_CAP) { atomicAdd(&bar[XB_TMO], 1u); break; } }
    }
    nloc = mine > 0u ? mine : 1u; nx = cnt > 0u ? cnt : 1u;
}
__device__ __forceinline__ void xcd_barrier(const XcdBarrier& b) {
    asm volatile("s_waitcnt vmcnt(0)" ::: "memory");
    __syncthreads();
    if (threadIdx.x == 0) {
        unsigned* bar = b.bar;
        __builtin_amdgcn_s_waitcnt(0);
        unsigned nloc = b.st[0], nx = b.st[1];
        if (nloc == 0u) { xcd_barrier_complete(bar, b.x, nloc, nx); b.st[0] = nloc; b.st[1] = nx; }
        const unsigned old = xb_add(&bar[XB_XSUB(b.x)], 1u);
        const unsigned gen = old / nloc;
        if (old + 1u == (gen + 1u) * nloc) {
            __builtin_amdgcn_fence(__ATOMIC_RELEASE, "agent");
            asm volatile("s_waitcnt vmcnt(0)" ::: "memory");
            const unsigned og = xb_add(&bar[XB_TOP], 1u);
            const unsigned tg = og / nx;
            if (og + 1u == (tg + 1u) * nx) xb_add(&bar[XB_TOPGEN], 1u);
            else XB_SPIN(xb_ld(&bar[XB_TOPGEN]) == tg, bar);
            __builtin_amdgcn_fence(__ATOMIC_ACQUIRE, "agent");
            xb_add(&bar[XB_XGEN(b.x)], 1u);
            asm volatile("s_waitcnt vmcnt(0)" ::: "memory");
        } else {
            XB_SPIN(xb_ld(&bar[XB_XGEN(b.x)]) == gen, bar);
            __builtin_amdgcn_fence(__ATOMIC_ACQUIRE, "agent");
            asm volatile("s_waitcnt vmcnt(0)" ::: "memory");
        }
    }
    __syncthreads();
}

constexpr int NWAVES = 8;
#define WSP(T, off) ((T*)(F.ws + (off)))
struct Args { const float* in[16]; float* out; unsigned char* ws; int ph_lo, ph_hi, li, pad; };
struct Frame {
    LAS unsigned char* lds; int tid, lane, wave, vcu, G;
    unsigned char* ws; float* out;
};
__device__ __forceinline__ float wave_sum(float v) {
#pragma unroll
    for (int o = 1; o < 64; o <<= 1) v += __shfl_xor(v, o);
    return v;
}

constexpr int CV_NB1 = DFF2 / 64, CV_W1 = (D / 32) * CV_NB1, CV_KB2 = DFF / 32, CV_TOTAL = CV_W1 + CV_KB2 * (D / 64);
static_assert(DFF % 64 == 0 && DFF2 % 64 == 0 && DFF % 32 == 0 && D / 32 == 128, "SCANCVT block shapes");
struct CvBlk { const float* src; bf16* dst; unsigned lds; };
__device__ __forceinline__ CvBlk cv_decode(const float* w1src, const float* w2src, unsigned char* ws, int id, int lane) {
    CvBlk b;
    if (id < CV_W1) { const int kb = id & (D / 32 - 1), nb = id >> 7, n = 64 * nb + lane;        const int f0 = n < DFF ? n : n - DFF; const int rowdst = 256 * (f0 >> 7) + (n < DFF ? 0 : 128) + (f0 & 127);
        b.src = w1src + (size_t)D * DFF2 + (size_t)(32 * kb) * DFF2 + n; b.dst = (bf16*)(ws + WS_W1) + (size_t)NFF1 * D + (size_t)rowdst * D + 32 * kb; b.lds = (unsigned)DFF2; }
    else { const int id2 = id - CV_W1, kb = id2 >> 6, nb = id2 & 63, n = 64 * nb + lane;
        b.src = w2src + (size_t)DFF * D + (size_t)(32 * kb) * D + n; b.dst = (bf16*)(ws + WS_W2) + (size_t)D * KFF2 + (size_t)n * KFF2 + 32 * kb; b.lds = (unsigned)D; }
    return b;
}
__device__ __forceinline__ void cv_load(const CvBlk& b, float (&v)[32]) {
#pragma unroll
    for (int i = 0; i < 32; ++i) v[i] = __builtin_nontemporal_load(b.src + (size_t)i * b.lds);
}
__device__ __forceinline__ void cv_store(const CvBlk& b, const float (&v)[32]) {
#pragma unroll
    for (int q = 0; q < 4; ++q) { u32x4 o; o.x = cvt_pk_bf16(v[8 * q], v[8 * q + 1]); o.y = cvt_pk_bf16(v[8 * q + 2], v[8 * q + 3]); o.z = cvt_pk_bf16(v[8 * q + 4], v[8 * q + 5]); o.w = cvt_pk_bf16(v[8 * q + 6], v[8 * q + 7]);
        *(u32x4*)(b.dst + 8 * q) = o; }
}

__device__ __forceinline__ void tr_item(const float* W, size_t ldw, int k0, int n0, bf16* WT, size_t ldt, int rowdst, LAS float* scr, int lane) {
#pragma unroll 8
    for (int i = 0; i < 32; ++i) { const int kk = 2 * i + (lane >> 5); scr[kk * 33 + (lane & 31)] = __builtin_nontemporal_load(W + (size_t)(k0 + kk) * ldw + n0 + (lane & 31)); }
    LDS_WAIT(); asm volatile("" ::: "memory");
    const int c = lane & 7;
#pragma unroll
    for (int j = 0; j < 4; ++j) { const int n = (lane >> 3) + 8 * j; const LAS float* s = scr + (8 * c) * 33 + n;
        u32x4 o; o.x = pk2(s[0 * 33], s[1 * 33]); o.y = pk2(s[2 * 33], s[3 * 33]); o.z = pk2(s[4 * 33], s[5 * 33]); o.w = pk2(s[6 * 33], s[7 * 33]);
        *(u32x4*)(WT + (size_t)(rowdst + n) * ldt + k0 + 8 * c) = o; }
    LDS_WAIT(); asm volatile("" ::: "memory");
}
__device__ __forceinline__ void rms_row_to_bf16(const float* xrow, const float* g, bf16* orow, float* rinv, int lane) {
    const f32x4* xr = (const f32x4*)xrow + lane; const f32x4* gr = (const f32x4*)g + lane;
    f32x4 v[16]; float s = 0.f;
#pragma unroll
    for (int j = 0; j < 16; ++j) { v[j] = __builtin_nontemporal_load(xr + 64 * j); s += (v[j][0] * v[j][0] + v[j][1] * v[j][1]) + (v[j][2] * v[j][2] + v[j][3] * v[j][3]); }
    const float rms = sqrtf(wave_sum(s) * (1.f / D) + EPS); const float rstd = 1.0f / rms;
    if (lane == 0) *rinv = rms;
    u32x2* o8 = (u32x2*)orow + lane;
#pragma unroll
    for (int j = 0; j < 16; ++j) { const f32x4 gg = gr[64 * j]; u32x2 w; w.x = pk2(v[j][0] * rstd * gg[0], v[j][1] * rstd * gg[1]); w.y = pk2(v[j][2] * rstd * gg[2], v[j][3] * rstd * gg[3]); o8[64 * j] = w; }
}
__device__ __forceinline__ void p0_prologue(Frame& F, const Args& args) {
    LAS float* scr = (LAS float*)(F.lds + RING_OFF + F.wave * 16384);
    const int gw = F.vcu * NWAVES + F.wave, NGW = F.G * NWAVES;
    constexpr int I_P = 64 * 384, I_O = 64 * 128, I_1 = 64 * 684, I_2 = 171 * 128, I_G = 16 * 32;
    constexpr int NITEMS = I_P + I_O + I_1 + I_2 + 4 * I_G;
    for (int it = gw; it < NITEMS; it += NGW) {
        int r = it + I_P; if (r >= NITEMS) r -= NITEMS;
        if (r < I_P) { const int kb = r / 384, nb = r % 384; tr_item(args.in[2], PROJ_W, 64 * kb, 32 * nb, WSP(bf16, WS_WP), D, 32 * nb, scr, F.lane); continue; } r -= I_P;
        if (r < I_O) { const int kb = r / 128, nb = r % 128; tr_item(args.in[6], D, 64 * kb, 32 * nb, WSP(bf16, WS_WO), D, 32 * nb, scr, F.lane); continue; } r -= I_O;
        if (r < I_1) { const int l = 0; const int kb = r / 684, nb = r % 684; const int n0 = 32 * nb; const int f0 = n0 < DFF ? n0 : n0 - DFF;
            const int rowdst = 256 * (f0 >> 7) + (n0 < DFF ? 0 : 128) + (f0 & 127);
            tr_item(args.in[11] + (size_t)l * D * DFF2, DFF2, 64 * kb, n0, WSP(bf16, WS_W1) + (size_t)l * NFF1 * D, D, rowdst, scr, F.lane); continue; } r -= I_1;
        if (r < I_2) { const int l = 0; const int kb = r / 128, nb = r % 128;
            tr_item(args.in[14] + (size_t)l * DFF * D, D, 64 * kb, 32 * nb, WSP(bf16, WS_W2) + (size_t)l * D * KFF2, KFF2, 32 * nb, scr, F.lane); continue; } r -= I_2;
        { const int gidx = r / I_G; r -= gidx * I_G; const int kb = r / 32, nb = r % 32;
            tr_item(args.in[8] + (size_t)gidx * 1024 * 1024, 1024, 64 * kb, 32 * nb, WSP(bf16, WS_WPOOL) + (size_t)gidx * 1024 * 1024, 1024, 32 * nb, scr, F.lane); }
    }
    {
        const int scan_blocks = ((256 + F.G - 1) / F.G) * (SEQ / 64) * NGW;
        for (int id = scan_blocks + gw; id < CV_TOTAL; id += NGW) { float v[32]; const CvBlk b = cv_decode(args.in[11], args.in[14], F.ws, id, F.lane); cv_load(b, v); cv_store(b, v); }
    }
    const int gt = F.vcu * (NWAVES * 64) + F.tid, NGT = F.G * NWAVES * 64;
    for (int i = gt; i < 2 * 128 * (D / 8); i += NGT) { const int l = i / (128 * (D / 8)), rr = (i / (D / 8)) % 128, c8 = i % (D / 8); const int row = 85 * 256 + (rr < 64 ? 64 + rr : 192 + (rr - 64));
        *(u32x4*)(WSP(bf16, WS_W1) + ((size_t)l * NFF1 + row) * D + 8 * c8) = (u32x4){0u, 0u, 0u, 0u}; }
    for (int i = gt; i < 2 * D * 8; i += NGT) { const int l = i / (D * 8), row = (i / 8) % D, c8 = i % 8; *(u32x4*)(WSP(bf16, WS_W2) + ((size_t)l * D + row) * KFF2 + DFF + 8 * c8) = (u32x4){0u, 0u, 0u, 0u}; }
    for (int i = gt; i < 2 * FT * 4 * 256; i += NGT) { const int cc = i & 255, p = (i >> 8) & 3, j = (i >> 10) % FT, l = i / (FT * 1024); const int f = 128 * j + (cc & 127); const int col = cc < 128 ? f : DFF + f;
        float v = 0.f; if (f < DFF) v = p < 3 ? args.in[12][((size_t)l * 3 + p) * DFF2 + col] : args.in[13][(size_t)l * DFF2 + col];
        WSP(float, WS_CONVP)[i] = v * (cc < 128 ? -1.44269504089f : -0.69314718056f); }
    for (int i = gt; i < 16 * D; i += NGT) { const int c = i & 15, k = i >> 4; WSP(bf16, WS_WG)[(size_t)c * D + k] = (bf16)f2bf(args.in[2][(size_t)k * PROJ_W + NPROJ + c]); }
    for (int m = gw; m < M; m += NGW) rms_row_to_bf16(args.in[0] + (size_t)m * D, args.in[1], WSP(bf16, WS_XA) + (size_t)m * D, WSP(float, WS_RINV) + m, F.lane);
}

__device__ __forceinline__ float softcap15(float a) { return 15.0f * tanhf(a * (1.0f / 15.0f)); }
__device__ __forceinline__ void p1_gates(Frame& F, const Args& args) {
    const int gw = F.vcu * NWAVES + F.wave, NGW = F.G * NWAVES; const int fr = F.lane & 15, fq = F.lane >> 4;
    for (int rb = gw; rb < M / 16; rb += NGW) {
        const bf16* ap = WSP(bf16, WS_XA) + (size_t)(rb * 16 + fr) * D + 8 * fq; const bf16* bp = WSP(bf16, WS_WG) + (size_t)fr * D + 8 * fq;
        f32x4 acc = (f32x4){0.f, 0.f, 0.f, 0.f};
#pragma unroll 16
        for (int k = 0; k < D; k += 32) { const bf16x8 a = *(const bf16x8*)(ap + k); const bf16x8 b = *(const bf16x8*)(bp + k); acc = __builtin_amdgcn_mfma_f32_16x16x32_bf16(a, b, acc, 0, 0, 0); }
        const int c = fr; const float bias = c < 8 ? args.in[3][c] : args.in[4][c - 8];
#pragma unroll
        for (int r = 0; r < 4; ++r) { const float z = softcap15(acc[r] + bias); float o = z;
            if (c >= 8) o = fminf(z, 0.f) - log1pf(expf(-fabsf(z)));
            WSP(float, WS_GATES)[(size_t)(rb * 16 + 4 * fq + r) * 16 + c] = o; }
    }
}

__device__ __forceinline__ float row_sum16(float x) {
    x += __builtin_bit_cast(float, __builtin_amdgcn_update_dpp(0, __builtin_bit_cast(int, x), 0x128, 0xf, 0xf, false));
    x += __builtin_bit_cast(float, __builtin_amdgcn_update_dpp(0, __builtin_bit_cast(int, x), 0x124, 0xf, 0xf, false));
    x += __builtin_bit_cast(float, __builtin_amdgcn_update_dpp(0, __builtin_bit_cast(int, x), 0x122, 0xf, 0xf, false));
    x += __builtin_bit_cast(float, __builtin_amdgcn_update_dpp(0, __builtin_bit_cast(int, x), 0x121, 0xf, 0xf, false));
    return x;
}
__device__ __forceinline__ float wave_scan_add(float x, int lane) {
#define SC_STEP(ctrl) x += __builtin_bit_cast(float, __builtin_amdgcn_update_dpp(0, __builtin_bit_cast(int, x), ctrl, 0xf, 0xf, true))
    SC_STEP(0x111); SC_STEP(0x112); SC_STEP(0x114); SC_STEP(0x118);
#undef SC_STEP
    const float t0 = __builtin_bit_cast(float, __builtin_amdgcn_readlane(__builtin_bit_cast(int, x), 15)), t1 = __builtin_bit_cast(float, __builtin_amdgcn_readlane(__builtin_bit_cast(int, x), 31)), t2 = __builtin_bit_cast(float, __builtin_amdgcn_readlane(__builtin_bit_cast(int, x), 47));
    const int g = lane >> 4; return x + (g >= 1 ? t0 : 0.f) + (g >= 2 ? t1 : 0.f) + (g >= 3 ? t2 : 0.f);
}
__device__ __forceinline__ float wave_scan_max(float x, int lane) {
    const int ninf = (int)0xff800000u;
#define SC_STEP(ctrl) x = fmaxf(x, __builtin_bit_cast(float, __builtin_amdgcn_update_dpp(ninf, __builtin_bit_cast(int, x), ctrl, 0xf, 0xf, false)))
    SC_STEP(0x111); SC_STEP(0x112); SC_STEP(0x114); SC_STEP(0x118);
#undef SC_STEP
    const float t0 = __builtin_bit_cast(float, __builtin_amdgcn_readlane(__builtin_bit_cast(int, x), 15)), t1 = __builtin_bit_cast(float, __builtin_amdgcn_readlane(__builtin_bit_cast(int, x), 31)), t2 = __builtin_bit_cast(float, __builtin_amdgcn_readlane(__builtin_bit_cast(int, x), 47));
    const int g = lane >> 4; const float ninff = __builtin_bit_cast(float, ninf);
    return fmaxf(fmaxf(x, g >= 1 ? t0 : ninff), fmaxf(g >= 2 ? t1 : ninff, g >= 3 ? t2 : ninff));
}
typedef short v4i16_t __attribute__((ext_vector_type(4)));
__device__ __forceinline__ v4i16_t tr16(const LAS unsigned char* p) { return __builtin_amdgcn_ds_read_tr16_b64_v4i16((LAS v4i16_t*)p); }
__device__ __forceinline__ bf16x8 cat8(v4i16_t a, v4i16_t b) { return (bf16x8){a[0], a[1], a[2], a[3], b[0], b[1], b[2], b[3]}; }
constexpr int SC_QS = 0, SC_KS = 33792, SC_VS = 67584, SC_VW = 84992, SC_SS = 102400, SC_HS = 111616, SC_FA = 129024;
static_assert(SC_FA + 8192 <= LDSCTL_OFF, "scan LDS map");
__device__ __forceinline__ void p2_scan(Frame& F, const Args& args) {
    LAS unsigned char* L = F.lds;
    LAS float* fa = (LAS float*)(L + SC_FA);
    LAS float *sA = fa, *sM = fa + 64, *sWi = fa + 128, *sEi = fa + 192, *sKw = fa + 256, *sInv = fa + 320, *rsp = fa + 384  , *qnp = fa + 640  , *sn = fa + 1152  , *ssp = fa + 1408  , *scal = fa + 1920;
    const int tid0 = F.tid, w = F.wave;
    const bf16* PROJ = WSP(bf16, WS_PROJ); bf16* HB = WSP(bf16, WS_HB); float* SSg = WSP(float, WS_SS); const float* GATES = WSP(float, WS_GATES);
    const __amdgpu_buffer_rsrc_t rsP = __builtin_amdgcn_make_buffer_rsrc((void*)PROJ, 0, 0x7fffffff, 0x00020000), rsH = __builtin_amdgcn_make_buffer_rsrc((void*)HB, 0, 0x7fffffff, 0x00020000);
#define SC_LDQ(i, soff) __builtin_bit_cast(u32x4, __builtin_amdgcn_raw_buffer_load_b128(rsP, (unsigned)((((tid + 512 * (i)) >> 5) * NPROJ + ((tid + 512 * (i)) & 31) * 8) * 2), (soff), 0))
#define SC_LDV(i, soff) __builtin_bit_cast(u32x4, __builtin_amdgcn_raw_buffer_load_b128(rsP, (unsigned)((((tid + 512 * (i)) >> 4) * NPROJ + ((tid + 512 * (i)) & 15) * 8) * 2), (soff), 2))
    int cvid = F.vcu * NWAVES + F.wave;
    for (int item = F.vcu; item < 256; item += F.G) {
        const int bh = item >> 2, es = item & 3, b = bh >> 3, h = bh & 7;
        f32x4 C[16];
#pragma unroll
        for (int i = 0; i < 16; ++i) C[i] = (f32x4){0.f, 0.f, 0.f, 0.f};
        __syncthreads();
        if (tid0 < 256) sn[tid0] = 0.f;
        if (tid0 == 0) scal[0] = 0.f;
        u32x4 qv[4], kv[4], vv[2]; float ig_n, lf_n;
        { const size_t row0 = (size_t)b * SEQ; const int tid = tid0; ig_n = GATES[(row0 + (tid & 63)) * 16 + h]; lf_n = GATES[(row0 + (tid & 63)) * 16 + 8 + h];
#pragma unroll
            for (int i = 0; i < 4; ++i) { const unsigned so = (unsigned)((row0 * NPROJ + h * DQK) * 2); qv[i] = SC_LDQ(i, so); kv[i] = SC_LDQ(i, so + QKW * 2); }
#pragma unroll
            for (int i = 0; i < 2; ++i) vv[i] = SC_LDV(i, (unsigned)((row0 * NPROJ + 2 * QKW + h * DV + es * 128) * 2)); }
        for (int c = 0; c <= SEQ / 64; ++c) {
            const size_t row0 = (size_t)b * SEQ + 64 * c;
            int tid = tid0; asm volatile("" : "+v"(tid));
            const int lane = tid & 63, fr = lane & 15, fq = lane >> 4, tq = fr >> 2, tp = fr & 3;
            __syncthreads();
            if (c > 0) {
                const size_t prow0 = row0 - 64;
#pragma unroll
                for (int i = 0; i < 2; ++i) { const int p = tid + 512 * i, row = p >> 4, cc = p & 15; __builtin_amdgcn_raw_buffer_store_b128(*(const LAS u32x4*)(L + SC_HS + row * 272 + cc * 16), rsH, (unsigned)((row * D + cc * 8) * 2), (unsigned)((prow0 * D + h * DV + es * 128) * 2), 0); }
                if (tid < 64) { float q = 0.f;
#pragma unroll
                    for (int p = 0; p < 8; ++p) q += ssp[p * 64 + tid];
                    SSg[(prow0 + tid) * 32 + h * 4 + es] = q; }
                if (tid == 0) scal[0] = scal[2];
            }
            if (c == SEQ / 64) break;
#pragma unroll
            for (int i = 0; i < 4; ++i) { const int p = tid + 512 * i, row = p >> 5, cc = p & 31; *(LAS u32x4*)(L + SC_QS + row * 528 + cc * 16) = qv[i]; *(LAS u32x4*)(L + SC_KS + row * 528 + cc * 16) = kv[i]; }
#pragma unroll
            for (int i = 0; i < 2; ++i) { const int p = tid + 512 * i, row = p >> 4, cc = p & 15; *(LAS u32x4*)(L + SC_VS + row * 272 + cc * 16) = vv[i]; }
            const float ig = ig_n, lf = lf_n;
            if (c + 1 < SEQ / 64) {
                const size_t nrow0 = row0 + 64; ig_n = GATES[(nrow0 + lane) * 16 + h]; lf_n = GATES[(nrow0 + lane) * 16 + 8 + h];
#pragma unroll
                for (int i = 0; i < 4; ++i) { const unsigned so = (unsigned)((nrow0 * NPROJ + h * DQK) * 2); qv[i] = SC_LDQ(i, so); kv[i] = SC_LDQ(i, so + QKW * 2); }
#pragma unroll
                for (int i = 0; i < 2; ++i) vv[i] = SC_LDV(i, (unsigned)((nrow0 * NPROJ + 2 * QKW + h * DV + es * 128) * 2));
            }
            float cv[32]; CvBlk cvb; const bool cvon = cvid < CV_TOTAL;
            if (cvon) { cvb = cv_decode(args.in[11], args.in[14], F.ws, cvid, tid & 63); cv_load(cvb, cv); }
            cvid += F.G * NWAVES;
            LDS_WAIT(); __builtin_amdgcn_s_barrier(); asm volatile("" ::: "memory");
            if (w == 0) {
                const float bs = wave_scan_add(lf, lane);
                const float a = ig - bs; const float pm = wave_scan_max(a, lane);
                const float mprev = scal[0]; const float Mt = fmaxf(mprev, pm);
                const float M63 = __builtin_bit_cast(float, __builtin_amdgcn_readlane(__builtin_bit_cast(int, Mt), 63)), b63 = __builtin_bit_cast(float, __builtin_amdgcn_readlane(__builtin_bit_cast(int, bs), 63));
                sA[lane] = a; sM[lane] = Mt; sWi[lane] = __expf(mprev - Mt); sEi[lane] = __expf(-(bs + Mt)); sKw[lane] = __expf(a - M63);
                if (lane == 0) { scal[1] = __expf(mprev - M63); scal[2] = b63 + M63; }
            }
            { const int t = tid & 63; float s = 0.f;
#pragma unroll
                for (int j = 0; j < 4; ++j) { const int d0 = w * 32 + 8 * j; const u32x4 q = *(const LAS u32x4*)(L + SC_QS + t * 528 + d0 * 2); const LAS float* np = sn + d0;
                    s += bf2f(q.x & 0xffffu) * np[0] + bf2f(q.x >> 16) * np[1] + bf2f(q.y & 0xffffu) * np[2] + bf2f(q.y >> 16) * np[3] + bf2f(q.z & 0xffffu) * np[4] + bf2f(q.z >> 16) * np[5] + bf2f(q.w & 0xffffu) * np[6] + bf2f(q.w >> 16) * np[7]; }
                qnp[w * 64 + t] = s; }
            const int tr = w >> 1, tc0 = (w & 1) * 2; f32x4 s0 = (f32x4){0.f, 0.f, 0.f, 0.f}, s1 = s0;
#pragma unroll
            for (int kk = 0; kk < 8; ++kk) { const bf16x8 a = *(const LAS bf16x8*)(L + SC_QS + (16 * tr + fr) * 528 + (32 * kk + 8 * fq) * 2);
                const bf16x8 b0 = *(const LAS bf16x8*)(L + SC_KS + (16 * tc0 + fr) * 528 + (32 * kk + 8 * fq) * 2); const bf16x8 b1 = *(const LAS bf16x8*)(L + SC_KS + (16 * tc0 + 16 + fr) * 528 + (32 * kk + 8 * fq) * 2);
                s0 = __builtin_amdgcn_mfma_f32_16x16x32_bf16(a, b0, s0, 0, 0, 0); s1 = __builtin_amdgcn_mfma_f32_16x16x32_bf16(a, b1, s1, 0, 0, 0); }
            __syncthreads();
#pragma unroll
            for (int q = 0; q < 2; ++q) { const int tc = tc0 + q, sidx = 16 * tc + fr; const float as = sA[sidx];
#pragma unroll
                for (int r = 0; r < 4; ++r) { const int t = 16 * tr + 4 * fq + r; const float e = __expf(fminf(as - sM[t], 0.f)); const float wgt = (sidx <= t) ? e : 0.f; const float v = (q == 0 ? s0[r] : s1[r]) * wgt;
                    *(LAS unsigned short*)(L + SC_SS + (t * 72 + sidx) * 2) = (unsigned short)cvt_pk_bf16(v, v);
                    rsp[t * 4 + tc] = row_sum16(v); } }
#pragma unroll
            for (int i = 0; i < 2; ++i) { const int p = tid + 512 * i, row = p >> 4, cc = p & 15; const float kw = sKw[row]; const u32x4 v = *(const LAS u32x4*)(L + SC_VS + row * 272 + cc * 16); u32x4 o;
                o.x = cvt_pk_bf16(kw * bf2f(v.x & 0xffffu), kw * bf2f(v.x >> 16)); o.y = cvt_pk_bf16(kw * bf2f(v.y & 0xffffu), kw * bf2f(v.y >> 16));
                o.z = cvt_pk_bf16(kw * bf2f(v.z & 0xffffu), kw * bf2f(v.z >> 16)); o.w = cvt_pk_bf16(kw * bf2f(v.w & 0xffffu), kw * bf2f(v.w >> 16));
                *(LAS u32x4*)(L + SC_VW + row * 272 + cc * 16) = o; }
            __syncthreads();
            if (tid < 64) { const int t = tid; float qn = 0.f;
#pragma unroll
                for (int p = 0; p < 8; ++p) qn += qnp[p * 64 + t];
                const float den = sWi[t] * qn + ((rsp[t * 4 + 0] + rsp[t * 4 + 1]) + (rsp[t * 4 + 2] + rsp[t * 4 + 3]));
                sInv[t] = 1.0f / fmaxf(fabsf(den), sEi[t]); }
            f32x4 nacc[4];
#pragma unroll
            for (int tt = 0; tt < 4; ++tt) nacc[tt] = (f32x4){0.f, 0.f, 0.f, 0.f};
#pragma unroll
            for (int kk = 0; kk < 8; ++kk) {
                u32x4 bw; bw.x = cvt_pk_bf16(C[2 * kk][0], C[2 * kk][1]); bw.y = cvt_pk_bf16(C[2 * kk][2], C[2 * kk][3]); bw.z = cvt_pk_bf16(C[2 * kk + 1][0], C[2 * kk + 1][1]); bw.w = cvt_pk_bf16(C[2 * kk + 1][2], C[2 * kk + 1][3]);
                const bf16x8 bq = __builtin_bit_cast(bf16x8, bw);
#pragma unroll
                for (int tt = 0; tt < 4; ++tt) { const bf16x8 a = *(const LAS bf16x8*)(L + SC_QS + (16 * tt + fr) * 528 + (32 * kk + 8 * fq) * 2);
                    nacc[tt] = __builtin_amdgcn_mfma_f32_16x16x32_bf16(a, bq, nacc[tt], 0, 0, 0); }
            }
#pragma unroll
            for (int tt = 0; tt < 4; ++tt)
#pragma unroll
                for (int r = 0; r < 4; ++r) nacc[tt][r] *= sWi[16 * tt + 4 * fq + r];
#pragma unroll
            for (int kk = 0; kk < 2; ++kk) { const LAS unsigned char* vp = L + SC_VS + (32 * kk + 8 * fq + tq) * 272 + (16 * w + 4 * tp) * 2;
                const bf16x8 bv = cat8(tr16(vp), tr16(vp + 4 * 272));
#pragma unroll
                for (int tt = 0; tt < 4; ++tt) { const bf16x8 as = *(const LAS bf16x8*)(L + SC_SS + ((16 * tt + fr) * 72 + 32 * kk + 8 * fq) * 2);
                    nacc[tt] = __builtin_amdgcn_mfma_f32_16x16x32_bf16(as, bv, nacc[tt], 0, 0, 0); } }
            __syncthreads();
#pragma unroll
            for (int tt = 0; tt < 4; ++tt)
#pragma unroll
                for (int r = 0; r < 4; ++r) { const int t = 16 * tt + 4 * fq + r; const float hv = nacc[tt][r] * sInv[t];
                    *(LAS unsigned short*)(L + SC_HS + t * 272 + (16 * w + fr) * 2) = (unsigned short)cvt_pk_bf16(hv, hv);
                    ssp[w * 64 + t] = row_sum16(hv * hv); }
            const float aprev = scal[1];
#pragma unroll
            for (int i = 0; i < 16; ++i) C[i] *= aprev;
            f32x4 ninc0 = (f32x4){0.f, 0.f, 0.f, 0.f}, ninc1 = ninc0;
#pragma unroll
            for (int kk = 0; kk < 2; ++kk) { const LAS unsigned char* vp = L + SC_VW + (32 * kk + 8 * fq + tq) * 272 + (16 * w + 4 * tp) * 2;
                const bf16x8 bvw = cat8(tr16(vp), tr16(vp + 4 * 272));
                u32x4 kn; { const LAS float* kp = sKw + 32 * kk + 8 * fq; kn.x = cvt_pk_bf16(kp[0], kp[1]); kn.y = cvt_pk_bf16(kp[2], kp[3]); kn.z = cvt_pk_bf16(kp[4], kp[5]); kn.w = cvt_pk_bf16(kp[6], kp[7]); }
                const bf16x8 bn = __builtin_bit_cast(bf16x8, kn);
                const LAS unsigned char* kp0 = L + SC_KS + (32 * kk + 8 * fq + tq) * 528 + (8 * tp) * 2;
#pragma unroll
                for (int T = 0; T < 16; ++T) { const LAS unsigned char* kp = kp0 + (32 * (T >> 1) + 4 * (T & 1)) * 2;
                    const bf16x8 ak = cat8(tr16(kp), tr16(kp + 4 * 528));
                    C[T] = __builtin_amdgcn_mfma_f32_16x16x32_bf16(ak, bvw, C[T], 0, 0, 0); }
                { const LAS unsigned char* kp = kp0 + (32 * w) * 2; const bf16x8 a0 = cat8(tr16(kp), tr16(kp + 4 * 528)), a1 = cat8(tr16(kp + 8), tr16(kp + 8 + 4 * 528));
                    ninc0 = __builtin_amdgcn_mfma_f32_16x16x32_bf16(a0, bn, ninc0, 0, 0, 0); ninc1 = __builtin_amdgcn_mfma_f32_16x16x32_bf16(a1, bn, ninc1, 0, 0, 0); } }
            {
#pragma unroll
                for (int r = 0; r < 4; ++r) { const int d0 = 32 * w + 8 * fq + r; const float n0 = aprev * sn[d0] + ninc0[r], n1 = aprev * sn[d0 + 4] + ninc1[r]; sn[d0] = n0; sn[d0 + 4] = n1; } }
            if (cvon) cv_store(cvb, cv);
        }
    }
    __syncthreads();
#undef SC_LDQ
#undef SC_LDV
}

__device__ __forceinline__ void p3_headnorm(Frame& F, const Args& args) {
    const int gw = F.vcu * NWAVES + F.wave, NGW = F.G * NWAVES;
    for (int m = gw; m < M; m += NGW) {
        u32x4 hva[8], ova[8];
#pragma unroll
        for (int j = 0; j < 8; ++j) { const int col = 512 * j + 8 * F.lane; hva[j] = __builtin_nontemporal_load((const u32x4*)(WSP(bf16, WS_HB) + (size_t)m * D + col)); ova[j] = __builtin_nontemporal_load((const u32x4*)(WSP(bf16, WS_PROJ) + (size_t)m * NPROJ + 2 * QKW + VW + col)); }
#pragma unroll
        for (int j = 0; j < 8; ++j) {
            const f32x4 s4 = *(const f32x4*)(WSP(float, WS_SS) + (size_t)m * 32 + 4 * j); const float r = 1.0f / sqrtf(((s4[0] + s4[1]) + (s4[2] + s4[3])) * (1.f / DV) + EPS);
            const int col = 512 * j + 8 * F.lane;
            const u32x4 hv = hva[j]; const u32x4 ov = ova[j];
            const f32x4 g0 = *(const f32x4*)(args.in[5] + col), g1 = *(const f32x4*)(args.in[5] + col + 4);
            const unsigned hw[4] = {hv.x, hv.y, hv.z, hv.w}, ow[4] = {ov.x, ov.y, ov.z, ov.w}; const float gg[8] = {g0[0], g0[1], g0[2], g0[3], g1[0], g1[1], g1[2], g1[3]}; unsigned res[4];
#pragma unroll
            for (int q = 0; q < 4; ++q) { const float h0 = bf2f(hw[q] & 0xffffu), h1 = bf2f(hw[q] >> 16), o0 = bf2f(ow[q] & 0xffffu), o1 = bf2f(ow[q] >> 16);
                const float y0 = h0 * r * gg[2 * q] / (1.0f + __expf(-o0)), y1 = h1 * r * gg[2 * q + 1] / (1.0f + __expf(-o1)); res[q] = pk2(y0, y1); }
            *(u32x4*)(WSP(bf16, WS_XB) + (size_t)m * D + col) = (u32x4){res[0], res[1], res[2], res[3]};
        }
    }
}

__device__ __forceinline__ void rstd_to_lds(Frame& F, int pm) {
    __syncthreads();
    if (F.tid < 256) { const f32x4* p = (const f32x4*)(WSP(float, WS_RSS) + (size_t)(pm * 256 + F.tid) * 64); float s = 0.f;
#pragma unroll
        for (int j = 0; j < 16; ++j) { const f32x4 v = p[j]; s += (v[0] + v[1]) + (v[2] + v[3]); }
        ((LAS float*)(F.lds + RSTD_OFF))[F.tid] = 1.0f / sqrtf(s * (1.f / D) + EPS); }
    VM_WAIT(); LDS_WAIT();
    __syncthreads();
}

__device__ __forceinline__ void p6_fixup(Frame& F, int layer, bf16* __restrict__ GATED) {
    const int gt = F.vcu * (NWAVES * 64) + F.tid, NGT = F.G * NWAVES * 64;
    const float* __restrict__ cpl = WSP(float, WS_CONVP) + (size_t)layer * FT * 1024; const float* __restrict__ HALO = WSP(float, WS_HALO);
    for (int i = gt; i < 64 * FT * 128; i += NGT) { const int ci = i & 127, pn = (i >> 7) % FT, pm = i / (FT * 128); if ((pm & 7) == 0) continue;
        float hc[2][2];
#pragma unroll
        for (int bj = 0; bj < 2; ++bj) { const int col = 256 * pn + 128 * bj + ci; const float* cp = cpl + (size_t)pn * 1024 + 128 * bj + ci;
            const float w0 = cp[0], w1 = cp[256], w2 = cp[512], cb = cp[768];
            const float hm2 = HALO[((size_t)(pm - 1) * 4 + 2) * NFF1 + col], hm1 = HALO[((size_t)(pm - 1) * 4 + 3) * NFF1 + col], h0 = HALO[((size_t)pm * 4 + 0) * NFF1 + col], h1 = HALO[((size_t)pm * 4 + 1) * NFF1 + col];
            hc[bj][0] = cb + w0 * hm2 + w1 * hm1 + w2 * h0; hc[bj][1] = cb + w0 * hm1 + w1 * h0 + w2 * h1; }
#pragma unroll
        for (int rr = 0; rr < 2; ++rr) GATED[(size_t)(pm * 256 + rr) * KFF2 + 128 * pn + ci] = (bf16)f2bf(hc[0][rr] * hc[1][rr] * __builtin_amdgcn_rcpf(1.0f + __builtin_amdgcn_exp2f(hc[0][rr])));
    }
}

__device__ __forceinline__ f32x2 ld_bf2(const bf16* p) { const unsigned w = *(const unsigned*)p; return (f32x2){bf2f(w & 0xffffu), bf2f(w >> 16)}; }
template <int W> __device__ __forceinline__ void pool_cols(const bf16* xb, const LAS float* rs, const f32x2 g, bf16* ob, int tb) {
    f32x2 prev[16], cur[16]; unsigned raw[16];
#pragma unroll
    for (int i = 0; i < 16; ++i) { if (tb == 0) prev[i] = (f32x2){0.f, 0.f}; else prev[i] = ld_bf2(xb + (size_t)i * D) * rs[i] * g; }
#pragma unroll
    for (int i = 0; i < 16; ++i) raw[i] = *(const unsigned*)(xb + (size_t)(16 + i) * D);
#pragma unroll 1
    for (int blk = 0; blk < 4; ++blk) {
#pragma unroll
        for (int i = 0; i < 16; ++i) cur[i] = (f32x2){bf2f(raw[i] & 0xffffu), bf2f(raw[i] >> 16)} * rs[16 + 16 * blk + i] * g;
        if (blk < 3) {
#pragma unroll
            for (int i = 0; i < 16; ++i) raw[i] = *(const unsigned*)(xb + (size_t)(32 + 16 * blk + i) * D); }
#pragma unroll
        for (int i = 0; i < 16; ++i) { f32x2 s = cur[i];
#pragma unroll
            for (int j = 1; j < W; ++j) s += (i - j >= 0) ? cur[(i - j) & 15] : prev[(16 + i - j) & 15];
            const int t = 64 * tb + 16 * blk + i; const float inv = 1.0f / (float)((t + 1) < W ? (t + 1) : W);
            const f32x2 o = s * inv - cur[i];
            *(unsigned*)(ob + (size_t)(16 * blk + i) * D) = pk2(o[0], o[1]); }
#pragma unroll
        for (int i = 0; i < 16; ++i) prev[i] = cur[i];
    }
}
__device__ __forceinline__ void p8_pool(Frame& F, const Args& args) {
    LAS float* rs = (LAS float*)(F.lds);
    for (int item = F.vcu; item < 256; item += F.G) {
        const int b = item >> 5, tb = item & 31; const size_t r0 = (size_t)b * SEQ + 64 * tb;
        __syncthreads();
        if (F.tid < 80) { float v = 0.f; if (tb > 0 || F.tid >= 16) { const f32x4* p = (const f32x4*)(WSP(float, WS_RSS) + (r0 - 16 + F.tid) * 64); float s = 0.f;
#pragma unroll
                for (int j = 0; j < 16; ++j) { const f32x4 q = p[j]; s += (q[0] + q[1]) + (q[2] + q[3]); }
                v = 1.0f / sqrtf(s * (1.f / D) + EPS); }
            rs[F.tid] = v; }
        __syncthreads();
#pragma unroll 1
        for (int part = 0; part < 4; ++part) { const int q = F.tid + 512 * part, col = 2 * q, grp = part;
            const f32x2 g = *(const f32x2*)(args.in[7] + col); const bf16* xb = WSP(bf16, WS_XA) + (r0 - 16) * D + col; bf16* ob = WSP(bf16, WS_XB) + r0 * D + col;
            if (grp == 0) pool_cols<2>(xb, rs, g, ob, tb); else if (grp == 1) pool_cols<4>(xb, rs, g, ob, tb); else if (grp == 2) pool_cols<8>(xb, rs, g, ob, tb); else pool_cols<16>(xb, rs, g, ob, tb); }
    }
    __syncthreads();
}

__device__ __forceinline__ void p13_final(Frame& F, const Args& args) {
    const int gw = F.vcu * NWAVES + F.wave, NGW = F.G * NWAVES;
    for (int m = gw; m < M; m += NGW) {
        const float rstd = 1.0f / sqrtf(wave_sum(WSP(float, WS_RSS)[(size_t)m * 64 + F.lane]) * (1.f / D) + EPS);
        const u32x4* xr = (const u32x4*)(WSP(bf16, WS_XA) + (size_t)m * D) + F.lane; f32x4* orow = (f32x4*)(F.out + (size_t)m * D) + 2 * F.lane; const f32x4* gr = (const f32x4*)args.in[15] + 2 * F.lane;
        u32x4 xw[8];
#pragma unroll
        for (int j = 0; j < 8; ++j) xw[j] = __builtin_nontemporal_load(xr + 64 * j);
#pragma unroll
        for (int j = 0; j < 8; ++j) { const u32x4 w = xw[j]; const f32x4 g0 = gr[128 * j], g1 = gr[128 * j + 1];
            __builtin_nontemporal_store((f32x4){bf2f(w.x & 0xffffu), bf2f(w.x >> 16), bf2f(w.y & 0xffffu), bf2f(w.y >> 16)} * rstd * g0, orow + 128 * j);
            __builtin_nontemporal_store((f32x4){bf2f(w.z & 0xffffu), bf2f(w.z >> 16), bf2f(w.w & 0xffffu), bf2f(w.w >> 16)} * rstd * g1, orow + 128 * j + 1); }
    }
}

__global__ void __launch_bounds__(NWAVES * 64, 2) fwd(Args args) {
    extern __shared__ __attribute__((aligned(16))) unsigned char lds[];
    Frame F;
    F.lds = (LAS unsigned char*)lds;
    F.tid = threadIdx.x; F.lane = F.tid & 63; F.wave = __builtin_amdgcn_readfirstlane(F.tid >> 6);
    F.G = gridDim.x; { const int bx = blockIdx.x; F.vcu = (F.G % 8 == 0) ? (bx % 8) * (F.G / 8) + bx / 8 : bx; }
    unsigned char* ws = args.ws; F.ws = ws; F.out = args.out;
    gu32* ctl = (gu32*)(ws + WS_CTL);
    for (int u = F.tid; u < (LDS_BYTES - LDSCTL_OFF) / 4; u += NWAVES * 64) ((LAS unsigned*)(F.lds + LDSCTL_OFF))[u] = 0u;
    __syncthreads();
    XcdBarrier bar; bar.bar = (unsigned*)(ctl + CW_BAR); bar.x = 0; bar.st = nullptr;
    if (MK_N_LAUNCHES == 1) bar = xcd_barrier_post((unsigned*)(ctl + CW_BAR), (volatile LAS unsigned*)(F.lds + MISC_OFF));
#define GRID_BAR() do { if (MK_N_LAUNCHES == 1) xcd_barrier(bar); } while (0)
    const int lo = args.ph_lo, hi = args.ph_hi;
#ifndef PHASE_MASK
#define PHASE_MASK 0x3fff
#endif
#define IN(k) ((((PHASE_MASK) >> (k)) & 1) && lo <= (k) && (k) < hi)
#define BOTH(k) (IN(k) && IN((k) + 1))
    bf16* GATED = WSP(bf16, WS_PROJ);
    const int c = (int)blockIdx.x;

    if (IN(0)) { p0_prologue(F, args); if (BOTH(0)) GRID_BAR(); }
    if (IN(1)) {
        pg8::Gemm g{WSP(bf16, WS_XA), WSP(bf16, WS_WP), D, D, D, 0, 0}; pg8::RowOrder S; S.init(NPROJ / 256, c);
        pg8::EpiProj E{WSP(bf16, WS_PROJ), NPROJ};
        pg8::gemm_phase(F.lds + RING_OFF, g, S, E);
        p1_gates(F, args);
        if (BOTH(1)) GRID_BAR();
    }
    if (IN(2)) { p2_scan(F, args); if (BOTH(2)) GRID_BAR(); }
    if (IN(3)) { p3_headnorm(F, args); if (BOTH(3)) GRID_BAR(); }
    if (IN(4)) {
        pg8::Gemm g{WSP(bf16, WS_XB), WSP(bf16, WS_WO), D, D, D, 0, 0}; pg8::RowOrder S; S.init(D / 256, c);
        pg8::EpiResid<false> E{WSP(bf16, WS_XA), args.in[1], nullptr, WSP(bf16, WS_XA), args.in[10], WSP(float, WS_RSS), WSP(float, WS_RINV)};
        pg8::gemm_phase(F.lds + RING_OFF, g, S, E);
        if (BOTH(4)) GRID_BAR();
    }
    if (IN(5)) {
        pg8::Gemm g{WSP(bf16, WS_XA), WSP(bf16, WS_W1), D, D, D, 0, 0}; pg8::RowOrder S; S.init(FT - 2, c);
        rstd_to_lds(F, S.pm);
        float* part = WSP(float, WS_PART) + (size_t)(c & 127) * 65536; unsigned* sflag = (unsigned*)(ctl + CW_SPLIT + 64 * (c & 127));
        { pg8::EpiFfn1T<0> E{GATED, WSP(float, WS_CONVP), WSP(float, WS_HALO), F.lds, part, sflag, 1u};
          pg8::gemm_phase(F.lds + RING_OFF, g, S, E); }
        pg8::TailOrder T; T.init(c);
        if (T.pn0 < 2) { pg8::EpiFfn1T<1> E{GATED, WSP(float, WS_CONVP), WSP(float, WS_HALO), F.lds, part, sflag, 1u}; pg8::gemm_phase(F.lds + RING_OFF, g, T, E); }
        else { pg8::EpiFfn1T<2> E{GATED, WSP(float, WS_CONVP), WSP(float, WS_HALO), F.lds, part, sflag, 1u}; pg8::gemm_phase(F.lds + RING_OFF, g, T, E); }
        if (BOTH(5)) GRID_BAR();
    }
    if (IN(6)) { p6_fixup(F, 0, GATED); if (BOTH(6)) GRID_BAR(); }
    if (IN(7)) {
        pg8::Gemm g{GATED, WSP(bf16, WS_W2), KFF2, KFF2, KFF2, 0, 0}; pg8::WideOrder S; S.init(D / 256, c);
        pg8::EpiResid<false> E{WSP(bf16, WS_XA), args.in[10], nullptr, WSP(bf16, WS_XA), nullptr, WSP(float, WS_RSS), nullptr};
        pg8::gemm_phase(F.lds + RING_OFF, g, S, E);
        if (BOTH(7)) GRID_BAR();
    }
    if (IN(8)) { p8_pool(F, args); if (BOTH(8)) GRID_BAR(); }
    if (IN(9)) {
        pg8::Gemm g{WSP(bf16, WS_XB), WSP(bf16, WS_WPOOL), D, 1024, 1024, 2, 1024}; pg8::RowOrder S; S.init(D / 256, c);
        pg8::EpiResid<false> E{WSP(bf16, WS_XA), nullptr, args.in[9], WSP(bf16, WS_XA), args.in[10] + D, WSP(float, WS_RSS), nullptr};
        pg8::gemm_phase(F.lds + RING_OFF, g, S, E);
        if (BOTH(9)) GRID_BAR();
    }
    if (IN(10)) {
        pg8::Gemm g{WSP(bf16, WS_XA), WSP(bf16, WS_W1) + (size_t)NFF1 * D, D, D, D, 0, 0}; pg8::RowOrder S; S.init(FT - 2, c);
        rstd_to_lds(F, S.pm);
        float* part = WSP(float, WS_PART) + (size_t)(c & 127) * 65536; unsigned* sflag = (unsigned*)(ctl + CW_SPLIT + 64 * (c & 127));
        { pg8::EpiFfn1T<0> E{GATED, WSP(float, WS_CONVP) + (size_t)FT * 1024, WSP(float, WS_HALO), F.lds, part, sflag, 2u};
          pg8::gemm_phase(F.lds + RING_OFF, g, S, E); }
        pg8::TailOrder T; T.init(c);
        if (T.pn0 < 2) { pg8::EpiFfn1T<1> E{GATED, WSP(float, WS_CONVP) + (size_t)FT * 1024, WSP(float, WS_HALO), F.lds, part, sflag, 2u}; pg8::gemm_phase(F.lds + RING_OFF, g, T, E); }
        else { pg8::EpiFfn1T<2> E{GATED, WSP(float, WS_CONVP) + (size_t)FT * 1024, WSP(float, WS_HALO), F.lds, part, sflag, 2u}; pg8::gemm_phase(F.lds + RING_OFF, g, T, E); }
        if (BOTH(10)) GRID_BAR();
    }
    if (IN(11)) { p6_fixup(F, 1, GATED); if (BOTH(11)) GRID_BAR(); }
    if (IN(12)) {
        pg8::Gemm g{GATED, WSP(bf16, WS_W2) + (size_t)D * KFF2, KFF2, KFF2, KFF2, 0, 0}; pg8::WideOrder S; S.init(D / 256, c);
        pg8::EpiResid<false> E{WSP(bf16, WS_XA), args.in[10] + D, nullptr, WSP(bf16, WS_XA), nullptr, WSP(float, WS_RSS), nullptr};
        pg8::gemm_phase(F.lds + RING_OFF, g, S, E);
        if (BOTH(12)) GRID_BAR();
    }
    if (IN(13)) { p13_final(F, args); }
#undef IN
#undef BOTH
}

extern "C" void kernel_launch(void* const* d_in, const int* in_sizes, int n_in, void* d_out, int out_size, void* d_ws, size_t ws_size, hipStream_t stream) {
    static int grid = 0;
    if (grid == 0) {
        if (n_in != 16 || out_size != M * D || ws_size < WS_END3) { fprintf(stderr, "kernel_launch: unexpected shapes (n_in %d, out %d, ws %zu, need %zu)\n", n_in, out_size, ws_size, (size_t)WS_END3); grid = -1; return; }
        if (hipFuncSetAttribute((const void*)fwd, hipFuncAttributeMaxDynamicSharedMemorySize, LDS_BYTES) != hipSuccess) { fprintf(stderr, "kernel_launch: hipFuncSetAttribute failed\n"); grid = -1; return; }
        int per_cu = 0;
        if (hipOccupancyMaxActiveBlocksPerMultiprocessor(&per_cu, (const void*)fwd, NWAVES * 64, LDS_BYTES) != hipSuccess || per_cu < 1) fprintf(stderr, "kernel_launch: occupancy query reports %d\n", per_cu);
        (void)hipGetLastError();
        grid = 256;
    }
    if (grid < 0) return;
    (void)hipMemsetAsync((char*)d_ws + WS_CTL, 0, CTL_ZERO_BYTES, stream);
    Args a{};
    for (int i = 0; i < 16; ++i) a.in[i] = (const float*)d_in[i];
    a.out = (float*)d_out; a.ws = (unsigned char*)d_ws;
    if (MK_N_LAUNCHES == 1) { a.ph_lo = 0; a.ph_hi = NPHASE; a.li = 0; hipLaunchKernelGGL(fwd, dim3(grid), dim3(NWAVES * 64), LDS_BYTES, stream, a); }
    else for (int p = 0; p < NPHASE; ++p) { a.ph_lo = p; a.ph_hi = p + 1; a.li = p; hipLaunchKernelGGL(fwd, dim3(grid), dim3(NWAVES * 64), LDS_BYTES, stream, a); }
}
```

```cpp
#include <hip/hip_runtime.h>
#include <cstdio>
#include <cstdint>

#ifndef MK_N_LAUNCHES
#define MK_N_LAUNCHES 1
#endif

#define GAS __attribute__((address_space(1)))
#define LAS __attribute__((address_space(3)))
typedef unsigned short bf16;
typedef short bf16x8 __attribute__((ext_vector_type(8)));
typedef short bf16x4 __attribute__((ext_vector_type(4)));
typedef float f32x4 __attribute__((ext_vector_type(4)));
typedef float f32x2 __attribute__((ext_vector_type(2)));
typedef unsigned u32x4 __attribute__((ext_vector_type(4)));
typedef unsigned u32x2 __attribute__((ext_vector_type(2)));
typedef GAS unsigned gu32;

constexpr int D = 4096, BATCH = 8, SEQ = 2048, M = BATCH * SEQ;
constexpr int NH = 8, DQK = 256, DV = 512, QKW = 2048, VW = 4096;
constexpr int NPROJ = 12288, PROJ_W = 12304;
constexpr int DFF = 10944, DFF2 = 21888, FT = 86, NFF1 = FT * 256  , KFF2 = FT * 128  ;
constexpr float EPS = 1e-6f;
constexpr int NPHASE = 14;

constexpr size_t MiB = 1u << 20;
constexpr size_t WS_CTL = 0, CTL_ZERO_BYTES = 131072;
constexpr size_t WS_WP = 2 * MiB;
constexpr size_t WS_WG = WS_WP + (size_t)NPROJ * D * 2;
constexpr size_t WS_WO = WS_WG + 1 * MiB;
constexpr size_t WS_W1 = WS_WO + (size_t)D * D * 2;
constexpr size_t WS_W2 = WS_W1 + 2 * (size_t)NFF1 * D * 2;
constexpr size_t WS_WPOOL = WS_W2 + 2 * (size_t)D * KFF2 * 2;
constexpr size_t WS_CONVP = WS_WPOOL + 4 * (size_t)1024 * 1024 * 2;
constexpr size_t WS_XA = WS_CONVP + 1 * MiB;
constexpr size_t WS_XB = WS_XA + (size_t)M * D * 2;
constexpr size_t WS_PROJ = WS_XB + (size_t)M * D * 2;
constexpr size_t WS_HB = WS_PROJ + (size_t)M * NPROJ * 2;
constexpr size_t WS_SS = WS_HB + (size_t)M * D * 2;
constexpr size_t WS_GATES = WS_SS + (size_t)M * 32 * 4;
constexpr size_t WS_RSS = WS_GATES + (size_t)M * 16 * 4;
constexpr size_t WS_HALO = WS_RSS + (size_t)M * 64 * 4;
constexpr size_t WS_END = WS_HALO + (size_t)64 * 4 * NFF1 * 4;
constexpr size_t WS_PART = WS_END, WS_END2 = WS_PART + (size_t)128 * 65536 * 4;
constexpr size_t WS_RINV = (WS_END2 + 4095) & ~(size_t)4095, WS_END3 = WS_RINV + (size_t)M * 4;
static_assert((size_t)M * KFF2 * 2 <= (size_t)M * NPROJ * 2, "GATED overlays PROJ");

constexpr int CW_TMO = 0, CW_BAR = 4096, CW_SPLIT = 8192;
static_assert((CW_BAR + 3456) <= CW_SPLIT && (CW_SPLIT + 64 * 128) * 4 <= (int)CTL_ZERO_BYTES, "control words inside the memset region");

constexpr int RING_OFF = 0, RING_BYTES = 131072;
constexpr int RSTD_OFF = 131072;
constexpr int CONVP_OFF = RSTD_OFF + 1024;
constexpr int EXCH_OFF = CONVP_OFF + 8192;
constexpr int LDSCTL_OFF = EXCH_OFF + 8192;
constexpr int MISC_OFF = LDSCTL_OFF + 64;
constexpr int LDS_BYTES = LDSCTL_OFF + 512;
static_assert(LDS_BYTES <= 160 * 1024, "LDS");

#define RLX_AGENT __ATOMIC_RELAXED, __HIP_MEMORY_SCOPE_AGENT
#define LDS_WAIT() asm volatile("s_waitcnt lgkmcnt(0)" ::: "memory")
#define VM_WAIT() asm volatile("s_waitcnt vmcnt(0)" ::: "memory")
__device__ __forceinline__ unsigned f2bf(float f) { unsigned u = __builtin_bit_cast(unsigned, f); return (u + 0x7fffu + ((u >> 16) & 1u)) >> 16; }
__device__ __forceinline__ unsigned pk2(float lo, float hi) { return f2bf(lo) | (f2bf(hi) << 16); }
__device__ __forceinline__ float bf2f(unsigned b) { return __builtin_bit_cast(float, b << 16); }
__device__ __forceinline__ unsigned cvt_pk_bf16(float lo, float hi) { unsigned r; asm volatile("v_cvt_pk_bf16_f32 %0, %1, %2" : "=v"(r) : "v"(lo), "v"(hi)); return r; }

#ifndef PG8_BAL
#define PG8_BAL 1
#endif
#ifndef PG8_LOADPRIO
#define PG8_LOADPRIO 1
#endif
namespace pg8 {
constexpr int BM = 256, BK = 64, HALF = 128, HTB = HALF * BK * 2, STAGE_BYTES = 8 * HTB;
__host__ __device__ __forceinline__ int lds_byte(int r, int c) { const int st = (r >> 4) * 2 + (c >> 5), rr = r & 15, cc = c & 31, ob = rr * 64 + cc * 2; return st * 1024 + (ob ^ (((ob >> 9) & 1) << 5)); }
__host__ __device__ __forceinline__ void stage_rc(int b, int& R, int& C) { const int st = b / 1024, sb = b % 1024, swz = sb ^ (((sb >> 9) & 1) << 5); R = (st >> 1) * 16 + swz / 64; C = (st & 1) * 32 + (swz % 64) / 2; }
__host__ __device__ __forceinline__ int perm32(int rho) { const int n = rho >> 4, i = rho & 15; return 8 * (i >> 2) + 4 * n + (i & 3); }

struct Unit { int pm, pn; int kt0, nkt; };
struct Gemm { const bf16* A; const bf16* Bt; int lda, ldb, K; int agrp_shift, agrp_stride; };

struct RowOrder {
    static constexpr bool SPLIT = false;
    int pm, pn0, nN;
    __device__ __forceinline__ void init(int nN_, int c) { const int x = c & 7, j = c >> 3; pm = 8 * x + (j & 7); pn0 = j >> 3; nN = nN_; }
    __device__ __forceinline__ bool next(int i, Unit& u) const { const int pn = 4 * i + pn0; u.pm = pm; u.pn = pn; return pn < nN; }
};

struct WideOrder {
    static constexpr bool SPLIT = false;
    int x, j;
    __device__ __forceinline__ void init(int, int c) { x = c & 7; j = c >> 3; }
    __device__ __forceinline__ bool next(int i, Unit& u) const { u.pm = 8 * x + 4 * (i >> 1) + (j & 3); u.pn = 8 * (i & 1) + (j >> 2); return i < 4; }
};
struct TailOrder {
    static constexpr bool SPLIT = true;
    int pm, pn0;
    __device__ __forceinline__ void init(int c) { const int x = c & 7, j = c >> 3; pm = 8 * x + (j & 7); pn0 = j >> 3; }
    __device__ __forceinline__ bool next(int i, Unit& u) const { u.pm = pm; u.pn = 84 + (pn0 & 1); u.kt0 = pn0 < 2 ? 0 : 32; u.nkt = 32; return i == 0; }
};
template <class Epi, class Sched, int PV = 0>
__device__ __forceinline__ void gemm_phase(LAS unsigned char* lds, const Gemm g, const Sched& S, Epi& E) {
    const int tid = threadIdx.x, wid = __builtin_amdgcn_readfirstlane(tid >> 6), lane = tid & 63, wr = wid >> 2, wc = wid & 3, fr = lane & 15, fq = lane >> 4;
    int nt = g.K / BK;
    const unsigned kstep = (unsigned)(BK * 2);
    const unsigned hstepA = (unsigned)HALF * g.lda * 2, hstepB = (unsigned)HALF * g.ldb * 2;
    unsigned voffA0[2], voffB0[2];
#pragma unroll
    for (int i = 0; i < 2; ++i) { int R, C; stage_rc(tid * 16 + i * 8192, R, C); const int Rb = Epi::PERM ? ((R & ~31) + perm32(R & 31)) : R;
        const int Ra = Epi::APERM ? ((R & 64) + 4 * (R & 15) + ((R >> 4) & 3)) : R;
        voffA0[i] = (unsigned)(Ra * g.lda + C) * 2u; voffB0[i] = (unsigned)(Rb * g.ldb + C) * 2u; }
    const __amdgpu_buffer_rsrc_t rsA = __builtin_amdgcn_make_buffer_rsrc((void*)g.A, 0, 0x7fffffff, 0x00020000), rsB = __builtin_amdgcn_make_buffer_rsrc((void*)g.Bt, 0, 0x7fffffff, 0x00020000);
    const unsigned ldsw = (unsigned)wid * 1024u;
    const int aoff = lds_byte(wr * 64 + fr, fq * 8), boff = lds_byte(wc * 32 + fr, fq * 8);
#define PG8_SA(b, h) (((b) * 2 + (h)) * HTB)
#define PG8_SB(b, h) ((4 + (b) * 2 + (h)) * HTB)
#define PG8_STAGE(rs, bufoff, off, voff) do { _Pragma("unroll") for (int _i = 0; _i < 2; ++_i) \
        __builtin_amdgcn_raw_ptr_buffer_load_lds(rs, (LAS void*)(lds + (bufoff) + ldsw + _i * 8192), 16, (voff)[_i], (unsigned)(off), 0, 0); } while (0)
#define PG8_LDA(dst, b, h) do { _Pragma("unroll") for (int m = 0; m < 4; ++m) _Pragma("unroll") for (int k = 0; k < 2; ++k) dst[m][k] = *(const LAS bf16x8*)(lds + PG8_SA(b, h) + aoff + m * 2048 + k * 1024); } while (0)
#define PG8_LDB(dst, b, h) do { _Pragma("unroll") for (int n = 0; n < 2; ++n) _Pragma("unroll") for (int k = 0; k < 2; ++k) dst[n][k] = *(const LAS bf16x8*)(lds + PG8_SB(b, h) + boff + n * 2048 + k * 1024); } while (0)
#define PG8_CH(bj, Bf, m, n) do { _Pragma("unroll") for (int k = 0; k < 2; ++k) acc[ai_][bj][m][n] = __builtin_amdgcn_mfma_f32_16x16x32_bf16(Bf[n][k], At[m][k], acc[ai_][bj][m][n], 0, 0, 0); __builtin_amdgcn_sched_barrier(0); } while (0)
#define PG8_MMA2(ai, B0) do { constexpr int ai_ = ai; __builtin_amdgcn_s_setprio(1); \
          \
        PG8_CH(0, B0, 0, 0); PG8_CH(0, B0, 0, 1); PG8_CH(1, B1, 0, 0); PG8_CH(1, B1, 0, 1); \
        PG8_CH(1, B1, 1, 1); PG8_CH(1, B1, 1, 0); PG8_CH(0, B0, 1, 1); PG8_CH(0, B0, 1, 0); \
        PG8_CH(0, B0, 2, 0); PG8_CH(0, B0, 2, 1); PG8_CH(1, B1, 2, 0); PG8_CH(1, B1, 2, 1); \
        PG8_CH(1, B1, 3, 1); PG8_CH(1, B1, 3, 0); PG8_CH(0, B0, 3, 1); PG8_CH(0, B0, 3, 0); \
        __builtin_amdgcn_s_setprio(PG8_LOADPRIO); } while (0)
#define PG8_WAIT_V(n) asm volatile("s_waitcnt vmcnt(" #n ")" ::: "memory")
#define PG8_WAIT_VL(n) __builtin_amdgcn_s_waitcnt(0x0070 | (n))
#define PG8_BAR __builtin_amdgcn_s_barrier()
#define PG8_SCHED __builtin_amdgcn_sched_barrier(0)
#define PG8_ITER(oA1, oA2, oB2, oB3, lastrd) do { \
            PG8_LDB(B1, 0, 1); PG8_SCHED; PG8_LDA(At, 0, 0); PG8_STAGE(rsA, PG8_SA(1, 0), oA1, voffA0); PG8_STAGE(rsA, PG8_SA(1, 1), (oA1) + hstepA, voffA0); \
            PG8_WAIT_VL(6); PG8_BAR; PG8_MMA2(0, B0e); PG8_BAR; PG8_SCHED; \
            PG8_LDA(At, 0, 1); PG8_LDB(B0o, 1, 0); PG8_STAGE(rsB, PG8_SB(0, 0), oB2, voffB0); PG8_STAGE(rsB, PG8_SB(0, 1), (oB2) + hstepB, voffB0); \
            PG8_WAIT_VL(6); PG8_BAR; PG8_MMA2(1, B0e); PG8_BAR; PG8_SCHED; \
            PG8_LDB(B1, 1, 1); PG8_SCHED; PG8_LDA(At, 1, 0); PG8_STAGE(rsA, PG8_SA(0, 0), oA2, voffA0); PG8_STAGE(rsA, PG8_SA(0, 1), (oA2) + hstepA, voffA0); \
            PG8_WAIT_VL(6); PG8_BAR; PG8_MMA2(0, B0o); PG8_BAR; PG8_SCHED; \
            PG8_LDA(At, 1, 1); if (lastrd) { PG8_LDB(B0e, 0, 0); } PG8_STAGE(rsB, PG8_SB(1, 0), oB3, voffB0); PG8_STAGE(rsB, PG8_SB(1, 1), (oB3) + hstepB, voffB0); \
            PG8_WAIT_VL(6); PG8_BAR; PG8_MMA2(1, B0o); PG8_BAR; PG8_SCHED; } while (0)
    Unit cur, nxt; int ui = 0;
    if (!S.next(0, cur)) return;
    f32x4 acc[2][2][4][2];
#pragma unroll
    for (int a = 0; a < 2; ++a)
#pragma unroll
        for (int b = 0; b < 2; ++b)
#pragma unroll
            for (int m = 0; m < 4; ++m)
#pragma unroll
                for (int n = 0; n < 2; ++n) acc[a][b][m][n] = (f32x4){0.f, 0.f, 0.f, 0.f};
    bf16x8 At[4][2], B0e[2][2], B0o[2][2], B1[2][2];
    unsigned cA = (unsigned)cur.pm * 2 * hstepA + (unsigned)((cur.pn >> g.agrp_shift) * g.agrp_stride) * 2; unsigned cB = (unsigned)cur.pn * 2 * hstepB;
    if constexpr (Sched::SPLIT) { nt = cur.nkt; cA += (unsigned)cur.kt0 * kstep; cB += (unsigned)cur.kt0 * kstep; }
    E.unit_begin(cur, 0, wid, lane);
    PG8_STAGE(rsB, PG8_SB(0, 0), cB, voffB0); PG8_STAGE(rsB, PG8_SB(0, 1), cB + hstepB, voffB0); PG8_STAGE(rsA, PG8_SA(0, 0), cA, voffA0); PG8_STAGE(rsA, PG8_SA(0, 1), cA + hstepA, voffA0);
    if (wr == 1) PG8_BAR;
    PG8_STAGE(rsB, PG8_SB(1, 0), cB + kstep, voffB0); PG8_STAGE(rsB, PG8_SB(1, 1), cB + kstep + hstepB, voffB0);
    PG8_WAIT_V(6); PG8_BAR; PG8_BAR;
    PG8_LDB(B0e, 0, 0);
    for (;;) {
        const bool has_next = S.next(ui + 1, nxt);
        unsigned nko = 0; if constexpr (Sched::SPLIT) nko = has_next ? (unsigned)nxt.kt0 * kstep : 0;
        const unsigned nA = has_next ? (unsigned)nxt.pm * 2 * hstepA + (unsigned)((nxt.pn >> g.agrp_shift) * g.agrp_stride) * 2 + nko : cA; const unsigned nB = has_next ? (unsigned)nxt.pn * 2 * hstepB + nko : cB;
        unsigned oA = cA + kstep, oB = cB + 2 * kstep;
        for (int t = 0; t < nt; t += 2) {
            const bool last = (t == nt - 2);
            const unsigned a2 = last ? nA : oA + kstep, b2 = last ? nB : oB;
            PG8_ITER(oA, a2, b2, b2 + kstep, !last); oA += 2 * kstep; oB += 2 * kstep; }
        if (wr == 0) PG8_BAR;
        E(acc, cur, ui, wr, wc, fr, fq);
        if (!has_next) break;
        { f32x2 z2 = (f32x2){0.f, 0.f}; asm volatile("" : "+v"(z2));
#pragma unroll
        for (int a = 0; a < 2; ++a)
#pragma unroll
            for (int b = 0; b < 2; ++b)
#pragma unroll
                for (int m = 0; m < 4; ++m)
#pragma unroll
                    for (int n = 0; n < 2; ++n) acc[a][b][m][n] = __builtin_shufflevector(z2, z2, 0, 1, 0, 1); }
        cur = nxt; cA = nA; cB = nB; ++ui; if constexpr (Sched::SPLIT) nt = cur.nkt;
        if (wr == 1) PG8_BAR;
        E.unit_begin(cur, ui, wid, lane);
        PG8_LDB(B0e, 0, 0);
    }
    PG8_WAIT_V(0);
    PG8_BAR;
#undef PG8_SA
#undef PG8_SB
#undef PG8_STAGE
#undef PG8_LDA
#undef PG8_LDB
#undef PG8_MMA2
#undef PG8_CH
#undef PG8_WAIT_V
#undef PG8_WAIT_VL
#undef PG8_BAR
#undef PG8_SCHED
#undef PG8_ITER
}

struct EpiProj {
    static constexpr bool PERM = true, APERM = false;
    bf16* O; int ldc;
    __device__ __forceinline__ void unit_begin(const Unit&, int, int, int) const {}
    __device__ __forceinline__ void operator()(const f32x4 (&acc)[2][2][4][2], const Unit& u, int, int wr, int wc, int fr, int fq) const {
        asm volatile("" : "+v"(fr), "+v"(fq));
        const int row0 = u.pm * BM + wr * 64 + fr, col0 = u.pn * BM + wc * 32 + 8 * fq; const float sc = u.pn < 8 ? 0.0625f : 1.f;
#pragma unroll
        for (int ai = 0; ai < 2; ++ai)
#pragma unroll
            for (int m = 0; m < 4; ++m) { bf16* rowp = O + (size_t)(row0 + ai * HALF + m * 16) * ldc + col0;
#pragma unroll
                for (int bj = 0; bj < 2; ++bj) { const f32x4 v0 = acc[ai][bj][m][0] * sc, v1 = acc[ai][bj][m][1] * sc;
                    u32x4 w; w.x = cvt_pk_bf16(v0[0], v0[1]); w.y = cvt_pk_bf16(v0[2], v0[3]); w.z = cvt_pk_bf16(v1[0], v1[1]); w.w = cvt_pk_bf16(v1[2], v1[3]);
                    *(u32x4*)(rowp + bj * HALF) = w; } }
    }
};

struct EpiNull {
    static constexpr bool PERM = false, APERM = false;
    __device__ __forceinline__ void unit_begin(const Unit&, int, int, int) const {}
    __device__ __forceinline__ void operator()(const f32x4 (&acc)[2][2][4][2], const Unit&, int, int, int, int, int) const {
#pragma unroll
        for (int ai = 0; ai < 2; ++ai)
#pragma unroll
            for (int bj = 0; bj < 2; ++bj)
#pragma unroll
                for (int m = 0; m < 4; ++m)
#pragma unroll
                    for (int n = 0; n < 2; ++n) asm volatile("" :: "v"(acc[ai][bj][m][n]));
    }
};
template <bool BASE_F32> struct EpiResid {
    static constexpr bool PERM = true, APERM = false;
    const void* base; const float* ginv_src; const float* colscale; bf16* O; const float* gA; float* rss; const float* rowscale;
    __device__ __forceinline__ void unit_begin(const Unit&, int, int, int) const {}
    __device__ __forceinline__ void operator()(const f32x4 (&acc)[2][2][4][2], const Unit& u, int, int wr, int wc, int fr, int fq) const {
        asm volatile("" : "+v"(fr), "+v"(fq));
        const int row0 = u.pm * BM + wr * 64 + fr, col0 = u.pn * BM + wc * 32 + 8 * fq;
        f32x4 cs[2][2], gv[2][2], gi[2][2];
#pragma unroll
        for (int bj = 0; bj < 2; ++bj)
#pragma unroll
            for (int n = 0; n < 2; ++n) { const int cc = col0 + bj * HALF + 4 * n;
                cs[bj][n] = colscale ? *(const f32x4*)(colscale + cc) : (f32x4){1.f, 1.f, 1.f, 1.f};
                gv[bj][n] = gA ? *(const f32x4*)(gA + cc) : (f32x4){1.f, 1.f, 1.f, 1.f};
                if (ginv_src) { const f32x4 t = *(const f32x4*)(ginv_src + cc); gi[bj][n] = (f32x4){__builtin_amdgcn_rcpf(t[0]), __builtin_amdgcn_rcpf(t[1]), __builtin_amdgcn_rcpf(t[2]), __builtin_amdgcn_rcpf(t[3])}; } else gi[bj][n] = (f32x4){1.f, 1.f, 1.f, 1.f}; }
#pragma unroll
        for (int ai = 0; ai < 2; ++ai) {
            f32x4 pb[4][2][2]; u32x4 pw[4][2];
#pragma unroll
            for (int m = 0; m < 4; ++m) { const size_t off = (size_t)(row0 + ai * HALF + m * 16) * D + col0;
#pragma unroll
                for (int bj = 0; bj < 2; ++bj) {
                    if (BASE_F32) { pb[m][bj][0] = __builtin_nontemporal_load((const f32x4*)((const float*)base + off + bj * HALF)); pb[m][bj][1] = __builtin_nontemporal_load((const f32x4*)((const float*)base + off + bj * HALF + 4)); }
                    else pw[m][bj] = *(const u32x4*)((const bf16*)base + off + bj * HALF); } }
            float rsc[4];
#pragma unroll
            for (int m = 0; m < 4; ++m) rsc[m] = rowscale ? rowscale[row0 + ai * HALF + m * 16] : 1.0f;
#pragma unroll
            for (int m = 0; m < 4; ++m) { const int r = row0 + ai * HALF + m * 16; const size_t off = (size_t)r * D + col0; float ss = 0.f;
#pragma unroll
                for (int bj = 0; bj < 2; ++bj) { f32x4 b0, b1;
                    if (BASE_F32) { b0 = pb[m][bj][0]; b1 = pb[m][bj][1]; }
                    else { const u32x4 w = pw[m][bj];
                        b0 = (f32x4){bf2f(w.x & 0xffffu), bf2f(w.x >> 16), bf2f(w.y & 0xffffu), bf2f(w.y >> 16)}; b1 = (f32x4){bf2f(w.z & 0xffffu), bf2f(w.z >> 16), bf2f(w.w & 0xffffu), bf2f(w.w >> 16)}; }
                    const f32x4 v0 = b0 * (gi[bj][0] * rsc[m]) + acc[ai][bj][m][0] * cs[bj][0], v1 = b1 * (gi[bj][1] * rsc[m]) + acc[ai][bj][m][1] * cs[bj][1];
                    ss += ((v0[0] * v0[0] + v0[1] * v0[1]) + (v0[2] * v0[2] + v0[3] * v0[3])) + ((v1[0] * v1[0] + v1[1] * v1[1]) + (v1[2] * v1[2] + v1[3] * v1[3]));
                    const f32x4 a0 = v0 * gv[bj][0], a1 = v1 * gv[bj][1];
                    u32x4 w; w.x = cvt_pk_bf16(a0[0], a0[1]); w.y = cvt_pk_bf16(a0[2], a0[3]); w.z = cvt_pk_bf16(a1[0], a1[1]); w.w = cvt_pk_bf16(a1[2], a1[3]);
                    *(u32x4*)(O + off + bj * HALF) = w; }
                ss += __shfl_xor(ss, 16); ss += __shfl_xor(ss, 32);
                if (fq == 0) rss[(size_t)r * 64 + u.pn * 4 + wc] = ss; }
            asm volatile("" ::: "memory");
        }
    }
};

__device__ __forceinline__ float dpp_shr1(float old, float src) { return __builtin_bit_cast(float, __builtin_amdgcn_update_dpp(__builtin_bit_cast(int, old), __builtin_bit_cast(int, src), 0x111, 0xf, 0xf, false)); }
__device__ __forceinline__ float dpp_shr2(float old, float src) { return __builtin_bit_cast(float, __builtin_amdgcn_update_dpp(__builtin_bit_cast(int, old), __builtin_bit_cast(int, src), 0x112, 0xf, 0xf, false)); }
__device__ __forceinline__ float dpp_ror1(float src) { return __builtin_bit_cast(float, __builtin_amdgcn_mov_dpp(__builtin_bit_cast(int, src), 0x121, 0xf, 0xf, true)); }
__device__ __forceinline__ float dpp_ror2(float src) { return __builtin_bit_cast(float, __builtin_amdgcn_mov_dpp(__builtin_bit_cast(int, src), 0x122, 0xf, 0xf, true)); }
__device__ __forceinline__ float silu_f(float x) { return x * __builtin_amdgcn_rcpf(1.0f + __builtin_amdgcn_exp2f(-1.44269504089f * x)); }
template <int KIND  > struct EpiFfn1T {
    static constexpr bool PERM = true, APERM = true;
    bf16* O; const float* convp; float* halo; LAS unsigned char* lds; float* part; unsigned* flag; unsigned epoch;
    __device__ __forceinline__ void unit_begin(const Unit& u, int ui, int wid, int lane) const {
        if (wid < 4)
            __builtin_amdgcn_global_load_lds((const unsigned*)((const char*)convp + (size_t)u.pn * 4096 + wid * 1024 + lane * 16), (LAS unsigned*)(lds + CONVP_OFF + (ui & 1) * 4096 + wid * 1024), 16, 0, 0);
    }
    __device__ __forceinline__ void operator()(f32x4 (&acc)[2][2][4][2], const Unit& u, int ui, int wr, int wc, int fr, int fq) const {
        asm volatile("" : "+v"(fr), "+v"(fq));
        const int wid = wr * 4 + wc;
        if constexpr (KIND == 2) {
            const __amdgpu_buffer_rsrc_t rsrc = __builtin_amdgcn_make_buffer_rsrc((void*)part, 0, 262144, 0x00020000);
            const int voff = (wid * 64 + fq * 16 + fr) * 16;
#pragma unroll
            for (int ai = 0; ai < 2; ++ai)
#pragma unroll
                for (int bj = 0; bj < 2; ++bj)
#pragma unroll
                    for (int m = 0; m < 4; ++m)
#pragma unroll
                        for (int n = 0; n < 2; ++n) __builtin_amdgcn_raw_buffer_store_b128(__builtin_bit_cast(u32x4, acc[ai][bj][m][n]), rsrc, voff + (((ai * 2 + bj) * 4 + m) * 2 + n) * 8192, 0, 16);
            asm volatile("s_waitcnt vmcnt(0)" ::: "memory"); __builtin_amdgcn_s_barrier(); asm volatile("" ::: "memory");
            if (wid == 0 && fq == 0 && fr == 0) __hip_atomic_store(flag, epoch, __ATOMIC_RELAXED, __HIP_MEMORY_SCOPE_AGENT);
            return;
        }
        if constexpr (KIND == 1) {
            if (wid == 0) { unsigned sp = 0;
                while ((unsigned)__builtin_amdgcn_readfirstlane(__hip_atomic_load(flag, __ATOMIC_RELAXED, __HIP_MEMORY_SCOPE_AGENT)) < epoch) { __builtin_amdgcn_s_sleep(2); if (++sp > (1u << 22)) break; }
                __builtin_amdgcn_fence(__ATOMIC_ACQUIRE, "agent"); asm volatile("s_waitcnt vmcnt(0)" ::: "memory"); }
            asm volatile("" ::: "memory"); __builtin_amdgcn_s_barrier(); asm volatile("" ::: "memory");
            const f32x4* pp = (const f32x4*)part + (wid * 64 + fq * 16 + fr);
#pragma unroll
            for (int ai = 0; ai < 2; ++ai)
#pragma unroll
                for (int bj = 0; bj < 2; ++bj) {
                    f32x4 t8[4][2];
#pragma unroll
                    for (int m = 0; m < 4; ++m)
#pragma unroll
                        for (int n = 0; n < 2; ++n) t8[m][n] = pp[(((ai * 2 + bj) * 4 + m) * 2 + n) * 512];
#pragma unroll
                    for (int m = 0; m < 4; ++m)
#pragma unroll
                        for (int n = 0; n < 2; ++n) acc[ai][bj][m][n] += t8[m][n];
                    asm volatile("" : "+v"(acc[ai][bj][0][0]), "+v"(acc[ai][bj][0][1]), "+v"(acc[ai][bj][1][0]), "+v"(acc[ai][bj][1][1]), "+v"(acc[ai][bj][2][0]), "+v"(acc[ai][bj][2][1]), "+v"(acc[ai][bj][3][0]), "+v"(acc[ai][bj][3][1]) :: "memory"); }
            asm volatile("" : "+v"(fr), "+v"(fq));
        }
        const LAS float* rstd = (const LAS float*)(lds + RSTD_OFF);
        const LAS float* cp = (const LAS float*)(lds + CONVP_OFF + (ui & 1) * 4096);
        LAS float* ex = (LAS float*)(lds + EXCH_OFF);
#pragma unroll
        for (int ai = 0; ai < 2; ++ai) { const f32x4 rs4 = *(const LAS f32x4*)(rstd + ai * HALF + wr * 64 + 4 * fr);
#pragma unroll
            for (int m = 0; m < 4; ++m)
#pragma unroll
                for (int bj = 0; bj < 2; ++bj)
#pragma unroll
                    for (int n = 0; n < 2; ++n) acc[ai][bj][m][n] *= rs4[m]; }
        if (fr == 15) {
#pragma unroll
            for (int ai = 0; ai < 2; ++ai)
#pragma unroll
                for (int bj = 0; bj < 2; ++bj)
#pragma unroll
                    for (int n = 0; n < 2; ++n) { *(LAS f32x4*)(ex + ((wid * 2 + ai) * 2 + 0) * 64 + (bj * 2 + n) * 16 + fq * 4) = acc[ai][bj][2][n]; *(LAS f32x4*)(ex + ((wid * 2 + ai) * 2 + 1) * 64 + (bj * 2 + n) * 16 + fq * 4) = acc[ai][bj][3][n]; }
        }
        {
            const int colb = u.pn * BM + wc * 32 + 8 * fq;
            if (wr == 0 && fr == 0) {
#pragma unroll
                for (int rr = 0; rr < 2; ++rr)
#pragma unroll
                    for (int bj = 0; bj < 2; ++bj)
#pragma unroll
                        for (int n = 0; n < 2; ++n) *(f32x4*)(halo + ((size_t)u.pm * 4 + rr) * NFF1 + colb + bj * HALF + 4 * n) = acc[0][bj][rr][n];
            }
            if (wr == 1 && fr == 15) {
#pragma unroll
                for (int rr = 0; rr < 2; ++rr)
#pragma unroll
                    for (int bj = 0; bj < 2; ++bj)
#pragma unroll
                        for (int n = 0; n < 2; ++n) *(f32x4*)(halo + ((size_t)u.pm * 4 + 2 + rr) * NFF1 + colb + bj * HALF + 4 * n) = acc[1][bj][2 + rr][n];
            }
        }
        LDS_WAIT(); __builtin_amdgcn_s_barrier(); asm volatile("" ::: "memory");
        const int row0 = u.pm * BM + wr * 64 + 4 * fr, colo = u.pn * HALF + wc * 32 + 8 * fq;
        u32x2 hold[2][4];
        f32x2 kone = (f32x2){1.0f, 1.0f}; asm volatile("" : "+v"(kone));
#pragma unroll
        for (int n = 0; n < 2; ++n) {
            f32x4 pw[4][2];
#pragma unroll
            for (int p = 0; p < 4; ++p)
#pragma unroll
                for (int bj = 0; bj < 2; ++bj) pw[p][bj] = *(const LAS f32x4*)(cp + p * 256 + bj * HALF + wc * 32 + 8 * fq + 4 * n);
#pragma unroll
            for (int ai = 0; ai < 2; ++ai) {
                const int swv = (ai == 1 && wr == 0) ? wid + 4 : wid - 4, sai = (ai == 1 && wr == 1) ? 1 : 0; const bool have = !(ai == 0 && wr == 0);
                f32x4 pm1[2], pm2[2];
#pragma unroll
                for (int bj = 0; bj < 2; ++bj) {
                    f32x4 e0 = (f32x4){0.f, 0.f, 0.f, 0.f}, e1 = e0;
                    if (have) { e0 = *(const LAS f32x4*)(ex + ((swv * 2 + sai) * 2 + 0) * 64 + (bj * 2 + n) * 16 + fq * 4); e1 = *(const LAS f32x4*)(ex + ((swv * 2 + sai) * 2 + 1) * 64 + (bj * 2 + n) * 16 + fq * 4); }
#pragma unroll
                    for (int i = 0; i < 4; ++i) { pm1[bj][i] = dpp_shr1(e1[i], acc[ai][bj][3][n][i]); pm2[bj][i] = dpp_shr1(e0[i], acc[ai][bj][2][n][i]); }
                }
#pragma unroll
                for (int m = 0; m < 4; ++m) {
                    f32x4 hc[2];
#pragma unroll
                    for (int bj = 0; bj < 2; ++bj) {
                        const f32x4 cur = acc[ai][bj][m][n];
                        const f32x4 h1 = m == 0 ? pm1[bj] : acc[ai][bj][m == 0 ? 0 : m - 1][n];
                        const f32x4 h2 = m == 0 ? pm2[bj] : (m == 1 ? pm1[bj] : acc[ai][bj][m < 2 ? 0 : m - 2][n]);
                        hc[bj] = pw[3][bj] + pw[0][bj] * h2 + pw[1][bj] * h1 + pw[2][bj] * cur;
                    }
                    const f32x2 e01 = (f32x2){__builtin_amdgcn_exp2f(hc[0][0]), __builtin_amdgcn_exp2f(hc[0][1])}, e23 = (f32x2){__builtin_amdgcn_exp2f(hc[0][2]), __builtin_amdgcn_exp2f(hc[0][3])};
                    const f32x2 d01 = e01 + kone, d23 = e23 + kone;
                    const f32x4 r = (f32x4){__builtin_amdgcn_rcpf(d01[0]), __builtin_amdgcn_rcpf(d01[1]), __builtin_amdgcn_rcpf(d23[0]), __builtin_amdgcn_rcpf(d23[1])};
                    const f32x4 o = (hc[0] * hc[1]) * r;
                    u32x2 w; w.x = cvt_pk_bf16(o[0], o[1]); w.y = cvt_pk_bf16(o[2], o[3]);
                    if (n == 0) hold[ai][m] = w;
                    else *(u32x4*)(O + (size_t)(row0 + ai * HALF + m) * KFF2 + colo) = (u32x4){hold[ai][m].x, hold[ai][m].y, w.x, w.y};
                }
            }
        }
    }
};
}

#define XB_TMO      128
#define XB_XCNT(j)  (256  + 64 * (j))
#define XB_XSUB(j)  (1280 + 64 * (j))
#define XB_XGEN(j)  (2304 + 64 * (j))
#define XB_TOP      3328
#define XB_TOPGEN   3392
#define XCD_BAR_WORDS 3456
#define XB_SPIN_CAP (1u << 18)
__device__ __forceinline__ unsigned xb_ld(unsigned* p)              { return __hip_atomic_load(p, __ATOMIC_RELAXED, __HIP_MEMORY_SCOPE_AGENT); }
__device__ __forceinline__ unsigned xb_add(unsigned* p, unsigned v) { return __hip_atomic_fetch_add(p, v, __ATOMIC_RELAXED, __HIP_MEMORY_SCOPE_AGENT); }
__device__ __forceinline__ unsigned xb_xcc_id() { return (unsigned)__builtin_amdgcn_s_getreg((3 << 11) | 20) & 0xFu; }
#define XB_SPIN(cond, bar) do { unsigned _sp = 0; while (cond) { __builtin_amdgcn_s_sleep(1); \
    if ((++_sp & 255u) == 0u) { if (xb_ld(&(bar)[XB_TMO])) break; if (_sp > XB_SPIN_CAP) { atomicAdd(&(bar)[XB_TMO], 1u); break; } } } } while (0)
struct XcdBarrier { unsigned* bar; unsigned x; volatile LAS unsigned* st; };
__device__ __forceinline__ XcdBarrier xcd_barrier_post(unsigned* bar, volatile LAS unsigned* st) {
    XcdBarrier b; b.bar = bar; b.x = xb_xcc_id(); b.st = st;
    if (threadIdx.x == 0) (void)xb_add(&bar[XB_XCNT(b.x)], 1u);
    return b;
}
__device__ __forceinline__ void xcd_barrier_complete(unsigned* bar, unsigned x, unsigned& nloc, unsigned& nx) {
    const unsigned G = gridDim.x * gridDim.y * gridDim.z;
    unsigned sum, cnt, mine, sp = 0u;
    for (;;) {
        sum = 0u; cnt = 0u; mine = 0u;
#pragma unroll
        for (unsigned j = 0; j < 16; ++j) { const unsigned c = xb_ld(&bar[XB_XCNT(j)]); sum += c; cnt += (c > 0u) ? 1u : 0u; mine = (j == x) ? c : mine; }
        if (sum == G) break;
        __builtin_amdgcn_s_sleep(1);
        if ((++sp & 255u) == 0u) { if (xb_ld(&bar[XB_TMO])) break; if (sp > XB_SPIN_CAP) { atomicAdd(&bar[XB_TMO], 1u); break; } }
    }
    nloc = mine > 0u ? mine : 1u; nx = cnt > 0u ? cnt : 1u;
}
__device__ __forceinline__ void xcd_barrier(const XcdBarrier& b) {
    asm volatile("s_waitcnt vmcnt(0)" ::: "memory");
    __syncthreads();
    if (threadIdx.x == 0) {
        unsigned* bar = b.bar;
        __builtin_amdgcn_s_waitcnt(0);
        unsigned nloc = b.st[0], nx = b.st[1];
        if (nloc == 0u) { xcd_barrier_complete(bar, b.x, nloc, nx); b.st[0] = nloc; b.st[1] = nx; }
        const unsigned old = xb_add(&bar[XB_XSUB(b.x)], 1u);
        const unsigned gen = old / nloc;
        if (old + 1u == (gen + 1u) * nloc) {
            __builtin_amdgcn_fence(__ATOMIC_RELEASE, "agent");
            asm volatile("s_waitcnt vmcnt(0)" ::: "memory");
            const unsigned og = xb_add(&bar[XB_TOP], 1u);
            const unsigned tg = og / nx;
            if (og + 1u == (tg + 1u) * nx) xb_add(&bar[XB_TOPGEN], 1u);
            else XB_SPIN(xb_ld(&bar[XB_TOPGEN]) == tg, bar);
            __builtin_amdgcn_fence(__ATOMIC_ACQUIRE, "agent");
            xb_add(&bar[XB_XGEN(b.x)], 1u);
            asm volatile("s_waitcnt vmcnt(0)" ::: "memory");
        } else {
            XB_SPIN(xb_ld(&bar[XB_XGEN(b.x)]) == gen, bar);
            __builtin_amdgcn_fence(__ATOMIC_ACQUIRE, "agent");
            asm volatile("s_waitcnt vmcnt(0)" ::: "memory");
        }
    }
    __syncthreads();
}

constexpr int NWAVES = 8;
#define WSP(T, off) ((T*)(F.ws + (off)))
struct Args { const float* in[16]; float* out; unsigned char* ws; int ph_lo, ph_hi, li, pad; };
struct Frame {
    LAS unsigned char* lds; int tid, lane, wave, vcu, G;
    unsigned char* ws; float* out;
};
__device__ __forceinline__ float wave_sum(float v) {
#pragma unroll
    for (int o = 1; o < 64; o <<= 1) v += __shfl_xor(v, o);
    return v;
}

constexpr int CV_NB1 = DFF2 / 64, CV_W1 = (D / 32) * CV_NB1, CV_KB2 = DFF / 32, CV_TOTAL = CV_W1 + CV_KB2 * (D / 64);
static_assert(DFF % 64 == 0 && DFF2 % 64 == 0 && DFF % 32 == 0 && D / 32 == 128, "SCANCVT block shapes");
struct CvBlk { const float* src; bf16* dst; unsigned lds; };
__device__ __forceinline__ CvBlk cv_decode(const float* w1src, const float* w2src, unsigned char* ws, int id, int lane) {
    CvBlk b;
    if (id < CV_W1) { const int kb = id & (D / 32 - 1), nb = id >> 7, n = 64 * nb + lane;        const int f0 = n < DFF ? n : n - DFF; const int rowdst = 256 * (f0 >> 7) + (n < DFF ? 0 : 128) + (f0 & 127);
        b.src = w1src + (size_t)D * DFF2 + (size_t)(32 * kb) * DFF2 + n; b.dst = (bf16*)(ws + WS_W1) + (size_t)NFF1 * D + (size_t)rowdst * D + 32 * kb; b.lds = (unsigned)DFF2; }
    else { const int id2 = id - CV_W1, kb = id2 >> 6, nb = id2 & 63, n = 64 * nb + lane;
        b.src = w2src + (size_t)DFF * D + (size_t)(32 * kb) * D + n; b.dst = (bf16*)(ws + WS_W2) + (size_t)D * KFF2 + (size_t)n * KFF2 + 32 * kb; b.lds = (unsigned)D; }
    return b;
}
__device__ __forceinline__ void cv_load(const CvBlk& b, float (&v)[32]) {
#pragma unroll
    for (int i = 0; i < 32; ++i) v[i] = __builtin_nontemporal_load(b.src + (size_t)i * b.lds);
}
__device__ __forceinline__ void cv_store(const CvBlk& b, const float (&v)[32]) {
#pragma unroll
    for (int q = 0; q < 4; ++q) { u32x4 o; o.x = cvt_pk_bf16(v[8 * q], v[8 * q + 1]); o.y = cvt_pk_bf16(v[8 * q + 2], v[8 * q + 3]); o.z = cvt_pk_bf16(v[8 * q + 4], v[8 * q + 5]); o.w = cvt_pk_bf16(v[8 * q + 6], v[8 * q + 7]);
        *(u32x4*)(b.dst + 8 * q) = o; }
}

__device__ __forceinline__ void tr_item(const float* W, size_t ldw, int k0, int n0, bf16* WT, size_t ldt, int rowdst, LAS float* scr, int lane) {
#pragma unroll 8
    for (int i = 0; i < 32; ++i) { const int kk = 2 * i + (lane >> 5); scr[kk * 33 + (lane & 31)] = __builtin_nontemporal_load(W + (size_t)(k0 + kk) * ldw + n0 + (lane & 31)); }
    LDS_WAIT(); asm volatile("" ::: "memory");
    const int c = lane & 7;
#pragma unroll
    for (int j = 0; j < 4; ++j) { const int n = (lane >> 3) + 8 * j; const LAS float* s = scr + (8 * c) * 33 + n;
        u32x4 o; o.x = pk2(s[0 * 33], s[1 * 33]); o.y = pk2(s[2 * 33], s[3 * 33]); o.z = pk2(s[4 * 33], s[5 * 33]); o.w = pk2(s[6 * 33], s[7 * 33]);
        *(u32x4*)(WT + (size_t)(rowdst + n) * ldt + k0 + 8 * c) = o; }
    LDS_WAIT(); asm volatile("" ::: "memory");
}
__device__ __forceinline__ void rms_row_to_bf16(const float* xrow, const float* g, bf16* orow, float* rinv, int lane) {
    const f32x4* xr = (const f32x4*)xrow + lane; const f32x4* gr = (const f32x4*)g + lane;
    f32x4 v[16]; float s = 0.f;
#pragma unroll
    for (int j = 0; j < 16; ++j) { v[j] = __builtin_nontemporal_load(xr + 64 * j); s += (v[j][0] * v[j][0] + v[j][1] * v[j][1]) + (v[j][2] * v[j][2] + v[j][3] * v[j][3]); }
    const float rms = sqrtf(wave_sum(s) * (1.f / D) + EPS); const float rstd = 1.0f / rms;
    if (lane == 0) *rinv = rms;
    u32x2* o8 = (u32x2*)orow + lane;
#pragma unroll
    for (int j = 0; j < 16; ++j) { const f32x4 gg = gr[64 * j]; u32x2 w; w.x = pk2(v[j][0] * rstd * gg[0], v[j][1] * rstd * gg[1]); w.y = pk2(v[j][2] * rstd * gg[2], v[j][3] * rstd * gg[3]); o8[64 * j] = w; }
}
__device__ __forceinline__ void p0_prologue(Frame& F, const Args& args) {
    LAS float* scr = (LAS float*)(F.lds + RING_OFF + F.wave * 16384);
    const int gw = F.vcu * NWAVES + F.wave, NGW = F.G * NWAVES;
    constexpr int I_P = 64 * 384, I_O = 64 * 128, I_1 = 64 * 684, I_2 = 171 * 128, I_G = 16 * 32;
    constexpr int NITEMS = I_P + I_O + I_1 + I_2 + 4 * I_G;
    for (int it = gw; it < NITEMS; it += NGW) {
        int r = it + I_P; if (r >= NITEMS) r -= NITEMS;
        if (r < I_P) { const int kb = r / 384, nb = r % 384; tr_item(args.in[2], PROJ_W, 64 * kb, 32 * nb, WSP(bf16, WS_WP), D, 32 * nb, scr, F.lane); continue; } r -= I_P;
        if (r < I_O) { const int kb = r / 128, nb = r % 128; tr_item(args.in[6], D, 64 * kb, 32 * nb, WSP(bf16, WS_WO), D, 32 * nb, scr, F.lane); continue; } r -= I_O;
        if (r < I_1) { const int l = 0; const int kb = r / 684, nb = r % 684; const int n0 = 32 * nb; const int f0 = n0 < DFF ? n0 : n0 - DFF;
            const int rowdst = 256 * (f0 >> 7) + (n0 < DFF ? 0 : 128) + (f0 & 127);
            tr_item(args.in[11] + (size_t)l * D * DFF2, DFF2, 64 * kb, n0, WSP(bf16, WS_W1) + (size_t)l * NFF1 * D, D, rowdst, scr, F.lane); continue; } r -= I_1;
        if (r < I_2) { const int l = 0; const int kb = r / 128, nb = r % 128;
            tr_item(args.in[14] + (size_t)l * DFF * D, D, 64 * kb, 32 * nb, WSP(bf16, WS_W2) + (size_t)l * D * KFF2, KFF2, 32 * nb, scr, F.lane); continue; } r -= I_2;
        { const int gidx = r / I_G; r -= gidx * I_G; const int kb = r / 32, nb = r % 32;
            tr_item(args.in[8] + (size_t)gidx * 1024 * 1024, 1024, 64 * kb, 32 * nb, WSP(bf16, WS_WPOOL) + (size_t)gidx * 1024 * 1024, 1024, 32 * nb, scr, F.lane); }
    }
    {
        const int scan_blocks = ((256 + F.G - 1) / F.G) * (SEQ / 64) * NGW;
        for (int id = scan_blocks + gw; id < CV_TOTAL; id += NGW) { float v[32]; const CvBlk b = cv_decode(args.in[11], args.in[14], F.ws, id, F.lane); cv_load(b, v); cv_store(b, v); }
    }
    const int gt = F.vcu * (NWAVES * 64) + F.tid, NGT = F.G * NWAVES * 64;
    for (int i = gt; i < 2 * 128 * (D / 8); i += NGT) { const int l = i / (128 * (D / 8)), rr = (i / (D / 8)) % 128, c8 = i % (D / 8); const int row = 85 * 256 + (rr < 64 ? 64 + rr : 192 + (rr - 64));
        *(u32x4*)(WSP(bf16, WS_W1) + ((size_t)l * NFF1 + row) * D + 8 * c8) = (u32x4){0u, 0u, 0u, 0u}; }
    for (int i = gt; i < 2 * D * 8; i += NGT) { const int l = i / (D * 8), row = (i / 8) % D, c8 = i % 8; *(u32x4*)(WSP(bf16, WS_W2) + ((size_t)l * D + row) * KFF2 + DFF + 8 * c8) = (u32x4){0u, 0u, 0u, 0u}; }
    for (int i = gt; i < 2 * FT * 4 * 256; i += NGT) { const int cc = i & 255, p = (i >> 8) & 3, j = (i >> 10) % FT, l = i / (FT * 1024); const int f = 128 * j + (cc & 127); const int col = cc < 128 ? f : DFF + f;
        float v = 0.f; if (f < DFF) v = p < 3 ? args.in[12][((size_t)l * 3 + p) * DFF2 + col] : args.in[13][(size_t)l * DFF2 + col];
        WSP(float, WS_CONVP)[i] = v * (cc < 128 ? -1.44269504089f : -0.69314718056f); }
    for (int i = gt; i < 16 * D; i += NGT) { const int c = i & 15, k = i >> 4; WSP(bf16, WS_WG)[(size_t)c * D + k] = (bf16)f2bf(args.in[2][(size_t)k * PROJ_W + NPROJ + c]); }
    for (int m = gw; m < M; m += NGW) rms_row_to_bf16(args.in[0] + (size_t)m * D, args.in[1], WSP(bf16, WS_XA) + (size_t)m * D, WSP(float, WS_RINV) + m, F.lane);
}

__device__ __forceinline__ float softcap15(float a) { return 15.0f * tanhf(a * (1.0f / 15.0f)); }
__device__ __forceinline__ void p1_gates(Frame& F, const Args& args) {
    const int gw = F.vcu * NWAVES + F.wave, NGW = F.G * NWAVES; const int fr = F.lane & 15, fq = F.lane >> 4;
    for (int rb = gw; rb < M / 16; rb += NGW) {
        const bf16* ap = WSP(bf16, WS_XA) + (size_t)(rb * 16 + fr) * D + 8 * fq; const bf16* bp = WSP(bf16, WS_WG) + (size_t)fr * D + 8 * fq;
        f32x4 acc = (f32x4){0.f, 0.f, 0.f, 0.f};
#pragma unroll 16
        for (int k = 0; k < D; k += 32) { const bf16x8 a = *(const bf16x8*)(ap + k); const bf16x8 b = *(const bf16x8*)(bp + k); acc = __builtin_amdgcn_mfma_f32_16x16x32_bf16(a, b, acc, 0, 0, 0); }
        const int c = fr; const float bias = c < 8 ? args.in[3][c] : args.in[4][c - 8];
#pragma unroll
        for (int r = 0; r < 4; ++r) { const float z = softcap15(acc[r] + bias); float o = z;
            if (c >= 8) o = fminf(z, 0.f) - log1pf(expf(-fabsf(z)));
            WSP(float, WS_GATES)[(size_t)(rb * 16 + 4 * fq + r) * 16 + c] = o; }
    }
}

__device__ __forceinline__ float row_sum16(float x) {
    x += __builtin_bit_cast(float, __builtin_amdgcn_update_dpp(0, __builtin_bit_cast(int, x), 0x128, 0xf, 0xf, false));
    x += __builtin_bit_cast(float, __builtin_amdgcn_update_dpp(0, __builtin_bit_cast(int, x), 0x124, 0xf, 0xf, false));
    x += __builtin_bit_cast(float, __builtin_amdgcn_update_dpp(0, __builtin_bit_cast(int, x), 0x122, 0xf, 0xf, false));
    x += __builtin_bit_cast(float, __builtin_amdgcn_update_dpp(0, __builtin_bit_cast(int, x), 0x121, 0xf, 0xf, false));
    return x;
}
__device__ __forceinline__ float wave_scan_add(float x, int lane) {
#define SC_STEP(ctrl) x += __builtin_bit_cast(float, __builtin_amdgcn_update_dpp(0, __builtin_bit_cast(int, x), ctrl, 0xf, 0xf, true))
    SC_STEP(0x111); SC_STEP(0x112); SC_STEP(0x114); SC_STEP(0x118);
#undef SC_STEP
    const float t0 = __builtin_bit_cast(float, __builtin_amdgcn_readlane(__builtin_bit_cast(int, x), 15)), t1 = __builtin_bit_cast(float, __builtin_amdgcn_readlane(__builtin_bit_cast(int, x), 31)), t2 = __builtin_bit_cast(float, __builtin_amdgcn_readlane(__builtin_bit_cast(int, x), 47));
    const int g = lane >> 4; return x + (g >= 1 ? t0 : 0.f) + (g >= 2 ? t1 : 0.f) + (g >= 3 ? t2 : 0.f);
}
__device__ __forceinline__ float wave_scan_max(float x, int lane) {
    const int ninf = (int)0xff800000u;
#define SC_STEP(ctrl) x = fmaxf(x, __builtin_bit_cast(float, __builtin_amdgcn_update_dpp(ninf, __builtin_bit_cast(int, x), ctrl, 0xf, 0xf, false)))
    SC_STEP(0x111); SC_STEP(0x112); SC_STEP(0x114); SC_STEP(0x118);
#undef SC_STEP
    const float t0 = __builtin_bit_cast(float, __builtin_amdgcn_readlane(__builtin_bit_cast(int, x), 15)), t1 = __builtin_bit_cast(float, __builtin_amdgcn_readlane(__builtin_bit_cast(int, x), 31)), t2 = __builtin_bit_cast(float, __builtin_amdgcn_readlane(__builtin_bit_cast(int, x), 47));
    const int g = lane >> 4; const float ninff = __builtin_bit_cast(float, ninf);
    return fmaxf(fmaxf(x, g >= 1 ? t0 : ninff), fmaxf(g >= 2 ? t1 : ninff, g >= 3 ? t2 : ninff));
}
typedef short v4i16_t __attribute__((ext_vector_type(4)));
__device__ __forceinline__ v4i16_t tr16(const LAS unsigned char* p) { return __builtin_amdgcn_ds_read_tr16_b64_v4i16((LAS v4i16_t*)p); }
__device__ __forceinline__ bf16x8 cat8(v4i16_t a, v4i16_t b) { return (bf16x8){a[0], a[1], a[2], a[3], b[0], b[1], b[2], b[3]}; }
constexpr int SC_QS = 0, SC_KS = 33792, SC_VS = 67584, SC_VW = 84992, SC_SS = 102400, SC_HS = 111616, SC_FA = 129024;
static_assert(SC_FA + 8192 <= LDSCTL_OFF, "scan LDS map");
__device__ __forceinline__ void p2_scan(Frame& F, const Args& args) {
    LAS unsigned char* L = F.lds;
    LAS float* fa = (LAS float*)(L + SC_FA);
    LAS float *sA = fa, *sM = fa + 64, *sWi = fa + 128, *sEi = fa + 192, *sKw = fa + 256, *sInv = fa + 320, *rsp = fa + 384  , *qnp = fa + 640  , *sn = fa + 1152  , *ssp = fa + 1408  , *scal = fa + 1920;
    const int tid0 = F.tid, w = F.wave;
    const bf16* PROJ = WSP(bf16, WS_PROJ); bf16* HB = WSP(bf16, WS_HB); float* SSg = WSP(float, WS_SS); const float* GATES = WSP(float, WS_GATES);
    const __amdgpu_buffer_rsrc_t rsP = __builtin_amdgcn_make_buffer_rsrc((void*)PROJ, 0, 0x7fffffff, 0x00020000), rsH = __builtin_amdgcn_make_buffer_rsrc((void*)HB, 0, 0x7fffffff, 0x00020000);
#define SC_LDQ(i, soff) __builtin_bit_cast(u32x4, __builtin_amdgcn_raw_buffer_load_b128(rsP, (unsigned)((((tid + 512 * (i)) >> 5) * NPROJ + ((tid + 512 * (i)) & 31) * 8) * 2), (soff), 0))
#define SC_LDV(i, soff) __builtin_bit_cast(u32x4, __builtin_amdgcn_raw_buffer_load_b128(rsP, (unsigned)((((tid + 512 * (i)) >> 4) * NPROJ + ((tid + 512 * (i)) & 15) * 8) * 2), (soff), 2))
    int cvid = F.vcu * NWAVES + F.wave;
    for (int item = F.vcu; item < 256; item += F.G) {
        const int bh = item >> 2, es = item & 3, b = bh >> 3, h = bh & 7;
        f32x4 C[16];
#pragma unroll
        for (int i = 0; i < 16; ++i) C[i] = (f32x4){0.f, 0.f, 0.f, 0.f};
        __syncthreads();
        if (tid0 < 256) sn[tid0] = 0.f;
        if (tid0 == 0) scal[0] = 0.f;
        u32x4 qv[4], kv[4], vv[2]; float ig_n, lf_n;
        { const size_t row0 = (size_t)b * SEQ; const int tid = tid0; ig_n = GATES[(row0 + (tid & 63)) * 16 + h]; lf_n = GATES[(row0 + (tid & 63)) * 16 + 8 + h];
#pragma unroll
            for (int i = 0; i < 4; ++i) { const unsigned so = (unsigned)((row0 * NPROJ + h * DQK) * 2); qv[i] = SC_LDQ(i, so); kv[i] = SC_LDQ(i, so + QKW * 2); }
#pragma unroll
            for (int i = 0; i < 2; ++i) vv[i] = SC_LDV(i, (unsigned)((row0 * NPROJ + 2 * QKW + h * DV + es * 128) * 2)); }
        for (int c = 0; c <= SEQ / 64; ++c) {
            const size_t row0 = (size_t)b * SEQ + 64 * c;
            int tid = tid0; asm volatile("" : "+v"(tid));
            const int lane = tid & 63, fr = lane & 15, fq = lane >> 4, tq = fr >> 2, tp = fr & 3;
            __syncthreads();
            if (c > 0) {
                const size_t prow0 = row0 - 64;
#pragma unroll
                for (int i = 0; i < 2; ++i) { const int p = tid + 512 * i, row = p >> 4, cc = p & 15; __builtin_amdgcn_raw_buffer_store_b128(*(const LAS u32x4*)(L + SC_HS + row * 272 + cc * 16), rsH, (unsigned)((row * D + cc * 8) * 2), (unsigned)((prow0 * D + h * DV + es * 128) * 2), 0); }
                if (tid < 64) { float q = 0.f;
#pragma unroll
                    for (int p = 0; p < 8; ++p) q += ssp[p * 64 + tid];
                    SSg[(prow0 + tid) * 32 + h * 4 + es] = q; }
                if (tid == 0) scal[0] = scal[2];
            }
            if (c == SEQ / 64) break;
#pragma unroll
            for (int i = 0; i < 4; ++i) { const int p = tid + 512 * i, row = p >> 5, cc = p & 31; *(LAS u32x4*)(L + SC_QS + row * 528 + cc * 16) = qv[i]; *(LAS u32x4*)(L + SC_KS + row * 528 + cc * 16) = kv[i]; }
#pragma unroll
            for (int i = 0; i < 2; ++i) { const int p = tid + 512 * i, row = p >> 4, cc = p & 15; *(LAS u32x4*)(L + SC_VS + row * 272 + cc * 16) = vv[i]; }
            const float ig = ig_n, lf = lf_n;
            if (c + 1 < SEQ / 64) {
                const size_t nrow0 = row0 + 64; ig_n = GATES[(nrow0 + lane) * 16 + h]; lf_n = GATES[(nrow0 + lane) * 16 + 8 + h];
#pragma unroll
                for (int i = 0; i < 4; ++i) { const unsigned so = (unsigned)((nrow0 * NPROJ + h * DQK) * 2); qv[i] = SC_LDQ(i, so); kv[i] = SC_LDQ(i, so + QKW * 2); }
#pragma unroll
                for (int i = 0; i < 2; ++i) vv[i] = SC_LDV(i, (unsigned)((nrow0 * NPROJ + 2 * QKW + h * DV + es * 128) * 2));
            }
            float cv[32]; CvBlk cvb; const bool cvon = cvid < CV_TOTAL;
            if (cvon) { cvb = cv_decode(args.in[11], args.in[14], F.ws, cvid, tid & 63); cv_load(cvb, cv); }
            cvid += F.G * NWAVES;
            LDS_WAIT(); __builtin_amdgcn_s_barrier(); asm volatile("" ::: "memory");
            if (w == 0) {
                const float bs = wave_scan_add(lf, lane);
                const float a = ig - bs; const float pm = wave_scan_max(a, lane);
                const float mprev = scal[0]; const float Mt = fmaxf(mprev, pm);
                const float M63 = __builtin_bit_cast(float, __builtin_amdgcn_readlane(__builtin_bit_cast(int, Mt), 63)), b63 = __builtin_bit_cast(float, __builtin_amdgcn_readlane(__builtin_bit_cast(int, bs), 63));
                sA[lane] = a; sM[lane] = Mt; sWi[lane] = __expf(mprev - Mt); sEi[lane] = __expf(-(bs + Mt)); sKw[lane] = __expf(a - M63);
                if (lane == 0) { scal[1] = __expf(mprev - M63); scal[2] = b63 + M63; }
            }
            { const int t = tid & 63; float s = 0.f;
#pragma unroll
                for (int j = 0; j < 4; ++j) { const int d0 = w * 32 + 8 * j; const u32x4 q = *(const LAS u32x4*)(L + SC_QS + t * 528 + d0 * 2); const LAS float* np = sn + d0;
                    s += bf2f(q.x & 0xffffu) * np[0] + bf2f(q.x >> 16) * np[1] + bf2f(q.y & 0xffffu) * np[2] + bf2f(q.y >> 16) * np[3] + bf2f(q.z & 0xffffu) * np[4] + bf2f(q.z >> 16) * np[5] + bf2f(q.w & 0xffffu) * np[6] + bf2f(q.w >> 16) * np[7]; }
                qnp[w * 64 + t] = s; }
            const int tr = w >> 1, tc0 = (w & 1) * 2; f32x4 s0 = (f32x4){0.f, 0.f, 0.f, 0.f}, s1 = s0;
#pragma unroll
            for (int kk = 0; kk < 8; ++kk) { const bf16x8 a = *(const LAS bf16x8*)(L + SC_QS + (16 * tr + fr) * 528 + (32 * kk + 8 * fq) * 2);
                const bf16x8 b0 = *(const LAS bf16x8*)(L + SC_KS + (16 * tc0 + fr) * 528 + (32 * kk + 8 * fq) * 2); const bf16x8 b1 = *(const LAS bf16x8*)(L + SC_KS + (16 * tc0 + 16 + fr) * 528 + (32 * kk + 8 * fq) * 2);
                s0 = __builtin_amdgcn_mfma_f32_16x16x32_bf16(a, b0, s0, 0, 0, 0); s1 = __builtin_amdgcn_mfma_f32_16x16x32_bf16(a, b1, s1, 0, 0, 0); }
            __syncthreads();
#pragma unroll
            for (int q = 0; q < 2; ++q) { const int tc = tc0 + q, sidx = 16 * tc + fr; const float as = sA[sidx];
#pragma unroll
                for (int r = 0; r < 4; ++r) { const int t = 16 * tr + 4 * fq + r; const float e = __expf(fminf(as - sM[t], 0.f)); const float wgt = (sidx <= t) ? e : 0.f; const float v = (q == 0 ? s0[r] : s1[r]) * wgt;
                    *(LAS unsigned short*)(L + SC_SS + (t * 72 + sidx) * 2) = (unsigned short)cvt_pk_bf16(v, v);
                    rsp[t * 4 + tc] = row_sum16(v); } }
#pragma unroll
            for (int i = 0; i < 2; ++i) { const int p = tid + 512 * i, row = p >> 4, cc = p & 15; const float kw = sKw[row]; const u32x4 v = *(const LAS u32x4*)(L + SC_VS + row * 272 + cc * 16); u32x4 o;
                o.x = cvt_pk_bf16(kw * bf2f(v.x & 0xffffu), kw * bf2f(v.x >> 16)); o.y = cvt_pk_bf16(kw * bf2f(v.y & 0xffffu), kw * bf2f(v.y >> 16));
                o.z = cvt_pk_bf16(kw * bf2f(v.z & 0xffffu), kw * bf2f(v.z >> 16)); o.w = cvt_pk_bf16(kw * bf2f(v.w & 0xffffu), kw * bf2f(v.w >> 16));
                *(LAS u32x4*)(L + SC_VW + row * 272 + cc * 16) = o; }
            __syncthreads();
            if (tid < 64) { const int t = tid; float qn = 0.f;
#pragma unroll
                for (int p = 0; p < 8; ++p) qn += qnp[p * 64 + t];
                const float den = sWi[t] * qn + ((rsp[t * 4 + 0] + rsp[t * 4 + 1]) + (rsp[t * 4 + 2] + rsp[t * 4 + 3]));
                sInv[t] = 1.0f / fmaxf(fabsf(den), sEi[t]); }
            f32x4 nacc[4];
#pragma unroll
            for (int tt = 0; tt < 4; ++tt) nacc[tt] = (f32x4){0.f, 0.f, 0.f, 0.f};
#pragma unroll
            for (int kk = 0; kk < 8; ++kk) {
                u32x4 bw; bw.x = cvt_pk_bf16(C[2 * kk][0], C[2 * kk][1]); bw.y = cvt_pk_bf16(C[2 * kk][2], C[2 * kk][3]); bw.z = cvt_pk_bf16(C[2 * kk + 1][0], C[2 * kk + 1][1]); bw.w = cvt_pk_bf16(C[2 * kk + 1][2], C[2 * kk + 1][3]);
                const bf16x8 bq = __builtin_bit_cast(bf16x8, bw);
#pragma unroll
                for (int tt = 0; tt < 4; ++tt) { const bf16x8 a = *(const LAS bf16x8*)(L + SC_QS + (16 * tt + fr) * 528 + (32 * kk + 8 * fq) * 2);
                    nacc[tt] = __builtin_amdgcn_mfma_f32_16x16x32_bf16(a, bq, nacc[tt], 0, 0, 0); }
            }
#pragma unroll
            for (int tt = 0; tt < 4; ++tt)
#pragma unroll
                for (int r = 0; r < 4; ++r) nacc[tt][r] *= sWi[16 * tt + 4 * fq + r];
#pragma unroll
            for (int kk = 0; kk < 2; ++kk) { const LAS unsigned char* vp = L + SC_VS + (32 * kk + 8 * fq + tq) * 272 + (16 * w + 4 * tp) * 2;
                const bf16x8 bv = cat8(tr16(vp), tr16(vp + 4 * 272));
#pragma unroll
                for (int tt = 0; tt < 4; ++tt) { const bf16x8 as = *(const LAS bf16x8*)(L + SC_SS + ((16 * tt + fr) * 72 + 32 * kk + 8 * fq) * 2);
                    nacc[tt] = __builtin_amdgcn_mfma_f32_16x16x32_bf16(as, bv, nacc[tt], 0, 0, 0); } }
            __syncthreads();
#pragma unroll
            for (int tt = 0; tt < 4; ++tt)
#pragma unroll
                for (int r = 0; r < 4; ++r) { const int t = 16 * tt + 4 * fq + r; const float hv = nacc[tt][r] * sInv[t];
                    *(LAS unsigned short*)(L + SC_HS + t * 272 + (16 * w + fr) * 2) = (unsigned short)cvt_pk_bf16(hv, hv);
                    ssp[w * 64 + t] = row_sum16(hv * hv); }
            const float aprev = scal[1];
#pragma unroll
            for (int i = 0; i < 16; ++i) C[i] *= aprev;
            f32x4 ninc0 = (f32x4){0.f, 0.f, 0.f, 0.f}, ninc1 = ninc0;
#pragma unroll
            for (int kk = 0; kk < 2; ++kk) { const LAS unsigned char* vp = L + SC_VW + (32 * kk + 8 * fq + tq) * 272 + (16 * w + 4 * tp) * 2;
                const bf16x8 bvw = cat8(tr16(vp), tr16(vp + 4 * 272));
                u32x4 kn; { const LAS float* kp = sKw + 32 * kk + 8 * fq; kn.x = cvt_pk_bf16(kp[0], kp[1]); kn.y = cvt_pk_bf16(kp[2], kp[3]); kn.z = cvt_pk_bf16(kp[4], kp[5]); kn.w = cvt_pk_bf16(kp[6], kp[7]); }
                const bf16x8 bn = __builtin_bit_cast(bf16x8, kn);
                const LAS unsigned char* kp0 = L + SC_KS + (32 * kk + 8 * fq + tq) * 528 + (8 * tp) * 2;
#pragma unroll
                for (int T = 0; T < 16; ++T) { const LAS unsigned char* kp = kp0 + (32 * (T >> 1) + 4 * (T & 1)) * 2;
                    const bf16x8 ak = cat8(tr16(kp), tr16(kp + 4 * 528));
                    C[T] = __builtin_amdgcn_mfma_f32_16x16x32_bf16(ak, bvw, C[T], 0, 0, 0); }
                { const LAS unsigned char* kp = kp0 + (32 * w) * 2; const bf16x8 a0 = cat8(tr16(kp), tr16(kp + 4 * 528)), a1 = cat8(tr16(kp + 8), tr16(kp + 8 + 4 * 528));
                    ninc0 = __builtin_amdgcn_mfma_f32_16x16x32_bf16(a0, bn, ninc0, 0, 0, 0); ninc1 = __builtin_amdgcn_mfma_f32_16x16x32_bf16(a1, bn, ninc1, 0, 0, 0); } }
            {
#pragma unroll
                for (int r = 0; r < 4; ++r) { const int d0 = 32 * w + 8 * fq + r; const float n0 = aprev * sn[d0] + ninc0[r], n1 = aprev * sn[d0 + 4] + ninc1[r]; sn[d0] = n0; sn[d0 + 4] = n1; } }
            if (cvon) cv_store(cvb, cv);
        }
    }
    __syncthreads();
#undef SC_LDQ
#undef SC_LDV
}

__device__ __forceinline__ void p3_headnorm(Frame& F, const Args& args) {
    const int gw = F.vcu * NWAVES + F.wave, NGW = F.G * NWAVES;
    for (int m = gw; m < M; m += NGW) {
        u32x4 hva[8], ova[8];
#pragma unroll
        for (int j = 0; j < 8; ++j) { const int col = 512 * j + 8 * F.lane; hva[j] = __builtin_nontemporal_load((const u32x4*)(WSP(bf16, WS_HB) + (size_t)m * D + col)); ova[j] = __builtin_nontemporal_load((const u32x4*)(WSP(bf16, WS_PROJ) + (size_t)m * NPROJ + 2 * QKW + VW + col)); }
#pragma unroll
        for (int j = 0; j < 8; ++j) {
            const f32x4 s4 = *(const f32x4*)(WSP(float, WS_SS) + (size_t)m * 32 + 4 * j); const float r = __builtin_amdgcn_rsqf(((s4[0] + s4[1]) + (s4[2] + s4[3])) * (1.f / DV) + EPS);
            const int col = 512 * j + 8 * F.lane;
            const u32x4 hv = hva[j]; const u32x4 ov = ova[j];
            const f32x4 g0 = *(const f32x4*)(args.in[5] + col), g1 = *(const f32x4*)(args.in[5] + col + 4);
            const unsigned hw[4] = {hv.x, hv.y, hv.z, hv.w}, ow[4] = {ov.x, ov.y, ov.z, ov.w}; const float gg[8] = {g0[0], g0[1], g0[2], g0[3], g1[0], g1[1], g1[2], g1[3]}; unsigned res[4];
#pragma unroll
            for (int q = 0; q < 4; ++q) { const float h0 = bf2f(hw[q] & 0xffffu), h1 = bf2f(hw[q] >> 16), o0 = bf2f(ow[q] & 0xffffu), o1 = bf2f(ow[q] >> 16);
                const float y0 = h0 * r * gg[2 * q] * __builtin_amdgcn_rcpf(1.0f + __builtin_amdgcn_exp2f(-1.44269504089f * o0)), y1 = h1 * r * gg[2 * q + 1] * __builtin_amdgcn_rcpf(1.0f + __builtin_amdgcn_exp2f(-1.44269504089f * o1)); res[q] = pk2(y0, y1); }
            *(u32x4*)(WSP(bf16, WS_XB) + (size_t)m * D + col) = (u32x4){res[0], res[1], res[2], res[3]};
        }
    }
}

__device__ __forceinline__ void rstd_to_lds(Frame& F, int pm) {
    __syncthreads();
    if (F.tid < 256) { const f32x4* p = (const f32x4*)(WSP(float, WS_RSS) + (size_t)(pm * 256 + F.tid) * 64); float s = 0.f;
#pragma unroll
        for (int j = 0; j < 16; ++j) { const f32x4 v = p[j]; s += (v[0] + v[1]) + (v[2] + v[3]); }
        ((LAS float*)(F.lds + RSTD_OFF))[F.tid] = 1.0f / sqrtf(s * (1.f / D) + EPS); }
    VM_WAIT(); LDS_WAIT();
    __syncthreads();
}

__device__ __forceinline__ void p6_fixup(Frame& F, int layer, bf16* __restrict__ GATED) {
    const int gt = F.vcu * (NWAVES * 64) + F.tid, NGT = F.G * NWAVES * 64;
    const float* __restrict__ cpl = WSP(float, WS_CONVP) + (size_t)layer * FT * 1024; const float* __restrict__ HALO = WSP(float, WS_HALO);
    for (int i = gt; i < 64 * FT * 128; i += NGT) { const int ci = i & 127, pn = (i >> 7) % FT, pm = i / (FT * 128); if ((pm & 7) == 0) continue;
        float hc[2][2];
#pragma unroll
        for (int bj = 0; bj < 2; ++bj) { const int col = 256 * pn + 128 * bj + ci; const float* cp = cpl + (size_t)pn * 1024 + 128 * bj + ci;
            const float w0 = cp[0], w1 = cp[256], w2 = cp[512], cb = cp[768];
            const float hm2 = HALO[((size_t)(pm - 1) * 4 + 2) * NFF1 + col], hm1 = HALO[((size_t)(pm - 1) * 4 + 3) * NFF1 + col], h0 = HALO[((size_t)pm * 4 + 0) * NFF1 + col], h1 = HALO[((size_t)pm * 4 + 1) * NFF1 + col];
            hc[bj][0] = cb + w0 * hm2 + w1 * hm1 + w2 * h0; hc[bj][1] = cb + w0 * hm1 + w1 * h0 + w2 * h1; }
#pragma unroll
        for (int rr = 0; rr < 2; ++rr) GATED[(size_t)(pm * 256 + rr) * KFF2 + 128 * pn + ci] = (bf16)f2bf(hc[0][rr] * hc[1][rr] * __builtin_amdgcn_rcpf(1.0f + __builtin_amdgcn_exp2f(hc[0][rr])));
    }
}

__device__ __forceinline__ f32x2 ld_bf2(const bf16* p) { const unsigned w = *(const unsigned*)p; return (f32x2){bf2f(w & 0xffffu), bf2f(w >> 16)}; }
template <int W> __device__ __forceinline__ void pool_cols(const bf16* xb, const LAS float* rs, const f32x2 g, bf16* ob, int tb) {
    f32x2 prev[16], cur[16]; unsigned raw[16];
#pragma unroll
    for (int i = 0; i < 16; ++i) { if (tb == 0) prev[i] = (f32x2){0.f, 0.f}; else prev[i] = ld_bf2(xb + (size_t)i * D) * rs[i] * g; }
#pragma unroll
    for (int i = 0; i < 16; ++i) raw[i] = *(const unsigned*)(xb + (size_t)(16 + i) * D);
#pragma unroll 1
    for (int blk = 0; blk < 4; ++blk) {
#pragma unroll
        for (int i = 0; i < 16; ++i) cur[i] = (f32x2){bf2f(raw[i] & 0xffffu), bf2f(raw[i] >> 16)} * rs[16 + 16 * blk + i] * g;
        if (blk < 3) {
#pragma unroll
            for (int i = 0; i < 16; ++i) raw[i] = *(const unsigned*)(xb + (size_t)(32 + 16 * blk + i) * D); }
#pragma unroll
        for (int i = 0; i < 16; ++i) { f32x2 s = cur[i];
#pragma unroll
            for (int j = 1; j < W; ++j) s += (i - j >= 0) ? cur[(i - j) & 15] : prev[(16 + i - j) & 15];
            const int t = 64 * tb + 16 * blk + i; const float inv = (t + 1) < W ? __builtin_amdgcn_rcpf((float)(t + 1)) : (1.0f / (float)W);
            const f32x2 o = s * inv - cur[i];
            *(unsigned*)(ob + (size_t)(16 * blk + i) * D) = pk2(o[0], o[1]); }
#pragma unroll
        for (int i = 0; i < 16; ++i) prev[i] = cur[i];
    }
}
__device__ __forceinline__ void p8_pool(Frame& F, const Args& args) {
    LAS float* rs = (LAS float*)(F.lds);
    for (int item = F.vcu; item < 256; item += F.G) {
        const int b = item >> 5, tb = item & 31; const size_t r0 = (size_t)b * SEQ + 64 * tb;
        __syncthreads();
        if (F.tid < 80) { float v = 0.f; if (tb > 0 || F.tid >= 16) { const f32x4* p = (const f32x4*)(WSP(float, WS_RSS) + (r0 - 16 + F.tid) * 64); float s = 0.f;
#pragma unroll
                for (int j = 0; j < 16; ++j) { const f32x4 q = p[j]; s += (q[0] + q[1]) + (q[2] + q[3]); }
                v = 1.0f / sqrtf(s * (1.f / D) + EPS); }
            rs[F.tid] = v; }
        __syncthreads();
#pragma unroll 1
        for (int part = 0; part < 4; ++part) { const int q = F.tid + 512 * part, col = 2 * q, grp = part;
            const f32x2 g = *(const f32x2*)(args.in[7] + col); const bf16* xb = WSP(bf16, WS_XA) + (r0 - 16) * D + col; bf16* ob = WSP(bf16, WS_XB) + r0 * D + col;
            if (grp == 0) pool_cols<2>(xb, rs, g, ob, tb); else if (grp == 1) pool_cols<4>(xb, rs, g, ob, tb); else if (grp == 2) pool_cols<8>(xb, rs, g, ob, tb); else pool_cols<16>(xb, rs, g, ob, tb); }
    }
    __syncthreads();
}

__device__ __forceinline__ void p13_final(Frame& F, const Args& args) {
    const int gw = F.vcu * NWAVES + F.wave, NGW = F.G * NWAVES;
    for (int m = gw; m < M; m += NGW) {
        const float rstd = 1.0f / sqrtf(wave_sum(WSP(float, WS_RSS)[(size_t)m * 64 + F.lane]) * (1.f / D) + EPS);
        const u32x4* xr = (const u32x4*)(WSP(bf16, WS_XA) + (size_t)m * D) + F.lane; f32x4* orow = (f32x4*)(F.out + (size_t)m * D) + 2 * F.lane; const f32x4* gr = (const f32x4*)args.in[15] + 2 * F.lane;
        u32x4 xw[8];
#pragma unroll
        for (int j = 0; j < 8; ++j) xw[j] = __builtin_nontemporal_load(xr + 64 * j);
#pragma unroll
        for (int j = 0; j < 8; ++j) { const u32x4 w = xw[j]; const f32x4 g0 = gr[128 * j], g1 = gr[128 * j + 1];
            __builtin_nontemporal_store((f32x4){bf2f(w.x & 0xffffu), bf2f(w.x >> 16), bf2f(w.y & 0xffffu), bf2f(w.y >> 16)} * rstd * g0, orow + 128 * j);
            __builtin_nontemporal_store((f32x4){bf2f(w.z & 0xffffu), bf2f(w.z >> 16), bf2f(w.w & 0xffffu), bf2f(w.w >> 16)} * rstd * g1, orow + 128 * j + 1); }
    }
}

__global__ void __launch_bounds__(NWAVES * 64, 2) fwd(Args args) {
    extern __shared__ __attribute__((aligned(16))) unsigned char lds[];
    Frame F;
    F.lds = (LAS unsigned char*)lds;
    F.tid = threadIdx.x; F.lane = F.tid & 63; F.wave = __builtin_amdgcn_readfirstlane(F.tid >> 6);
    F.G = gridDim.x; { const int bx = blockIdx.x; F.vcu = (F.G % 8 == 0) ? (bx % 8) * (F.G / 8) + bx / 8 : bx; }
    unsigned char* ws = args.ws; F.ws = ws; F.out = args.out;
    gu32* ctl = (gu32*)(ws + WS_CTL);
    for (int u = F.tid; u < (LDS_BYTES - LDSCTL_OFF) / 4; u += NWAVES * 64) ((LAS unsigned*)(F.lds + LDSCTL_OFF))[u] = 0u;
    __syncthreads();
    XcdBarrier bar; bar.bar = (unsigned*)(ctl + CW_BAR); bar.x = 0; bar.st = nullptr;
    if (MK_N_LAUNCHES == 1) bar = xcd_barrier_post((unsigned*)(ctl + CW_BAR), (volatile LAS unsigned*)(F.lds + MISC_OFF));
#define GRID_BAR() do { if (MK_N_LAUNCHES == 1) xcd_barrier(bar); } while (0)
    const int lo = args.ph_lo, hi = args.ph_hi;
#ifndef PHASE_MASK
#define PHASE_MASK 0x3fff
#endif
#define IN(k) ((((PHASE_MASK) >> (k)) & 1) && lo <= (k) && (k) < hi)
#define BOTH(k) (IN(k) && IN((k) + 1))
    bf16* GATED = WSP(bf16, WS_PROJ);
    const int c = (int)blockIdx.x;

    if (IN(0)) { p0_prologue(F, args); if (BOTH(0)) GRID_BAR(); }
    if (IN(1)) {
        pg8::Gemm g{WSP(bf16, WS_XA), WSP(bf16, WS_WP), D, D, D, 0, 0}; pg8::RowOrder S; S.init(NPROJ / 256, c);
        pg8::EpiProj E{WSP(bf16, WS_PROJ), NPROJ};
        pg8::gemm_phase(F.lds + RING_OFF, g, S, E);
        p1_gates(F, args);
        if (BOTH(1)) GRID_BAR();
    }
    if (IN(2)) { p2_scan(F, args); if (BOTH(2)) GRID_BAR(); }
    if (IN(3)) { p3_headnorm(F, args); if (BOTH(3)) GRID_BAR(); }
    if (IN(4)) {
        pg8::Gemm g{WSP(bf16, WS_XB), WSP(bf16, WS_WO), D, D, D, 0, 0}; pg8::RowOrder S; S.init(D / 256, c);
        pg8::EpiResid<false> E{WSP(bf16, WS_XA), args.in[1], nullptr, WSP(bf16, WS_XA), args.in[10], WSP(float, WS_RSS), WSP(float, WS_RINV)};
        pg8::gemm_phase(F.lds + RING_OFF, g, S, E);
        if (BOTH(4)) GRID_BAR();
    }
    if (IN(5)) {
        pg8::Gemm g{WSP(bf16, WS_XA), WSP(bf16, WS_W1), D, D, D, 0, 0}; pg8::RowOrder S; S.init(FT - 2, c);
        rstd_to_lds(F, S.pm);
        float* part = WSP(float, WS_PART) + (size_t)(c & 127) * 65536; unsigned* sflag = (unsigned*)(ctl + CW_SPLIT + 64 * (c & 127));
        { pg8::EpiFfn1T<0> E{GATED, WSP(float, WS_CONVP), WSP(float, WS_HALO), F.lds, part, sflag, 1u};
          pg8::gemm_phase(F.lds + RING_OFF, g, S, E); }
        pg8::TailOrder T; T.init(c);
        if (T.pn0 < 2) { pg8::EpiFfn1T<1> E{GATED, WSP(float, WS_CONVP), WSP(float, WS_HALO), F.lds, part, sflag, 1u}; pg8::gemm_phase(F.lds + RING_OFF, g, T, E); }
        else { pg8::EpiFfn1T<2> E{GATED, WSP(float, WS_CONVP), WSP(float, WS_HALO), F.lds, part, sflag, 1u}; pg8::gemm_phase(F.lds + RING_OFF, g, T, E); }
        if (BOTH(5)) GRID_BAR();
    }
    if (IN(6)) { p6_fixup(F, 0, GATED); if (BOTH(6)) GRID_BAR(); }
    if (IN(7)) {
        pg8::Gemm g{GATED, WSP(bf16, WS_W2), KFF2, KFF2, KFF2, 0, 0}; pg8::WideOrder S; S.init(D / 256, c);
        pg8::EpiResid<false> E{WSP(bf16, WS_XA), args.in[10], nullptr, WSP(bf16, WS_XA), nullptr, WSP(float, WS_RSS), nullptr};
        pg8::gemm_phase(F.lds + RING_OFF, g, S, E);
        if (BOTH(7)) GRID_BAR();
    }
    if (IN(8)) { p8_pool(F, args); if (BOTH(8)) GRID_BAR(); }
    if (IN(9)) {
        pg8::Gemm g{WSP(bf16, WS_XB), WSP(bf16, WS_WPOOL), D, 1024, 1024, 2, 1024}; pg8::RowOrder S; S.init(D / 256, c);
        pg8::EpiResid<false> E{WSP(bf16, WS_XA), nullptr, args.in[9], WSP(bf16, WS_XA), args.in[10] + D, WSP(float, WS_RSS), nullptr};
        pg8::gemm_phase(F.lds + RING_OFF, g, S, E);
        if (BOTH(9)) GRID_BAR();
    }
    if (IN(10)) {
        pg8::Gemm g{WSP(bf16, WS_XA), WSP(bf16, WS_W1) + (size_t)NFF1 * D, D, D, D, 0, 0}; pg8::RowOrder S; S.init(FT - 2, c);
        rstd_to_lds(F, S.pm);
        float* part = WSP(float, WS_PART) + (size_t)(c & 127) * 65536; unsigned* sflag = (unsigned*)(ctl + CW_SPLIT + 64 * (c & 127));
        { pg8::EpiFfn1T<0> E{GATED, WSP(float, WS_CONVP) + (size_t)FT * 1024, WSP(float, WS_HALO), F.lds, part, sflag, 2u};
          pg8::gemm_phase(F.lds + RING_OFF, g, S, E); }
        pg8::TailOrder T; T.init(c);
        if (T.pn0 < 2) { pg8::EpiFfn1T<1> E{GATED, WSP(float, WS_CONVP) + (size_t)FT * 1024, WSP(float, WS_HALO), F.lds, part, sflag, 2u}; pg8::gemm_phase(F.lds + RING_OFF, g, T, E); }
        else { pg8::EpiFfn1T<2> E{GATED, WSP(float, WS_CONVP) + (size_t)FT * 1024, WSP(float, WS_HALO), F.lds, part, sflag, 2u}; pg8::gemm_phase(F.lds + RING_OFF, g, T, E); }
        if (BOTH(10)) GRID_BAR();
    }
    if (IN(11)) { p6_fixup(F, 1, GATED); if (BOTH(11)) GRID_BAR(); }
    if (IN(12)) {
        pg8::Gemm g{GATED, WSP(bf16, WS_W2) + (size_t)D * KFF2, KFF2, KFF2, KFF2, 0, 0}; pg8::WideOrder S; S.init(D / 256, c);
        pg8::EpiResid<false> E{WSP(bf16, WS_XA), args.in[10] + D, nullptr, WSP(bf16, WS_XA), nullptr, WSP(float, WS_RSS), nullptr};
        pg8::gemm_phase(F.lds + RING_OFF, g, S, E);
        if (BOTH(12)) GRID_BAR();
    }
    if (IN(13)) { p13_final(F, args); }
#undef IN
#undef BOTH
}

extern "C" void kernel_launch(void* const* d_in, const int* in_sizes, int n_in, void* d_out, int out_size, void* d_ws, size_t ws_size, hipStream_t stream) {
    static int grid = 0;
    if (grid == 0) {
        if (n_in != 16 || out_size != M * D || ws_size < WS_END3) { fprintf(stderr, "kernel_launch: unexpected shapes (n_in %d, out %d, ws %zu, need %zu)\n", n_in, out_size, ws_size, (size_t)WS_END3); grid = -1; return; }
        if (hipFuncSetAttribute((const void*)fwd, hipFuncAttributeMaxDynamicSharedMemorySize, LDS_BYTES) != hipSuccess) { fprintf(stderr, "kernel_launch: hipFuncSetAttribute failed\n"); grid = -1; return; }
        int per_cu = 0;
        if (hipOccupancyMaxActiveBlocksPerMultiprocessor(&per_cu, (const void*)fwd, NWAVES * 64, LDS_BYTES) != hipSuccess || per_cu < 1) fprintf(stderr, "kernel_launch: occupancy query reports %d\n", per_cu);
        (void)hipGetLastError();
        grid = 256;
    }
    if (grid < 0) return;
    (void)hipMemsetAsync((char*)d_ws + WS_CTL, 0, CTL_ZERO_BYTES, stream);
    Args a{};
    for (int i = 0; i < 16; ++i) a.in[i] = (const float*)d_in[i];
    a.out = (float*)d_out; a.ws = (unsigned char*)d_ws;
    if (MK_N_LAUNCHES == 1) { a.ph_lo = 0; a.ph_hi = NPHASE; a.li = 0; hipLaunchKernelGGL(fwd, dim3(grid), dim3(NWAVES * 64), LDS_BYTES, stream, a); }
    else for (int p = 0; p < NPHASE; ++p) { a.ph_lo = p; a.ph_hi = p + 1; a.li = p; hipLaunchKernelGGL(fwd, dim3(grid), dim3(NWAVES * 64), LDS_BYTES, stream, a); }
}
```

```cpp
#include <hip/hip_runtime.h>
#include <cstdio>
#include <cstdint>

#ifndef MK_N_LAUNCHES
#define MK_N_LAUNCHES 1
#endif

#define GAS __attribute__((address_space(1)))
#define LAS __attribute__((address_space(3)))
typedef unsigned short bf16;
typedef short bf16x8 __attribute__((ext_vector_type(8)));
typedef short bf16x4 __attribute__((ext_vector_type(4)));
typedef float f32x4 __attribute__((ext_vector_type(4)));
typedef float f32x2 __attribute__((ext_vector_type(2)));
typedef unsigned u32x4 __attribute__((ext_vector_type(4)));
typedef unsigned u32x2 __attribute__((ext_vector_type(2)));
typedef GAS unsigned gu32;

constexpr int D = 4096, BATCH = 8, SEQ = 2048, M = BATCH * SEQ;
constexpr int NH = 8, DQK = 256, DV = 512, QKW = 2048, VW = 4096;
constexpr int NPROJ = 12288, PROJ_W = 12304;
constexpr int DFF = 10944, DFF2 = 21888, FT = 86, NFF1 = FT * 256  , KFF2 = FT * 128  ;
constexpr float EPS = 1e-6f;
constexpr int NPHASE = 14;

constexpr size_t MiB = 1u << 20;
constexpr size_t WS_CTL = 0, CTL_ZERO_BYTES = 131072;
constexpr size_t WS_WP = 2 * MiB;
constexpr size_t WS_WG = WS_WP + (size_t)NPROJ * D * 2;
constexpr size_t WS_WO = WS_WG + 1 * MiB;
constexpr size_t WS_W1 = WS_WO + (size_t)D * D * 2;
constexpr size_t WS_W2 = WS_W1 + 2 * (size_t)NFF1 * D * 2;
constexpr size_t WS_WPOOL = WS_W2 + 2 * (size_t)D * KFF2 * 2;
constexpr size_t WS_CONVP = WS_WPOOL + 4 * (size_t)1024 * 1024 * 2;
constexpr size_t WS_XA = WS_CONVP + 1 * MiB;
constexpr size_t WS_XB = WS_XA + (size_t)M * D * 2;
constexpr size_t WS_PROJ = WS_XB + (size_t)M * D * 2;
constexpr size_t WS_HB = WS_PROJ + (size_t)M * NPROJ * 2;
constexpr size_t WS_SS = WS_HB + (size_t)M * D * 2;
constexpr size_t WS_GATES = WS_SS + (size_t)M * 32 * 4;
constexpr size_t WS_RSS = WS_GATES + (size_t)M * 16 * 4;
constexpr size_t WS_HALO = WS_RSS + (size_t)M * 64 * 4;
constexpr size_t WS_END = WS_HALO + (size_t)64 * 4 * NFF1 * 4;
constexpr size_t WS_PART = WS_END, WS_END2 = WS_PART + (size_t)128 * 65536 * 4;
constexpr size_t WS_RINV = (WS_END2 + 4095) & ~(size_t)4095, WS_END3 = WS_RINV + (size_t)M * 4;
static_assert((size_t)M * KFF2 * 2 <= (size_t)M * NPROJ * 2, "GATED overlays PROJ");

constexpr int CW_TMO = 0, CW_BAR = 4096, CW_SPLIT = 8192;
static_assert((CW_BAR + 3456) <= CW_SPLIT && (CW_SPLIT + 64 * 128) * 4 <= (int)CTL_ZERO_BYTES, "control words inside the memset region");

constexpr int RING_OFF = 0, RING_BYTES = 131072;
constexpr int RSTD_OFF = 131072;
constexpr int CONVP_OFF = RSTD_OFF + 1024;
constexpr int EXCH_OFF = CONVP_OFF + 8192;
constexpr int LDSCTL_OFF = EXCH_OFF + 8192;
constexpr int MISC_OFF = LDSCTL_OFF + 64;
constexpr int LDS_BYTES = LDSCTL_OFF + 512;
static_assert(LDS_BYTES <= 160 * 1024, "LDS");

#define RLX_AGENT __ATOMIC_RELAXED, __HIP_MEMORY_SCOPE_AGENT
#define LDS_WAIT() asm volatile("s_waitcnt lgkmcnt(0)" ::: "memory")
#define VM_WAIT() asm volatile("s_waitcnt vmcnt(0)" ::: "memory")
__device__ __forceinline__ unsigned f2bf(float f) { unsigned u = __builtin_bit_cast(unsigned, f); return (u + 0x7fffu + ((u >> 16) & 1u)) >> 16; }
__device__ __forceinline__ unsigned pk2(float lo, float hi) { return f2bf(lo) | (f2bf(hi) << 16); }
#ifndef WMANT_DROP
#define WMANT_DROP 2
#endif
__device__ __forceinline__ unsigned wq2(unsigned packed) {
    if (WMANT_DROP == 0) return packed;
    const unsigned half = (1u << (WMANT_DROP - 1)) * 0x00010001u, keep = ~(((1u << WMANT_DROP) - 1u) * 0x00010001u);
    return (packed + half) & keep;
}
__device__ __forceinline__ float bf2f(unsigned b) { return __builtin_bit_cast(float, b << 16); }
__device__ __forceinline__ unsigned cvt_pk_bf16(float lo, float hi) { unsigned r; asm volatile("v_cvt_pk_bf16_f32 %0, %1, %2" : "=v"(r) : "v"(lo), "v"(hi)); return r; }

#ifndef PG8_BAL
#define PG8_BAL 1
#endif
#ifndef PG8_LOADPRIO
#define PG8_LOADPRIO 1
#endif
namespace pg8 {
constexpr int BM = 256, BK = 64, HALF = 128, HTB = HALF * BK * 2, STAGE_BYTES = 8 * HTB;
__host__ __device__ __forceinline__ int lds_byte(int r, int c) { const int st = (r >> 4) * 2 + (c >> 5), rr = r & 15, cc = c & 31, ob = rr * 64 + cc * 2; return st * 1024 + (ob ^ (((ob >> 9) & 1) << 5)); }
__host__ __device__ __forceinline__ void stage_rc(int b, int& R, int& C) { const int st = b / 1024, sb = b % 1024, swz = sb ^ (((sb >> 9) & 1) << 5); R = (st >> 1) * 16 + swz / 64; C = (st & 1) * 32 + (swz % 64) / 2; }
__host__ __device__ __forceinline__ int perm32(int rho) { const int n = rho >> 4, i = rho & 15; return 8 * (i >> 2) + 4 * n + (i & 3); }

struct Unit { int pm, pn; int kt0, nkt; };
struct Gemm { const bf16* A; const bf16* Bt; int lda, ldb, K; int agrp_shift, agrp_stride; };

struct RowOrder {
    static constexpr bool SPLIT = false;
    int pm, pn0, nN;
    __device__ __forceinline__ void init(int nN_, int c) { const int x = c & 7, j = c >> 3; pm = 8 * x + (j & 7); pn0 = j >> 3; nN = nN_; }
    __device__ __forceinline__ bool next(int i, Unit& u) const { const int pn = 4 * i + pn0; u.pm = pm; u.pn = pn; return pn < nN; }
};

struct WideOrder {
    static constexpr bool SPLIT = false;
    int x, j;
    __device__ __forceinline__ void init(int, int c) { x = c & 7; j = c >> 3; }
    __device__ __forceinline__ bool next(int i, Unit& u) const { u.pm = 8 * x + 4 * (i >> 1) + (j & 3); u.pn = 8 * (i & 1) + (j >> 2); return i < 4; }
};
struct TailOrder {
    static constexpr bool SPLIT = true;
    int pm, pn0;
    __device__ __forceinline__ void init(int c) { const int x = c & 7, j = c >> 3; pm = 8 * x + (j & 7); pn0 = j >> 3; }
    __device__ __forceinline__ bool next(int i, Unit& u) const { u.pm = pm; u.pn = 84 + (pn0 & 1); u.kt0 = pn0 < 2 ? 0 : 32; u.nkt = 32; return i == 0; }
};
template <class Epi, class Sched, int PV = 0>
__device__ __forceinline__ void gemm_phase(LAS unsigned char* lds, const Gemm g, const Sched& S, Epi& E) {
    const int tid = threadIdx.x, wid = __builtin_amdgcn_readfirstlane(tid >> 6), lane = tid & 63, wr = wid >> 2, wc = wid & 3, fr = lane & 15, fq = lane >> 4;
    int nt = g.K / BK;
    const unsigned kstep = (unsigned)(BK * 2);
    const unsigned hstepA = (unsigned)HALF * g.lda * 2, hstepB = (unsigned)HALF * g.ldb * 2;
    unsigned voffA0[2], voffB0[2];
#pragma unroll
    for (int i = 0; i < 2; ++i) { int R, C; stage_rc(tid * 16 + i * 8192, R, C); const int Rb = Epi::PERM ? ((R & ~31) + perm32(R & 31)) : R;
        const int Ra = Epi::APERM ? ((R & 64) + 4 * (R & 15) + ((R >> 4) & 3)) : R;
        voffA0[i] = (unsigned)(Ra * g.lda + C) * 2u; voffB0[i] = (unsigned)(Rb * g.ldb + C) * 2u; }
    const __amdgpu_buffer_rsrc_t rsA = __builtin_amdgcn_make_buffer_rsrc((void*)g.A, 0, 0x7fffffff, 0x00020000), rsB = __builtin_amdgcn_make_buffer_rsrc((void*)g.Bt, 0, 0x7fffffff, 0x00020000);
    const unsigned ldsw = (unsigned)wid * 1024u;
    const int aoff = lds_byte(wr * 64 + fr, fq * 8), boff = lds_byte(wc * 32 + fr, fq * 8);
#define PG8_SA(b, h) (((b) * 2 + (h)) * HTB)
#define PG8_SB(b, h) ((4 + (b) * 2 + (h)) * HTB)
#define PG8_STAGE(rs, bufoff, off, voff) do { _Pragma("unroll") for (int _i = 0; _i < 2; ++_i) \
        __builtin_amdgcn_raw_ptr_buffer_load_lds(rs, (LAS void*)(lds + (bufoff) + ldsw + _i * 8192), 16, (voff)[_i], (unsigned)(off), 0, 0); } while (0)
#define PG8_LDA(dst, b, h) do { _Pragma("unroll") for (int m = 0; m < 4; ++m) _Pragma("unroll") for (int k = 0; k < 2; ++k) dst[m][k] = *(const LAS bf16x8*)(lds + PG8_SA(b, h) + aoff + m * 2048 + k * 1024); } while (0)
#define PG8_LDB(dst, b, h) do { _Pragma("unroll") for (int n = 0; n < 2; ++n) _Pragma("unroll") for (int k = 0; k < 2; ++k) dst[n][k] = *(const LAS bf16x8*)(lds + PG8_SB(b, h) + boff + n * 2048 + k * 1024); } while (0)
#define PG8_CH(bj, Bf, m, n) do { _Pragma("unroll") for (int k = 0; k < 2; ++k) acc[ai_][bj][m][n] = __builtin_amdgcn_mfma_f32_16x16x32_bf16(Bf[n][k], At[m][k], acc[ai_][bj][m][n], 0, 0, 0); __builtin_amdgcn_sched_barrier(0); } while (0)
#define PG8_MMA2(ai, B0) do { constexpr int ai_ = ai; __builtin_amdgcn_s_setprio(1); \
          \
        PG8_CH(0, B0, 0, 0); PG8_CH(0, B0, 0, 1); PG8_CH(1, B1, 0, 0); PG8_CH(1, B1, 0, 1); \
        PG8_CH(1, B1, 1, 1); PG8_CH(1, B1, 1, 0); PG8_CH(0, B0, 1, 1); PG8_CH(0, B0, 1, 0); \
        PG8_CH(0, B0, 2, 0); PG8_CH(0, B0, 2, 1); PG8_CH(1, B1, 2, 0); PG8_CH(1, B1, 2, 1); \
        PG8_CH(1, B1, 3, 1); PG8_CH(1, B1, 3, 0); PG8_CH(0, B0, 3, 1); PG8_CH(0, B0, 3, 0); \
        __builtin_amdgcn_s_setprio(PG8_LOADPRIO); } while (0)
#define PG8_WAIT_V(n) asm volatile("s_waitcnt vmcnt(" #n ")" ::: "memory")
#define PG8_WAIT_VL(n) __builtin_amdgcn_s_waitcnt(0x0070 | (n))
#define PG8_BAR __builtin_amdgcn_s_barrier()
#define PG8_SCHED __builtin_amdgcn_sched_barrier(0)
#define PG8_ITER(oA1, oA2, oB2, oB3, lastrd) do { \
            PG8_LDB(B1, 0, 1); PG8_SCHED; PG8_LDA(At, 0, 0); PG8_STAGE(rsA, PG8_SA(1, 0), oA1, voffA0); PG8_STAGE(rsA, PG8_SA(1, 1), (oA1) + hstepA, voffA0); \
            PG8_WAIT_VL(6); PG8_BAR; PG8_MMA2(0, B0e); PG8_BAR; PG8_SCHED; \
            PG8_LDA(At, 0, 1); PG8_LDB(B0o, 1, 0); PG8_STAGE(rsB, PG8_SB(0, 0), oB2, voffB0); PG8_STAGE(rsB, PG8_SB(0, 1), (oB2) + hstepB, voffB0); \
            PG8_WAIT_VL(6); PG8_BAR; PG8_MMA2(1, B0e); PG8_BAR; PG8_SCHED; \
            PG8_LDB(B1, 1, 1); PG8_SCHED; PG8_LDA(At, 1, 0); PG8_STAGE(rsA, PG8_SA(0, 0), oA2, voffA0); PG8_STAGE(rsA, PG8_SA(0, 1), (oA2) + hstepA, voffA0); \
            PG8_WAIT_VL(6); PG8_BAR; PG8_MMA2(0, B0o); PG8_BAR; PG8_SCHED; \
            PG8_LDA(At, 1, 1); if (lastrd) { PG8_LDB(B0e, 0, 0); } PG8_STAGE(rsB, PG8_SB(1, 0), oB3, voffB0); PG8_STAGE(rsB, PG8_SB(1, 1), (oB3) + hstepB, voffB0); \
            PG8_WAIT_VL(6); PG8_BAR; PG8_MMA2(1, B0o); PG8_BAR; PG8_SCHED; } while (0)
    Unit cur, nxt; int ui = 0;
    if (!S.next(0, cur)) return;
    f32x4 acc[2][2][4][2];
#pragma unroll
    for (int a = 0; a < 2; ++a)
#pragma unroll
        for (int b = 0; b < 2; ++b)
#pragma unroll
            for (int m = 0; m < 4; ++m)
#pragma unroll
                for (int n = 0; n < 2; ++n) acc[a][b][m][n] = (f32x4){0.f, 0.f, 0.f, 0.f};
    bf16x8 At[4][2], B0e[2][2], B0o[2][2], B1[2][2];
    unsigned cA = (unsigned)cur.pm * 2 * hstepA + (unsigned)((cur.pn >> g.agrp_shift) * g.agrp_stride) * 2; unsigned cB = (unsigned)cur.pn * 2 * hstepB;
    if constexpr (Sched::SPLIT) { nt = cur.nkt; cA += (unsigned)cur.kt0 * kstep; cB += (unsigned)cur.kt0 * kstep; }
    E.unit_begin(cur, 0, wid, lane);
    PG8_STAGE(rsB, PG8_SB(0, 0), cB, voffB0); PG8_STAGE(rsB, PG8_SB(0, 1), cB + hstepB, voffB0); PG8_STAGE(rsA, PG8_SA(0, 0), cA, voffA0); PG8_STAGE(rsA, PG8_SA(0, 1), cA + hstepA, voffA0);
    if (wr == 1) PG8_BAR;
    PG8_STAGE(rsB, PG8_SB(1, 0), cB + kstep, voffB0); PG8_STAGE(rsB, PG8_SB(1, 1), cB + kstep + hstepB, voffB0);
    PG8_WAIT_V(6); PG8_BAR; PG8_BAR;
    PG8_LDB(B0e, 0, 0);
    for (;;) {
        const bool has_next = S.next(ui + 1, nxt);
        unsigned nko = 0; if constexpr (Sched::SPLIT) nko = has_next ? (unsigned)nxt.kt0 * kstep : 0;
        const unsigned nA = has_next ? (unsigned)nxt.pm * 2 * hstepA + (unsigned)((nxt.pn >> g.agrp_shift) * g.agrp_stride) * 2 + nko : cA; const unsigned nB = has_next ? (unsigned)nxt.pn * 2 * hstepB + nko : cB;
        unsigned oA = cA + kstep, oB = cB + 2 * kstep;
        for (int t = 0; t < nt; t += 2) {
            const bool last = (t == nt - 2);
            const unsigned a2 = last ? nA : oA + kstep, b2 = last ? nB : oB;
            PG8_ITER(oA, a2, b2, b2 + kstep, !last); oA += 2 * kstep; oB += 2 * kstep; }
        if (wr == 0) PG8_BAR;
        E(acc, cur, ui, wr, wc, fr, fq);
        if (!has_next) break;
        { f32x2 z2 = (f32x2){0.f, 0.f}; asm volatile("" : "+v"(z2));
#pragma unroll
        for (int a = 0; a < 2; ++a)
#pragma unroll
            for (int b = 0; b < 2; ++b)
#pragma unroll
                for (int m = 0; m < 4; ++m)
#pragma unroll
                    for (int n = 0; n < 2; ++n) acc[a][b][m][n] = __builtin_shufflevector(z2, z2, 0, 1, 0, 1); }
        cur = nxt; cA = nA; cB = nB; ++ui; if constexpr (Sched::SPLIT) nt = cur.nkt;
        if (wr == 1) PG8_BAR;
        E.unit_begin(cur, ui, wid, lane);
        PG8_LDB(B0e, 0, 0);
    }
    PG8_WAIT_V(0);
    PG8_BAR;
#undef PG8_SA
#undef PG8_SB
#undef PG8_STAGE
#undef PG8_LDA
#undef PG8_LDB
#undef PG8_MMA2
#undef PG8_CH
#undef PG8_WAIT_V
#undef PG8_WAIT_VL
#undef PG8_BAR
#undef PG8_SCHED
#undef PG8_ITER
}

struct EpiProj {
    static constexpr bool PERM = true, APERM = false;
    bf16* O; int ldc;
    __device__ __forceinline__ void unit_begin(const Unit&, int, int, int) const {}
    __device__ __forceinline__ void operator()(const f32x4 (&acc)[2][2][4][2], const Unit& u, int, int wr, int wc, int fr, int fq) const {
        asm volatile("" : "+v"(fr), "+v"(fq));
        const int row0 = u.pm * BM + wr * 64 + fr, col0 = u.pn * BM + wc * 32 + 8 * fq; const float sc = u.pn < 8 ? 0.0625f : 1.f;
#pragma unroll
        for (int ai = 0; ai < 2; ++ai)
#pragma unroll
            for (int m = 0; m < 4; ++m) { bf16* rowp = O + (size_t)(row0 + ai * HALF + m * 16) * ldc + col0;
#pragma unroll
                for (int bj = 0; bj < 2; ++bj) { const f32x4 v0 = acc[ai][bj][m][0] * sc, v1 = acc[ai][bj][m][1] * sc;
                    u32x4 w; w.x = cvt_pk_bf16(v0[0], v0[1]); w.y = cvt_pk_bf16(v0[2], v0[3]); w.z = cvt_pk_bf16(v1[0], v1[1]); w.w = cvt_pk_bf16(v1[2], v1[3]);
                    *(u32x4*)(rowp + bj * HALF) = w; } }
    }
};

struct EpiNull {
    static constexpr bool PERM = false, APERM = false;
    __device__ __forceinline__ void unit_begin(const Unit&, int, int, int) const {}
    __device__ __forceinline__ void operator()(const f32x4 (&acc)[2][2][4][2], const Unit&, int, int, int, int, int) const {
#pragma unroll
        for (int ai = 0; ai < 2; ++ai)
#pragma unroll
            for (int bj = 0; bj < 2; ++bj)
#pragma unroll
                for (int m = 0; m < 4; ++m)
#pragma unroll
                    for (int n = 0; n < 2; ++n) asm volatile("" :: "v"(acc[ai][bj][m][n]));
    }
};
template <bool BASE_F32> struct EpiResid {
    static constexpr bool PERM = true, APERM = false;
    const void* base; const float* ginv_src; const float* colscale; bf16* O; const float* gA; float* rss; const float* rowscale;
    __device__ __forceinline__ void unit_begin(const Unit&, int, int, int) const {}
    __device__ __forceinline__ void operator()(const f32x4 (&acc)[2][2][4][2], const Unit& u, int, int wr, int wc, int fr, int fq) const {
        asm volatile("" : "+v"(fr), "+v"(fq));
        const int row0 = u.pm * BM + wr * 64 + fr, col0 = u.pn * BM + wc * 32 + 8 * fq;
        f32x4 cs[2][2], gv[2][2], gi[2][2];
#pragma unroll
        for (int bj = 0; bj < 2; ++bj)
#pragma unroll
            for (int n = 0; n < 2; ++n) { const int cc = col0 + bj * HALF + 4 * n;
                cs[bj][n] = colscale ? *(const f32x4*)(colscale + cc) : (f32x4){1.f, 1.f, 1.f, 1.f};
                gv[bj][n] = gA ? *(const f32x4*)(gA + cc) : (f32x4){1.f, 1.f, 1.f, 1.f};
                if (ginv_src) { const f32x4 t = *(const f32x4*)(ginv_src + cc); gi[bj][n] = (f32x4){__builtin_amdgcn_rcpf(t[0]), __builtin_amdgcn_rcpf(t[1]), __builtin_amdgcn_rcpf(t[2]), __builtin_amdgcn_rcpf(t[3])}; } else gi[bj][n] = (f32x4){1.f, 1.f, 1.f, 1.f}; }
#pragma unroll
        for (int ai = 0; ai < 2; ++ai) {
            f32x4 pb[4][2][2]; u32x4 pw[4][2];
#pragma unroll
            for (int m = 0; m < 4; ++m) { const size_t off = (size_t)(row0 + ai * HALF + m * 16) * D + col0;
#pragma unroll
                for (int bj = 0; bj < 2; ++bj) {
                    if (BASE_F32) { pb[m][bj][0] = __builtin_nontemporal_load((const f32x4*)((const float*)base + off + bj * HALF)); pb[m][bj][1] = __builtin_nontemporal_load((const f32x4*)((const float*)base + off + bj * HALF + 4)); }
                    else pw[m][bj] = *(const u32x4*)((const bf16*)base + off + bj * HALF); } }
            float rsc[4];
#pragma unroll
            for (int m = 0; m < 4; ++m) rsc[m] = rowscale ? rowscale[row0 + ai * HALF + m * 16] : 1.0f;
#pragma unroll
            for (int m = 0; m < 4; ++m) { const int r = row0 + ai * HALF + m * 16; const size_t off = (size_t)r * D + col0; float ss = 0.f;
#pragma unroll
                for (int bj = 0; bj < 2; ++bj) { f32x4 b0, b1;
                    if (BASE_F32) { b0 = pb[m][bj][0]; b1 = pb[m][bj][1]; }
                    else { const u32x4 w = pw[m][bj];
                        b0 = (f32x4){bf2f(w.x & 0xffffu), bf2f(w.x >> 16), bf2f(w.y & 0xffffu), bf2f(w.y >> 16)}; b1 = (f32x4){bf2f(w.z & 0xffffu), bf2f(w.z >> 16), bf2f(w.w & 0xffffu), bf2f(w.w >> 16)}; }
                    const f32x4 v0 = b0 * (gi[bj][0] * rsc[m]) + acc[ai][bj][m][0] * cs[bj][0], v1 = b1 * (gi[bj][1] * rsc[m]) + acc[ai][bj][m][1] * cs[bj][1];
                    ss += ((v0[0] * v0[0] + v0[1] * v0[1]) + (v0[2] * v0[2] + v0[3] * v0[3])) + ((v1[0] * v1[0] + v1[1] * v1[1]) + (v1[2] * v1[2] + v1[3] * v1[3]));
                    const f32x4 a0 = v0 * gv[bj][0], a1 = v1 * gv[bj][1];
                    u32x4 w; w.x = cvt_pk_bf16(a0[0], a0[1]); w.y = cvt_pk_bf16(a0[2], a0[3]); w.z = cvt_pk_bf16(a1[0], a1[1]); w.w = cvt_pk_bf16(a1[2], a1[3]);
                    *(u32x4*)(O + off + bj * HALF) = w; }
                ss += __shfl_xor(ss, 16); ss += __shfl_xor(ss, 32);
                if (fq == 0) rss[(size_t)r * 64 + u.pn * 4 + wc] = ss; }
            asm volatile("" ::: "memory");
        }
    }
};

__device__ __forceinline__ float dpp_shr1(float old, float src) { return __builtin_bit_cast(float, __builtin_amdgcn_update_dpp(__builtin_bit_cast(int, old), __builtin_bit_cast(int, src), 0x111, 0xf, 0xf, false)); }
__device__ __forceinline__ float dpp_shr2(float old, float src) { return __builtin_bit_cast(float, __builtin_amdgcn_update_dpp(__builtin_bit_cast(int, old), __builtin_bit_cast(int, src), 0x112, 0xf, 0xf, false)); }
__device__ __forceinline__ float dpp_ror1(float src) { return __builtin_bit_cast(float, __builtin_amdgcn_mov_dpp(__builtin_bit_cast(int, src), 0x121, 0xf, 0xf, true)); }
__device__ __forceinline__ float dpp_ror2(float src) { return __builtin_bit_cast(float, __builtin_amdgcn_mov_dpp(__builtin_bit_cast(int, src), 0x122, 0xf, 0xf, true)); }
__device__ __forceinline__ float silu_f(float x) { return x * __builtin_amdgcn_rcpf(1.0f + __builtin_amdgcn_exp2f(-1.44269504089f * x)); }
template <int KIND  > struct EpiFfn1T {
    static constexpr bool PERM = true, APERM = true;
    bf16* O; const float* convp; float* halo; LAS unsigned char* lds; float* part; unsigned* flag; unsigned epoch;
    __device__ __forceinline__ void unit_begin(const Unit& u, int ui, int wid, int lane) const {
        if (wid < 4)
            __builtin_amdgcn_global_load_lds((const unsigned*)((const char*)convp + (size_t)u.pn * 4096 + wid * 1024 + lane * 16), (LAS unsigned*)(lds + CONVP_OFF + (ui & 1) * 4096 + wid * 1024), 16, 0, 0);
    }
    __device__ __forceinline__ void operator()(f32x4 (&acc)[2][2][4][2], const Unit& u, int ui, int wr, int wc, int fr, int fq) const {
        asm volatile("" : "+v"(fr), "+v"(fq));
        const int wid = wr * 4 + wc;
        if constexpr (KIND == 2) {
            const __amdgpu_buffer_rsrc_t rsrc = __builtin_amdgcn_make_buffer_rsrc((void*)part, 0, 262144, 0x00020000);
            const int voff = (wid * 64 + fq * 16 + fr) * 16;
#pragma unroll
            for (int ai = 0; ai < 2; ++ai)
#pragma unroll
                for (int bj = 0; bj < 2; ++bj)
#pragma unroll
                    for (int m = 0; m < 4; ++m)
#pragma unroll
                        for (int n = 0; n < 2; ++n) __builtin_amdgcn_raw_buffer_store_b128(__builtin_bit_cast(u32x4, acc[ai][bj][m][n]), rsrc, voff + (((ai * 2 + bj) * 4 + m) * 2 + n) * 8192, 0, 16);
            asm volatile("s_waitcnt vmcnt(0)" ::: "memory"); __builtin_amdgcn_s_barrier(); asm volatile("" ::: "memory");
            if (wid == 0 && fq == 0 && fr == 0) __hip_atomic_store(flag, epoch, __ATOMIC_RELAXED, __HIP_MEMORY_SCOPE_AGENT);
            return;
        }
        if constexpr (KIND == 1) {
            if (wid == 0) { unsigned sp = 0;
                while ((unsigned)__builtin_amdgcn_readfirstlane(__hip_atomic_load(flag, __ATOMIC_RELAXED, __HIP_MEMORY_SCOPE_AGENT)) < epoch) { __builtin_amdgcn_s_sleep(2); if (++sp > (1u << 22)) break; }
                __builtin_amdgcn_fence(__ATOMIC_ACQUIRE, "agent"); asm volatile("s_waitcnt vmcnt(0)" ::: "memory"); }
            asm volatile("" ::: "memory"); __builtin_amdgcn_s_barrier(); asm volatile("" ::: "memory");
            const f32x4* pp = (const f32x4*)part + (wid * 64 + fq * 16 + fr);
#pragma unroll
            for (int ai = 0; ai < 2; ++ai)
#pragma unroll
                for (int bj = 0; bj < 2; ++bj) {
                    f32x4 t8[4][2];
#pragma unroll
                    for (int m = 0; m < 4; ++m)
#pragma unroll
                        for (int n = 0; n < 2; ++n) t8[m][n] = pp[(((ai * 2 + bj) * 4 + m) * 2 + n) * 512];
#pragma unroll
                    for (int m = 0; m < 4; ++m)
#pragma unroll
                        for (int n = 0; n < 2; ++n) acc[ai][bj][m][n] += t8[m][n];
                    asm volatile("" : "+v"(acc[ai][bj][0][0]), "+v"(acc[ai][bj][0][1]), "+v"(acc[ai][bj][1][0]), "+v"(acc[ai][bj][1][1]), "+v"(acc[ai][bj][2][0]), "+v"(acc[ai][bj][2][1]), "+v"(acc[ai][bj][3][0]), "+v"(acc[ai][bj][3][1]) :: "memory"); }
            asm volatile("" : "+v"(fr), "+v"(fq));
        }
        const LAS float* rstd = (const LAS float*)(lds + RSTD_OFF);
        const LAS float* cp = (const LAS float*)(lds + CONVP_OFF + (ui & 1) * 4096);
        LAS float* ex = (LAS float*)(lds + EXCH_OFF);
#pragma unroll
        for (int ai = 0; ai < 2; ++ai) { const f32x4 rs4 = *(const LAS f32x4*)(rstd + ai * HALF + wr * 64 + 4 * fr);
#pragma unroll
            for (int m = 0; m < 4; ++m)
#pragma unroll
                for (int bj = 0; bj < 2; ++bj)
#pragma unroll
                    for (int n = 0; n < 2; ++n) acc[ai][bj][m][n] *= rs4[m]; }
        if (fr == 15) {
#pragma unroll
            for (int ai = 0; ai < 2; ++ai)
#pragma unroll
                for (int bj = 0; bj < 2; ++bj)
#pragma unroll
                    for (int n = 0; n < 2; ++n) { *(LAS f32x4*)(ex + ((wid * 2 + ai) * 2 + 0) * 64 + (bj * 2 + n) * 16 + fq * 4) = acc[ai][bj][2][n]; *(LAS f32x4*)(ex + ((wid * 2 + ai) * 2 + 1) * 64 + (bj * 2 + n) * 16 + fq * 4) = acc[ai][bj][3][n]; }
        }
        {
            const int colb = u.pn * BM + wc * 32 + 8 * fq;
            if (wr == 0 && fr == 0) {
#pragma unroll
                for (int rr = 0; rr < 2; ++rr)
#pragma unroll
                    for (int bj = 0; bj < 2; ++bj)
#pragma unroll
                        for (int n = 0; n < 2; ++n) *(f32x4*)(halo + ((size_t)u.pm * 4 + rr) * NFF1 + colb + bj * HALF + 4 * n) = acc[0][bj][rr][n];
            }
            if (wr == 1 && fr == 15) {
#pragma unroll
                for (int rr = 0; rr < 2; ++rr)
#pragma unroll
                    for (int bj = 0; bj < 2; ++bj)
#pragma unroll
                        for (int n = 0; n < 2; ++n) *(f32x4*)(halo + ((size_t)u.pm * 4 + 2 + rr) * NFF1 + colb + bj * HALF + 4 * n) = acc[1][bj][2 + rr][n];
            }
        }
        LDS_WAIT(); __builtin_amdgcn_s_barrier(); asm volatile("" ::: "memory");
        const int row0 = u.pm * BM + wr * 64 + 4 * fr, colo = u.pn * HALF + wc * 32 + 8 * fq;
        u32x2 hold[2][4];
        f32x2 kone = (f32x2){1.0f, 1.0f}; asm volatile("" : "+v"(kone));
#pragma unroll
        for (int n = 0; n < 2; ++n) {
            f32x4 pw[4][2];
#pragma unroll
            for (int p = 0; p < 4; ++p)
#pragma unroll
                for (int bj = 0; bj < 2; ++bj) pw[p][bj] = *(const LAS f32x4*)(cp + p * 256 + bj * HALF + wc * 32 + 8 * fq + 4 * n);
#pragma unroll
            for (int ai = 0; ai < 2; ++ai) {
                const int swv = (ai == 1 && wr == 0) ? wid + 4 : wid - 4, sai = (ai == 1 && wr == 1) ? 1 : 0; const bool have = !(ai == 0 && wr == 0);
                f32x4 pm1[2], pm2[2];
#pragma unroll
                for (int bj = 0; bj < 2; ++bj) {
                    f32x4 e0 = (f32x4){0.f, 0.f, 0.f, 0.f}, e1 = e0;
                    if (have) { e0 = *(const LAS f32x4*)(ex + ((swv * 2 + sai) * 2 + 0) * 64 + (bj * 2 + n) * 16 + fq * 4); e1 = *(const LAS f32x4*)(ex + ((swv * 2 + sai) * 2 + 1) * 64 + (bj * 2 + n) * 16 + fq * 4); }
#pragma unroll
                    for (int i = 0; i < 4; ++i) { pm1[bj][i] = dpp_shr1(e1[i], acc[ai][bj][3][n][i]); pm2[bj][i] = dpp_shr1(e0[i], acc[ai][bj][2][n][i]); }
                }
#pragma unroll
                for (int m = 0; m < 4; ++m) {
                    f32x4 hc[2];
#pragma unroll
                    for (int bj = 0; bj < 2; ++bj) {
                        const f32x4 cur = acc[ai][bj][m][n];
                        const f32x4 h1 = m == 0 ? pm1[bj] : acc[ai][bj][m == 0 ? 0 : m - 1][n];
                        const f32x4 h2 = m == 0 ? pm2[bj] : (m == 1 ? pm1[bj] : acc[ai][bj][m < 2 ? 0 : m - 2][n]);
                        hc[bj] = pw[3][bj] + pw[0][bj] * h2 + pw[1][bj] * h1 + pw[2][bj] * cur;
                    }
                    const f32x2 e01 = (f32x2){__builtin_amdgcn_exp2f(hc[0][0]), __builtin_amdgcn_exp2f(hc[0][1])}, e23 = (f32x2){__builtin_amdgcn_exp2f(hc[0][2]), __builtin_amdgcn_exp2f(hc[0][3])};
                    const f32x2 d01 = e01 + kone, d23 = e23 + kone;
                    const f32x4 r = (f32x4){__builtin_amdgcn_rcpf(d01[0]), __builtin_amdgcn_rcpf(d01[1]), __builtin_amdgcn_rcpf(d23[0]), __builtin_amdgcn_rcpf(d23[1])};
                    const f32x4 o = (hc[0] * hc[1]) * r;
                    u32x2 w; w.x = cvt_pk_bf16(o[0], o[1]); w.y = cvt_pk_bf16(o[2], o[3]);
                    if (n == 0) hold[ai][m] = w;
                    else *(u32x4*)(O + (size_t)(row0 + ai * HALF + m) * KFF2 + colo) = (u32x4){hold[ai][m].x, hold[ai][m].y, w.x, w.y};
                }
            }
        }
    }
};
}

#define XB_TMO      128
#define XB_XCNT(j)  (256  + 64 * (j))
#define XB_XSUB(j)  (1280 + 64 * (j))
#define XB_XGEN(j)  (2304 + 64 * (j))
#define XB_TOP      3328
#define XB_TOPGEN   3392
#define XCD_BAR_WORDS 3456
#define XB_SPIN_CAP (1u << 18)
__device__ __forceinline__ unsigned xb_ld(unsigned* p)              { return __hip_atomic_load(p, __ATOMIC_RELAXED, __HIP_MEMORY_SCOPE_AGENT); }
__device__ __forceinline__ unsigned xb_add(unsigned* p, unsigned v) { return __hip_atomic_fetch_add(p, v, __ATOMIC_RELAXED, __HIP_MEMORY_SCOPE_AGENT); }
__device__ __forceinline__ unsigned xb_xcc_id() { return (unsigned)__builtin_amdgcn_s_getreg((3 << 11) | 20) & 0xFu; }
#define XB_SPIN(cond, bar) do { unsigned _sp = 0; while (cond) { __builtin_amdgcn_s_sleep(1); \
    if ((++_sp & 255u) == 0u) { if (xb_ld(&(bar)[XB_TMO])) break; if (_sp > XB_SPIN_CAP) { atomicAdd(&(bar)[XB_TMO], 1u); break; } } } } while (0)
struct XcdBarrier { unsigned* bar; unsigned x; volatile LAS unsigned* st; };
__device__ __forceinline__ XcdBarrier xcd_barrier_post(unsigned* bar, volatile LAS unsigned* st) {
    XcdBarrier b; b.bar = bar; b.x = xb_xcc_id(); b.st = st;
    if (threadIdx.x == 0) (void)xb_add(&bar[XB_XCNT(b.x)], 1u);
    return b;
}
__device__ __forceinline__ void xcd_barrier_complete(unsigned* bar, unsigned x, unsigned& nloc, unsigned& nx) {
    const unsigned G = gridDim.x * gridDim.y * gridDim.z;
    unsigned sum, cnt, mine, sp = 0u;
    for (;;) {
        sum = 0u; cnt = 0u; mine = 0u;
#pragma unroll
        for (unsigned j = 0; j < 16; ++j) { const unsigned c = xb_ld(&bar[XB_XCNT(j)]); sum += c; cnt += (c > 0u) ? 1u : 0u; mine = (j == x) ? c : mine; }
        if (sum == G) break;
        __builtin_amdgcn_s_sleep(1);
        if ((++sp & 255u) == 0u) { if (xb_ld(&bar[XB_TMO])) break; if (sp > XB_SPIN_CAP) { atomicAdd(&bar[XB_TMO], 1u); break; } }
    }
    nloc = mine > 0u ? mine : 1u; nx = cnt > 0u ? cnt : 1u;
}
__device__ __forceinline__ void xcd_barrier(const XcdBarrier& b) {
    asm volatile("s_waitcnt vmcnt(0)" ::: "memory");
    __syncthreads();
    if (threadIdx.x == 0) {
        unsigned* bar = b.bar;
        __builtin_amdgcn_s_waitcnt(0);
        unsigned nloc = b.st[0], nx = b.st[1];
        if (nloc == 0u) { xcd_barrier_complete(bar, b.x, nloc, nx); b.st[0] = nloc; b.st[1] = nx; }
        const unsigned old = xb_add(&bar[XB_XSUB(b.x)], 1u);
        const unsigned gen = old / nloc;
        if (old + 1u == (gen + 1u) * nloc) {
            __builtin_amdgcn_fence(__ATOMIC_RELEASE, "agent");
            asm volatile("s_waitcnt vmcnt(0)" ::: "memory");
            const unsigned og = xb_add(&bar[XB_TOP], 1u);
            const unsigned tg = og / nx;
            if (og + 1u == (tg + 1u) * nx) xb_add(&bar[XB_TOPGEN], 1u);
            else XB_SPIN(xb_ld(&bar[XB_TOPGEN]) == tg, bar);
            __builtin_amdgcn_fence(__ATOMIC_ACQUIRE, "agent");
            xb_add(&bar[XB_XGEN(b.x)], 1u);
            asm volatile("s_waitcnt vmcnt(0)" ::: "memory");
        } else {
            XB_SPIN(xb_ld(&bar[XB_XGEN(b.x)]) == gen, bar);
            __builtin_amdgcn_fence(__ATOMIC_ACQUIRE, "agent");
            asm volatile("s_waitcnt vmcnt(0)" ::: "memory");
        }
    }
    __syncthreads();
}

constexpr int NWAVES = 8;
#define WSP(T, off) ((T*)(F.ws + (off)))
struct Args { const float* in[16]; float* out; unsigned char* ws; int ph_lo, ph_hi, li, pad; };
struct Frame {
    LAS unsigned char* lds; int tid, lane, wave, vcu, G;
    unsigned char* ws; float* out;
};
__device__ __forceinline__ float wave_sum(float v) {
#pragma unroll
    for (int o = 1; o < 64; o <<= 1) v += __shfl_xor(v, o);
    return v;
}

constexpr int CV_NB1 = DFF2 / 64, CV_W1 = (D / 32) * CV_NB1, CV_KB2 = DFF / 32, CV_TOTAL = CV_W1 + CV_KB2 * (D / 64);
static_assert(DFF % 64 == 0 && DFF2 % 64 == 0 && DFF % 32 == 0 && D / 32 == 128, "SCANCVT block shapes");
struct CvBlk { const float* src; bf16* dst; unsigned lds; };
__device__ __forceinline__ CvBlk cv_decode(const float* w1src, const float* w2src, unsigned char* ws, int id, int lane) {
    CvBlk b;
    if (id < CV_W1) { const int kb = id & (D / 32 - 1), nb = id >> 7, n = 64 * nb + lane;        const int f0 = n < DFF ? n : n - DFF; const int rowdst = 256 * (f0 >> 7) + (n < DFF ? 0 : 128) + (f0 & 127);
        b.src = w1src + (size_t)D * DFF2 + (size_t)(32 * kb) * DFF2 + n; b.dst = (bf16*)(ws + WS_W1) + (size_t)NFF1 * D + (size_t)rowdst * D + 32 * kb; b.lds = (unsigned)DFF2; }
    else { const int id2 = id - CV_W1, kb = id2 >> 6, nb = id2 & 63, n = 64 * nb + lane;
        b.src = w2src + (size_t)DFF * D + (size_t)(32 * kb) * D + n; b.dst = (bf16*)(ws + WS_W2) + (size_t)D * KFF2 + (size_t)n * KFF2 + 32 * kb; b.lds = (unsigned)D; }
    return b;
}
__device__ __forceinline__ void cv_load(const CvBlk& b, float (&v)[32]) {
#pragma unroll
    for (int i = 0; i < 32; ++i) v[i] = __builtin_nontemporal_load(b.src + (size_t)i * b.lds);
}
__device__ __forceinline__ void cv_store(const CvBlk& b, const float (&v)[32]) {
#pragma unroll
    for (int q = 0; q < 4; ++q) { u32x4 o; o.x = wq2(cvt_pk_bf16(v[8 * q], v[8 * q + 1])); o.y = wq2(cvt_pk_bf16(v[8 * q + 2], v[8 * q + 3])); o.z = wq2(cvt_pk_bf16(v[8 * q + 4], v[8 * q + 5])); o.w = wq2(cvt_pk_bf16(v[8 * q + 6], v[8 * q + 7]));
        *(u32x4*)(b.dst + 8 * q) = o; }
}

__device__ __forceinline__ void tr_item(const float* W, size_t ldw, int k0, int n0, bf16* WT, size_t ldt, int rowdst, LAS float* scr, int lane) {
#pragma unroll 8
    for (int i = 0; i < 32; ++i) { const int kk = 2 * i + (lane >> 5); scr[kk * 33 + (lane & 31)] = __builtin_nontemporal_load(W + (size_t)(k0 + kk) * ldw + n0 + (lane & 31)); }
    LDS_WAIT(); asm volatile("" ::: "memory");
    const int c = lane & 7;
#pragma unroll
    for (int j = 0; j < 4; ++j) { const int n = (lane >> 3) + 8 * j; const LAS float* s = scr + (8 * c) * 33 + n;
        u32x4 o; o.x = wq2(pk2(s[0 * 33], s[1 * 33])); o.y = wq2(pk2(s[2 * 33], s[3 * 33])); o.z = wq2(pk2(s[4 * 33], s[5 * 33])); o.w = wq2(pk2(s[6 * 33], s[7 * 33]));
        *(u32x4*)(WT + (size_t)(rowdst + n) * ldt + k0 + 8 * c) = o; }
    LDS_WAIT(); asm volatile("" ::: "memory");
}
__device__ __forceinline__ void rms_row_to_bf16(const float* xrow, const float* g, bf16* orow, float* rinv, int lane) {
    const f32x4* xr = (const f32x4*)xrow + lane; const f32x4* gr = (const f32x4*)g + lane;
    f32x4 v[16]; float s = 0.f;
#pragma unroll
    for (int j = 0; j < 16; ++j) { v[j] = __builtin_nontemporal_load(xr + 64 * j); s += (v[j][0] * v[j][0] + v[j][1] * v[j][1]) + (v[j][2] * v[j][2] + v[j][3] * v[j][3]); }
    const float rms = sqrtf(wave_sum(s) * (1.f / D) + EPS); const float rstd = 1.0f / rms;
    if (lane == 0) *rinv = rms;
    u32x2* o8 = (u32x2*)orow + lane;
#pragma unroll
    for (int j = 0; j < 16; ++j) { const f32x4 gg = gr[64 * j]; u32x2 w; w.x = pk2(v[j][0] * rstd * gg[0], v[j][1] * rstd * gg[1]); w.y = pk2(v[j][2] * rstd * gg[2], v[j][3] * rstd * gg[3]); o8[64 * j] = w; }
}
__device__ __forceinline__ void p0_prologue(Frame& F, const Args& args) {
    LAS float* scr = (LAS float*)(F.lds + RING_OFF + F.wave * 16384);
    const int gw = F.vcu * NWAVES + F.wave, NGW = F.G * NWAVES;
    constexpr int I_P = 64 * 384, I_O = 64 * 128, I_1 = 64 * 684, I_2 = 171 * 128, I_G = 16 * 32;
    constexpr int NITEMS = I_P + I_O + I_1 + I_2 + 4 * I_G;
    for (int it = gw; it < NITEMS; it += NGW) {
        int r = it + I_P; if (r >= NITEMS) r -= NITEMS;
        if (r < I_P) { const int kb = r / 384, nb = r % 384; tr_item(args.in[2], PROJ_W, 64 * kb, 32 * nb, WSP(bf16, WS_WP), D, 32 * nb, scr, F.lane); continue; } r -= I_P;
        if (r < I_O) { const int kb = r / 128, nb = r % 128; tr_item(args.in[6], D, 64 * kb, 32 * nb, WSP(bf16, WS_WO), D, 32 * nb, scr, F.lane); continue; } r -= I_O;
        if (r < I_1) { const int l = 0; const int kb = r / 684, nb = r % 684; const int n0 = 32 * nb; const int f0 = n0 < DFF ? n0 : n0 - DFF;
            const int rowdst = 256 * (f0 >> 7) + (n0 < DFF ? 0 : 128) + (f0 & 127);
            tr_item(args.in[11] + (size_t)l * D * DFF2, DFF2, 64 * kb, n0, WSP(bf16, WS_W1) + (size_t)l * NFF1 * D, D, rowdst, scr, F.lane); continue; } r -= I_1;
        if (r < I_2) { const int l = 0; const int kb = r / 128, nb = r % 128;
            tr_item(args.in[14] + (size_t)l * DFF * D, D, 64 * kb, 32 * nb, WSP(bf16, WS_W2) + (size_t)l * D * KFF2, KFF2, 32 * nb, scr, F.lane); continue; } r -= I_2;
        { const int gidx = r / I_G; r -= gidx * I_G; const int kb = r / 32, nb = r % 32;
            tr_item(args.in[8] + (size_t)gidx * 1024 * 1024, 1024, 64 * kb, 32 * nb, WSP(bf16, WS_WPOOL) + (size_t)gidx * 1024 * 1024, 1024, 32 * nb, scr, F.lane); }
    }
    {
        const int scan_blocks = ((256 + F.G - 1) / F.G) * (SEQ / 64) * NGW;
        for (int id = scan_blocks + gw; id < CV_TOTAL; id += NGW) { float v[32]; const CvBlk b = cv_decode(args.in[11], args.in[14], F.ws, id, F.lane); cv_load(b, v); cv_store(b, v); }
    }
    const int gt = F.vcu * (NWAVES * 64) + F.tid, NGT = F.G * NWAVES * 64;
    for (int i = gt; i < 2 * 128 * (D / 8); i += NGT) { const int l = i / (128 * (D / 8)), rr = (i / (D / 8)) % 128, c8 = i % (D / 8); const int row = 85 * 256 + (rr < 64 ? 64 + rr : 192 + (rr - 64));
        *(u32x4*)(WSP(bf16, WS_W1) + ((size_t)l * NFF1 + row) * D + 8 * c8) = (u32x4){0u, 0u, 0u, 0u}; }
    for (int i = gt; i < 2 * D * 8; i += NGT) { const int l = i / (D * 8), row = (i / 8) % D, c8 = i % 8; *(u32x4*)(WSP(bf16, WS_W2) + ((size_t)l * D + row) * KFF2 + DFF + 8 * c8) = (u32x4){0u, 0u, 0u, 0u}; }
    for (int i = gt; i < 2 * FT * 4 * 256; i += NGT) { const int cc = i & 255, p = (i >> 8) & 3, j = (i >> 10) % FT, l = i / (FT * 1024); const int f = 128 * j + (cc & 127); const int col = cc < 128 ? f : DFF + f;
        float v = 0.f; if (f < DFF) v = p < 3 ? args.in[12][((size_t)l * 3 + p) * DFF2 + col] : args.in[13][(size_t)l * DFF2 + col];
        WSP(float, WS_CONVP)[i] = v * (cc < 128 ? -1.44269504089f : -0.69314718056f); }
    for (int i = gt; i < 16 * D; i += NGT) { const int c = i & 15, k = i >> 4; WSP(bf16, WS_WG)[(size_t)c * D + k] = (bf16)f2bf(args.in[2][(size_t)k * PROJ_W + NPROJ + c]); }
    for (int m = gw; m < M; m += NGW) rms_row_to_bf16(args.in[0] + (size_t)m * D, args.in[1], WSP(bf16, WS_XA) + (size_t)m * D, WSP(float, WS_RINV) + m, F.lane);
}

__device__ __forceinline__ float softcap15(float a) { return 15.0f * tanhf(a * (1.0f / 15.0f)); }
__device__ __forceinline__ void p1_gates(Frame& F, const Args& args) {
    const int gw = F.vcu * NWAVES + F.wave, NGW = F.G * NWAVES; const int fr = F.lane & 15, fq = F.lane >> 4;
    for (int rb = gw; rb < M / 16; rb += NGW) {
        const bf16* ap = WSP(bf16, WS_XA) + (size_t)(rb * 16 + fr) * D + 8 * fq; const bf16* bp = WSP(bf16, WS_WG) + (size_t)fr * D + 8 * fq;
        f32x4 acc = (f32x4){0.f, 0.f, 0.f, 0.f};
#pragma unroll 16
        for (int k = 0; k < D; k += 32) { const bf16x8 a = *(const bf16x8*)(ap + k); const bf16x8 b = *(const bf16x8*)(bp + k); acc = __builtin_amdgcn_mfma_f32_16x16x32_bf16(a, b, acc, 0, 0, 0); }
        const int c = fr; const float bias = c < 8 ? args.in[3][c] : args.in[4][c - 8];
#pragma unroll
        for (int r = 0; r < 4; ++r) { const float z = softcap15(acc[r] + bias); float o = z;
            if (c >= 8) o = fminf(z, 0.f) - log1pf(expf(-fabsf(z)));
            WSP(float, WS_GATES)[(size_t)(rb * 16 + 4 * fq + r) * 16 + c] = o; }
    }
}

__device__ __forceinline__ float row_sum16(float x) {
    x += __builtin_bit_cast(float, __builtin_amdgcn_update_dpp(0, __builtin_bit_cast(int, x), 0x128, 0xf, 0xf, false));
    x += __builtin_bit_cast(float, __builtin_amdgcn_update_dpp(0, __builtin_bit_cast(int, x), 0x124, 0xf, 0xf, false));
    x += __builtin_bit_cast(float, __builtin_amdgcn_update_dpp(0, __builtin_bit_cast(int, x), 0x122, 0xf, 0xf, false));
    x += __builtin_bit_cast(float, __builtin_amdgcn_update_dpp(0, __builtin_bit_cast(int, x), 0x121, 0xf, 0xf, false));
    return x;
}
__device__ __forceinline__ float wave_scan_add(float x, int lane) {
#define SC_STEP(ctrl) x += __builtin_bit_cast(float, __builtin_amdgcn_update_dpp(0, __builtin_bit_cast(int, x), ctrl, 0xf, 0xf, true))
    SC_STEP(0x111); SC_STEP(0x112); SC_STEP(0x114); SC_STEP(0x118);
#undef SC_STEP
    const float t0 = __builtin_bit_cast(float, __builtin_amdgcn_readlane(__builtin_bit_cast(int, x), 15)), t1 = __builtin_bit_cast(float, __builtin_amdgcn_readlane(__builtin_bit_cast(int, x), 31)), t2 = __builtin_bit_cast(float, __builtin_amdgcn_readlane(__builtin_bit_cast(int, x), 47));
    const int g = lane >> 4; return x + (g >= 1 ? t0 : 0.f) + (g >= 2 ? t1 : 0.f) + (g >= 3 ? t2 : 0.f);
}
__device__ __forceinline__ float wave_scan_max(float x, int lane) {
    const int ninf = (int)0xff800000u;
#define SC_STEP(ctrl) x = fmaxf(x, __builtin_bit_cast(float, __builtin_amdgcn_update_dpp(ninf, __builtin_bit_cast(int, x), ctrl, 0xf, 0xf, false)))
    SC_STEP(0x111); SC_STEP(0x112); SC_STEP(0x114); SC_STEP(0x118);
#undef SC_STEP
    const float t0 = __builtin_bit_cast(float, __builtin_amdgcn_readlane(__builtin_bit_cast(int, x), 15)), t1 = __builtin_bit_cast(float, __builtin_amdgcn_readlane(__builtin_bit_cast(int, x), 31)), t2 = __builtin_bit_cast(float, __builtin_amdgcn_readlane(__builtin_bit_cast(int, x), 47));
    const int g = lane >> 4; const float ninff = __builtin_bit_cast(float, ninf);
    return fmaxf(fmaxf(x, g >= 1 ? t0 : ninff), fmaxf(g >= 2 ? t1 : ninff, g >= 3 ? t2 : ninff));
}
typedef short v4i16_t __attribute__((ext_vector_type(4)));
__device__ __forceinline__ v4i16_t tr16(const LAS unsigned char* p) { return __builtin_amdgcn_ds_read_tr16_b64_v4i16((LAS v4i16_t*)p); }
__device__ __forceinline__ bf16x8 cat8(v4i16_t a, v4i16_t b) { return (bf16x8){a[0], a[1], a[2], a[3], b[0], b[1], b[2], b[3]}; }
constexpr int SC_QS = 0, SC_KS = 33792, SC_VS = 67584, SC_VW = 84992, SC_SS = 102400, SC_HS = 111616, SC_FA = 129024;
static_assert(SC_FA + 8192 <= LDSCTL_OFF, "scan LDS map");
__device__ __forceinline__ void p2_scan(Frame& F, const Args& args) {
    LAS unsigned char* L = F.lds;
    LAS float* fa = (LAS float*)(L + SC_FA);
    LAS float *sA = fa, *sM = fa + 64, *sWi = fa + 128, *sEi = fa + 192, *sKw = fa + 256, *sInv = fa + 320, *rsp = fa + 384  , *qnp = fa + 640  , *sn = fa + 1152  , *ssp = fa + 1408  , *scal = fa + 1920;
    const int tid0 = F.tid, w = F.wave;
    const bf16* PROJ = WSP(bf16, WS_PROJ); bf16* HB = WSP(bf16, WS_HB); float* SSg = WSP(float, WS_SS); const float* GATES = WSP(float, WS_GATES);
    const __amdgpu_buffer_rsrc_t rsP = __builtin_amdgcn_make_buffer_rsrc((void*)PROJ, 0, 0x7fffffff, 0x00020000), rsH = __builtin_amdgcn_make_buffer_rsrc((void*)HB, 0, 0x7fffffff, 0x00020000);
#define SC_LDQ(i, soff) __builtin_bit_cast(u32x4, __builtin_amdgcn_raw_buffer_load_b128(rsP, (unsigned)((((tid + 512 * (i)) >> 5) * NPROJ + ((tid + 512 * (i)) & 31) * 8) * 2), (soff), 0))
#define SC_LDV(i, soff) __builtin_bit_cast(u32x4, __builtin_amdgcn_raw_buffer_load_b128(rsP, (unsigned)((((tid + 512 * (i)) >> 4) * NPROJ + ((tid + 512 * (i)) & 15) * 8) * 2), (soff), 2))
    int cvid = F.vcu * NWAVES + F.wave;
    for (int item = F.vcu; item < 256; item += F.G) {
        const int bh = item >> 2, es = item & 3, b = bh >> 3, h = bh & 7;
        f32x4 C[16];
#pragma unroll
        for (int i = 0; i < 16; ++i) C[i] = (f32x4){0.f, 0.f, 0.f, 0.f};
        __syncthreads();
        if (tid0 < 256) sn[tid0] = 0.f;
        if (tid0 == 0) scal[0] = 0.f;
        u32x4 qv[4], kv[4], vv[2]; float ig_n, lf_n;
        { const size_t row0 = (size_t)b * SEQ; const int tid = tid0; ig_n = GATES[(row0 + (tid & 63)) * 16 + h]; lf_n = GATES[(row0 + (tid & 63)) * 16 + 8 + h];
#pragma unroll
            for (int i = 0; i < 4; ++i) { const unsigned so = (unsigned)((row0 * NPROJ + h * DQK) * 2); qv[i] = SC_LDQ(i, so); kv[i] = SC_LDQ(i, so + QKW * 2); }
#pragma unroll
            for (int i = 0; i < 2; ++i) vv[i] = SC_LDV(i, (unsigned)((row0 * NPROJ + 2 * QKW + h * DV + es * 128) * 2)); }
        for (int c = 0; c <= SEQ / 64; ++c) {
            const size_t row0 = (size_t)b * SEQ + 64 * c;
            int tid = tid0; asm volatile("" : "+v"(tid));
            const int lane = tid & 63, fr = lane & 15, fq = lane >> 4, tq = fr >> 2, tp = fr & 3;
            __syncthreads();
            if (c > 0) {
                const size_t prow0 = row0 - 64;
#pragma unroll
                for (int i = 0; i < 2; ++i) { const int p = tid + 512 * i, row = p >> 4, cc = p & 15; __builtin_amdgcn_raw_buffer_store_b128(*(const LAS u32x4*)(L + SC_HS + row * 272 + cc * 16), rsH, (unsigned)((row * D + cc * 8) * 2), (unsigned)((prow0 * D + h * DV + es * 128) * 2), 0); }
                if (tid < 64) { float q = 0.f;
#pragma unroll
                    for (int p = 0; p < 8; ++p) q += ssp[p * 64 + tid];
                    SSg[(prow0 + tid) * 32 + h * 4 + es] = q; }
                if (tid == 0) scal[0] = scal[2];
            }
            if (c == SEQ / 64) break;
#pragma unroll
            for (int i = 0; i < 4; ++i) { const int p = tid + 512 * i, row = p >> 5, cc = p & 31; *(LAS u32x4*)(L + SC_QS + row * 528 + cc * 16) = qv[i]; *(LAS u32x4*)(L + SC_KS + row * 528 + cc * 16) = kv[i]; }
#pragma unroll
            for (int i = 0; i < 2; ++i) { const int p = tid + 512 * i, row = p >> 4, cc = p & 15; *(LAS u32x4*)(L + SC_VS + row * 272 + cc * 16) = vv[i]; }
            const float ig = ig_n, lf = lf_n;
            if (c + 1 < SEQ / 64) {
                const size_t nrow0 = row0 + 64; ig_n = GATES[(nrow0 + lane) * 16 + h]; lf_n = GATES[(nrow0 + lane) * 16 + 8 + h];
#pragma unroll
                for (int i = 0; i < 4; ++i) { const unsigned so = (unsigned)((nrow0 * NPROJ + h * DQK) * 2); qv[i] = SC_LDQ(i, so); kv[i] = SC_LDQ(i, so + QKW * 2); }
#pragma unroll
                for (int i = 0; i < 2; ++i) vv[i] = SC_LDV(i, (unsigned)((nrow0 * NPROJ + 2 * QKW + h * DV + es * 128) * 2));
            }
            float cv[32]; CvBlk cvb; const bool cvon = cvid < CV_TOTAL;
            if (cvon) { cvb = cv_decode(args.in[11], args.in[14], F.ws, cvid, tid & 63); cv_load(cvb, cv); }
            cvid += F.G * NWAVES;
            LDS_WAIT(); __builtin_amdgcn_s_barrier(); asm volatile("" ::: "memory");
            if (w == 0) {
                const float bs = wave_scan_add(lf, lane);
                const float a = ig - bs; const float pm = wave_scan_max(a, lane);
                const float mprev = scal[0]; const float Mt = fmaxf(mprev, pm);
                const float M63 = __builtin_bit_cast(float, __builtin_amdgcn_readlane(__builtin_bit_cast(int, Mt), 63)), b63 = __builtin_bit_cast(float, __builtin_amdgcn_readlane(__builtin_bit_cast(int, bs), 63));
                sA[lane] = a; sM[lane] = Mt; sWi[lane] = __expf(mprev - Mt); sEi[lane] = __expf(-(bs + Mt)); sKw[lane] = __expf(a - M63);
                if (lane == 0) { scal[1] = __expf(mprev - M63); scal[2] = b63 + M63; }
            }
            { const int t = tid & 63; float s = 0.f;
#pragma unroll
                for (int j = 0; j < 4; ++j) { const int d0 = w * 32 + 8 * j; const u32x4 q = *(const LAS u32x4*)(L + SC_QS + t * 528 + d0 * 2); const LAS float* np = sn + d0;
                    s += bf2f(q.x & 0xffffu) * np[0] + bf2f(q.x >> 16) * np[1] + bf2f(q.y & 0xffffu) * np[2] + bf2f(q.y >> 16) * np[3] + bf2f(q.z & 0xffffu) * np[4] + bf2f(q.z >> 16) * np[5] + bf2f(q.w & 0xffffu) * np[6] + bf2f(q.w >> 16) * np[7]; }
                qnp[w * 64 + t] = s; }
            const int tr = w >> 1, tc0 = (w & 1) * 2; f32x4 s0 = (f32x4){0.f, 0.f, 0.f, 0.f}, s1 = s0;
#pragma unroll
            for (int kk = 0; kk < 8; ++kk) { const bf16x8 a = *(const LAS bf16x8*)(L + SC_QS + (16 * tr + fr) * 528 + (32 * kk + 8 * fq) * 2);
                const bf16x8 b0 = *(const LAS bf16x8*)(L + SC_KS + (16 * tc0 + fr) * 528 + (32 * kk + 8 * fq) * 2); const bf16x8 b1 = *(const LAS bf16x8*)(L + SC_KS + (16 * tc0 + 16 + fr) * 528 + (32 * kk + 8 * fq) * 2);
                s0 = __builtin_amdgcn_mfma_f32_16x16x32_bf16(a, b0, s0, 0, 0, 0); s1 = __builtin_amdgcn_mfma_f32_16x16x32_bf16(a, b1, s1, 0, 0, 0); }
            __syncthreads();
#pragma unroll
            for (int q = 0; q < 2; ++q) { const int tc = tc0 + q, sidx = 16 * tc + fr; const float as = sA[sidx];
#pragma unroll
                for (int r = 0; r < 4; ++r) { const int t = 16 * tr + 4 * fq + r; const float e = __expf(fminf(as - sM[t], 0.f)); const float wgt = (sidx <= t) ? e : 0.f; const float v = (q == 0 ? s0[r] : s1[r]) * wgt;
                    *(LAS unsigned short*)(L + SC_SS + (t * 72 + sidx) * 2) = (unsigned short)cvt_pk_bf16(v, v);
                    rsp[t * 4 + tc] = row_sum16(v); } }
#pragma unroll
            for (int i = 0; i < 2; ++i) { const int p = tid + 512 * i, row = p >> 4, cc = p & 15; const float kw = sKw[row]; const u32x4 v = *(const LAS u32x4*)(L + SC_VS + row * 272 + cc * 16); u32x4 o;
                o.x = cvt_pk_bf16(kw * bf2f(v.x & 0xffffu), kw * bf2f(v.x >> 16)); o.y = cvt_pk_bf16(kw * bf2f(v.y & 0xffffu), kw * bf2f(v.y >> 16));
                o.z = cvt_pk_bf16(kw * bf2f(v.z & 0xffffu), kw * bf2f(v.z >> 16)); o.w = cvt_pk_bf16(kw * bf2f(v.w & 0xffffu), kw * bf2f(v.w >> 16));
                *(LAS u32x4*)(L + SC_VW + row * 272 + cc * 16) = o; }
            __syncthreads();
            if (tid < 64) { const int t = tid; float qn = 0.f;
#pragma unroll
                for (int p = 0; p < 8; ++p) qn += qnp[p * 64 + t];
                const float den = sWi[t] * qn + ((rsp[t * 4 + 0] + rsp[t * 4 + 1]) + (rsp[t * 4 + 2] + rsp[t * 4 + 3]));
                sInv[t] = 1.0f / fmaxf(fabsf(den), sEi[t]); }
            f32x4 nacc[4];
#pragma unroll
            for (int tt = 0; tt < 4; ++tt) nacc[tt] = (f32x4){0.f, 0.f, 0.f, 0.f};
#pragma unroll
            for (int kk = 0; kk < 8; ++kk) {
                u32x4 bw; bw.x = cvt_pk_bf16(C[2 * kk][0], C[2 * kk][1]); bw.y = cvt_pk_bf16(C[2 * kk][2], C[2 * kk][3]); bw.z = cvt_pk_bf16(C[2 * kk + 1][0], C[2 * kk + 1][1]); bw.w = cvt_pk_bf16(C[2 * kk + 1][2], C[2 * kk + 1][3]);
                const bf16x8 bq = __builtin_bit_cast(bf16x8, bw);
#pragma unroll
                for (int tt = 0; tt < 4; ++tt) { const bf16x8 a = *(const LAS bf16x8*)(L + SC_QS + (16 * tt + fr) * 528 + (32 * kk + 8 * fq) * 2);
                    nacc[tt] = __builtin_amdgcn_mfma_f32_16x16x32_bf16(a, bq, nacc[tt], 0, 0, 0); }
            }
#pragma unroll
            for (int tt = 0; tt < 4; ++tt)
#pragma unroll
                for (int r = 0; r < 4; ++r) nacc[tt][r] *= sWi[16 * tt + 4 * fq + r];
#pragma unroll
            for (int kk = 0; kk < 2; ++kk) { const LAS unsigned char* vp = L + SC_VS + (32 * kk + 8 * fq + tq) * 272 + (16 * w + 4 * tp) * 2;
                const bf16x8 bv = cat8(tr16(vp), tr16(vp + 4 * 272));
#pragma unroll
                for (int tt = 0; tt < 4; ++tt) { const bf16x8 as = *(const LAS bf16x8*)(L + SC_SS + ((16 * tt + fr) * 72 + 32 * kk + 8 * fq) * 2);
                    nacc[tt] = __builtin_amdgcn_mfma_f32_16x16x32_bf16(as, bv, nacc[tt], 0, 0, 0); } }
            __syncthreads();
#pragma unroll
            for (int tt = 0; tt < 4; ++tt)
#pragma unroll
                for (int r = 0; r < 4; ++r) { const int t = 16 * tt + 4 * fq + r; const float hv = nacc[tt][r] * sInv[t];
                    *(LAS unsigned short*)(L + SC_HS + t * 272 + (16 * w + fr) * 2) = (unsigned short)cvt_pk_bf16(hv, hv);
                    ssp[w * 64 + t] = row_sum16(hv * hv); }
            const float aprev = scal[1];
#pragma unroll
            for (int i = 0; i < 16; ++i) C[i] *= aprev;
            f32x4 ninc0 = (f32x4){0.f, 0.f, 0.f, 0.f}, ninc1 = ninc0;
#pragma unroll
            for (int kk = 0; kk < 2; ++kk) { const LAS unsigned char* vp = L + SC_VW + (32 * kk + 8 * fq + tq) * 272 + (16 * w + 4 * tp) * 2;
                const bf16x8 bvw = cat8(tr16(vp), tr16(vp + 4 * 272));
                u32x4 kn; { const LAS float* kp = sKw + 32 * kk + 8 * fq; kn.x = cvt_pk_bf16(kp[0], kp[1]); kn.y = cvt_pk_bf16(kp[2], kp[3]); kn.z = cvt_pk_bf16(kp[4], kp[5]); kn.w = cvt_pk_bf16(kp[6], kp[7]); }
                const bf16x8 bn = __builtin_bit_cast(bf16x8, kn);
                const LAS unsigned char* kp0 = L + SC_KS + (32 * kk + 8 * fq + tq) * 528 + (8 * tp) * 2;
#pragma unroll
                for (int T = 0; T < 16; ++T) { const LAS unsigned char* kp = kp0 + (32 * (T >> 1) + 4 * (T & 1)) * 2;
                    const bf16x8 ak = cat8(tr16(kp), tr16(kp + 4 * 528));
                    C[T] = __builtin_amdgcn_mfma_f32_16x16x32_bf16(ak, bvw, C[T], 0, 0, 0); }
                { const LAS unsigned char* kp = kp0 + (32 * w) * 2; const bf16x8 a0 = cat8(tr16(kp), tr16(kp + 4 * 528)), a1 = cat8(tr16(kp + 8), tr16(kp + 8 + 4 * 528));
                    ninc0 = __builtin_amdgcn_mfma_f32_16x16x32_bf16(a0, bn, ninc0, 0, 0, 0); ninc1 = __builtin_amdgcn_mfma_f32_16x16x32_bf16(a1, bn, ninc1, 0, 0, 0); } }
            {
#pragma unroll
                for (int r = 0; r < 4; ++r) { const int d0 = 32 * w + 8 * fq + r; const float n0 = aprev * sn[d0] + ninc0[r], n1 = aprev * sn[d0 + 4] + ninc1[r]; sn[d0] = n0; sn[d0 + 4] = n1; } }
            if (cvon) cv_store(cvb, cv);
        }
    }
    __syncthreads();
#undef SC_LDQ
#undef SC_LDV
}

__device__ __forceinline__ void p3_headnorm(Frame& F, const Args& args) {
    const int gw = F.vcu * NWAVES + F.wave, NGW = F.G * NWAVES;
    for (int m = gw; m < M; m += NGW) {
        u32x4 hva[8], ova[8];
#pragma unroll
        for (int j = 0; j < 8; ++j) { const int col = 512 * j + 8 * F.lane; hva[j] = __builtin_nontemporal_load((const u32x4*)(WSP(bf16, WS_HB) + (size_t)m * D + col)); ova[j] = __builtin_nontemporal_load((const u32x4*)(WSP(bf16, WS_PROJ) + (size_t)m * NPROJ + 2 * QKW + VW + col)); }
#pragma unroll
        for (int j = 0; j < 8; ++j) {
            const f32x4 s4 = *(const f32x4*)(WSP(float, WS_SS) + (size_t)m * 32 + 4 * j); const float r = __builtin_amdgcn_rsqf(((s4[0] + s4[1]) + (s4[2] + s4[3])) * (1.f / DV) + EPS);
            const int col = 512 * j + 8 * F.lane;
            const u32x4 hv = hva[j]; const u32x4 ov = ova[j];
            const f32x4 g0 = *(const f32x4*)(args.in[5] + col), g1 = *(const f32x4*)(args.in[5] + col + 4);
            const unsigned hw[4] = {hv.x, hv.y, hv.z, hv.w}, ow[4] = {ov.x, ov.y, ov.z, ov.w}; const float gg[8] = {g0[0], g0[1], g0[2], g0[3], g1[0], g1[1], g1[2], g1[3]}; unsigned res[4];
#pragma unroll
            for (int q = 0; q < 4; ++q) { const float h0 = bf2f(hw[q] & 0xffffu), h1 = bf2f(hw[q] >> 16), o0 = bf2f(ow[q] & 0xffffu), o1 = bf2f(ow[q] >> 16);
                const float y0 = h0 * r * gg[2 * q] * __builtin_amdgcn_rcpf(1.0f + __builtin_amdgcn_exp2f(-1.44269504089f * o0)), y1 = h1 * r * gg[2 * q + 1] * __builtin_amdgcn_rcpf(1.0f + __builtin_amdgcn_exp2f(-1.44269504089f * o1)); res[q] = pk2(y0, y1); }
            *(u32x4*)(WSP(bf16, WS_XB) + (size_t)m * D + col) = (u32x4){res[0], res[1], res[2], res[3]};
        }
    }
}

__device__ __forceinline__ void rstd_to_lds(Frame& F, int pm) {
    __syncthreads();
    if (F.tid < 256) { const f32x4* p = (const f32x4*)(WSP(float, WS_RSS) + (size_t)(pm * 256 + F.tid) * 64); float s = 0.f;
#pragma unroll
        for (int j = 0; j < 16; ++j) { const f32x4 v = p[j]; s += (v[0] + v[1]) + (v[2] + v[3]); }
        ((LAS float*)(F.lds + RSTD_OFF))[F.tid] = 1.0f / sqrtf(s * (1.f / D) + EPS); }
    VM_WAIT(); LDS_WAIT();
    __syncthreads();
}

__device__ __forceinline__ void p6_fixup(Frame& F, int layer, bf16* __restrict__ GATED) {
    const int gt = F.vcu * (NWAVES * 64) + F.tid, NGT = F.G * NWAVES * 64;
    const float* __restrict__ cpl = WSP(float, WS_CONVP) + (size_t)layer * FT * 1024; const float* __restrict__ HALO = WSP(float, WS_HALO);
    for (int i = gt; i < 64 * FT * 128; i += NGT) { const int ci = i & 127, pn = (i >> 7) % FT, pm = i / (FT * 128); if ((pm & 7) == 0) continue;
        float hc[2][2];
#pragma unroll
        for (int bj = 0; bj < 2; ++bj) { const int col = 256 * pn + 128 * bj + ci; const float* cp = cpl + (size_t)pn * 1024 + 128 * bj + ci;
            const float w0 = cp[0], w1 = cp[256], w2 = cp[512], cb = cp[768];
            const float hm2 = HALO[((size_t)(pm - 1) * 4 + 2) * NFF1 + col], hm1 = HALO[((size_t)(pm - 1) * 4 + 3) * NFF1 + col], h0 = HALO[((size_t)pm * 4 + 0) * NFF1 + col], h1 = HALO[((size_t)pm * 4 + 1) * NFF1 + col];
            hc[bj][0] = cb + w0 * hm2 + w1 * hm1 + w2 * h0; hc[bj][1] = cb + w0 * hm1 + w1 * h0 + w2 * h1; }
#pragma unroll
        for (int rr = 0; rr < 2; ++rr) GATED[(size_t)(pm * 256 + rr) * KFF2 + 128 * pn + ci] = (bf16)f2bf(hc[0][rr] * hc[1][rr] * __builtin_amdgcn_rcpf(1.0f + __builtin_amdgcn_exp2f(hc[0][rr])));
    }
}

__device__ __forceinline__ f32x2 ld_bf2(const bf16* p) { const unsigned w = *(const unsigned*)p; return (f32x2){bf2f(w & 0xffffu), bf2f(w >> 16)}; }
template <int W> __device__ __forceinline__ void pool_cols(const bf16* xb, const LAS float* rs, const f32x2 g, bf16* ob, int tb) {
    f32x2 prev[16], cur[16]; unsigned raw[16];
#pragma unroll
    for (int i = 0; i < 16; ++i) { if (tb == 0) prev[i] = (f32x2){0.f, 0.f}; else prev[i] = ld_bf2(xb + (size_t)i * D) * rs[i] * g; }
#pragma unroll
    for (int i = 0; i < 16; ++i) raw[i] = *(const unsigned*)(xb + (size_t)(16 + i) * D);
#pragma unroll 1
    for (int blk = 0; blk < 4; ++blk) {
#pragma unroll
        for (int i = 0; i < 16; ++i) cur[i] = (f32x2){bf2f(raw[i] & 0xffffu), bf2f(raw[i] >> 16)} * rs[16 + 16 * blk + i] * g;
        if (blk < 3) {
#pragma unroll
            for (int i = 0; i < 16; ++i) raw[i] = *(const unsigned*)(xb + (size_t)(32 + 16 * blk + i) * D); }
#pragma unroll
        for (int i = 0; i < 16; ++i) { f32x2 s = cur[i];
#pragma unroll
            for (int j = 1; j < W; ++j) s += (i - j >= 0) ? cur[(i - j) & 15] : prev[(16 + i - j) & 15];
            const int t = 64 * tb + 16 * blk + i; const float inv = (t + 1) < W ? __builtin_amdgcn_rcpf((float)(t + 1)) : (1.0f / (float)W);
            const f32x2 o = s * inv - cur[i];
            *(unsigned*)(ob + (size_t)(16 * blk + i) * D) = pk2(o[0], o[1]); }
#pragma unroll
        for (int i = 0; i < 16; ++i) prev[i] = cur[i];
    }
}
__device__ __forceinline__ void p8_pool(Frame& F, const Args& args) {
    LAS float* rs = (LAS float*)(F.lds);
    for (int item = F.vcu; item < 256; item += F.G) {
        const int b = item >> 5, tb = item & 31; const size_t r0 = (size_t)b * SEQ + 64 * tb;
        __syncthreads();
        if (F.tid < 80) { float v = 0.f; if (tb > 0 || F.tid >= 16) { const f32x4* p = (const f32x4*)(WSP(float, WS_RSS) + (r0 - 16 + F.tid) * 64); float s = 0.f;
#pragma unroll
                for (int j = 0; j < 16; ++j) { const f32x4 q = p[j]; s += (q[0] + q[1]) + (q[2] + q[3]); }
                v = 1.0f / sqrtf(s * (1.f / D) + EPS); }
            rs[F.tid] = v; }
        __syncthreads();
#pragma unroll 1
        for (int part = 0; part < 4; ++part) { const int q = F.tid + 512 * part, col = 2 * q, grp = part;
            const f32x2 g = *(const f32x2*)(args.in[7] + col); const bf16* xb = WSP(bf16, WS_XA) + (r0 - 16) * D + col; bf16* ob = WSP(bf16, WS_XB) + r0 * D + col;
            if (grp == 0) pool_cols<2>(xb, rs, g, ob, tb); else if (grp == 1) pool_cols<4>(xb, rs, g, ob, tb); else if (grp == 2) pool_cols<8>(xb, rs, g, ob, tb); else pool_cols<16>(xb, rs, g, ob, tb); }
    }
    __syncthreads();
}

__device__ __forceinline__ void p13_final(Frame& F, const Args& args) {
    const int gw = F.vcu * NWAVES + F.wave, NGW = F.G * NWAVES;
    for (int m = gw; m < M; m += NGW) {
        const float rstd = 1.0f / sqrtf(wave_sum(WSP(float, WS_RSS)[(size_t)m * 64 + F.lane]) * (1.f / D) + EPS);
        const u32x4* xr = (const u32x4*)(WSP(bf16, WS_XA) + (size_t)m * D) + F.lane; f32x4* orow = (f32x4*)(F.out + (size_t)m * D) + 2 * F.lane; const f32x4* gr = (const f32x4*)args.in[15] + 2 * F.lane;
        u32x4 xw[8];
#pragma unroll
        for (int j = 0; j < 8; ++j) xw[j] = __builtin_nontemporal_load(xr + 64 * j);
#pragma unroll
        for (int j = 0; j < 8; ++j) { const u32x4 w = xw[j]; const f32x4 g0 = gr[128 * j], g1 = gr[128 * j + 1];
            __builtin_nontemporal_store((f32x4){bf2f(w.x & 0xffffu), bf2f(w.x >> 16), bf2f(w.y & 0xffffu), bf2f(w.y >> 16)} * rstd * g0, orow + 128 * j);
            __builtin_nontemporal_store((f32x4){bf2f(w.z & 0xffffu), bf2f(w.z >> 16), bf2f(w.w & 0xffffu), bf2f(w.w >> 16)} * rstd * g1, orow + 128 * j + 1); }
    }
}

__global__ void __launch_bounds__(NWAVES * 64, 2) fwd(Args args) {
    extern __shared__ __attribute__((aligned(16))) unsigned char lds[];
    Frame F;
    F.lds = (LAS unsigned char*)lds;
    F.tid = threadIdx.x; F.lane = F.tid & 63; F.wave = __builtin_amdgcn_readfirstlane(F.tid >> 6);
    F.G = gridDim.x; { const int bx = blockIdx.x; F.vcu = (F.G % 8 == 0) ? (bx % 8) * (F.G / 8) + bx / 8 : bx; }
    unsigned char* ws = args.ws; F.ws = ws; F.out = args.out;
    gu32* ctl = (gu32*)(ws + WS_CTL);
    for (int u = F.tid; u < (LDS_BYTES - LDSCTL_OFF) / 4; u += NWAVES * 64) ((LAS unsigned*)(F.lds + LDSCTL_OFF))[u] = 0u;
    __syncthreads();
    XcdBarrier bar; bar.bar = (unsigned*)(ctl + CW_BAR); bar.x = 0; bar.st = nullptr;
    if (MK_N_LAUNCHES == 1) bar = xcd_barrier_post((unsigned*)(ctl + CW_BAR), (volatile LAS unsigned*)(F.lds + MISC_OFF));
#define GRID_BAR() do { if (MK_N_LAUNCHES == 1) xcd_barrier(bar); } while (0)
    const int lo = args.ph_lo, hi = args.ph_hi;
#ifndef PHASE_MASK
#define PHASE_MASK 0x3fff
#endif
#define IN(k) ((((PHASE_MASK) >> (k)) & 1) && lo <= (k) && (k) < hi)
#define BOTH(k) (IN(k) && IN((k) + 1))
    bf16* GATED = WSP(bf16, WS_PROJ);
    const int c = (int)blockIdx.x;

    if (IN(0)) { p0_prologue(F, args); if (BOTH(0)) GRID_BAR(); }
    if (IN(1)) {
        pg8::Gemm g{WSP(bf16, WS_XA), WSP(bf16, WS_WP), D, D, D, 0, 0}; pg8::RowOrder S; S.init(NPROJ / 256, c);
        pg8::EpiProj E{WSP(bf16, WS_PROJ), NPROJ};
        pg8::gemm_phase(F.lds + RING_OFF, g, S, E);
        p1_gates(F, args);
        if (BOTH(1)) GRID_BAR();
    }
    if (IN(2)) { p2_scan(F, args); if (BOTH(2)) GRID_BAR(); }
    if (IN(3)) { p3_headnorm(F, args); if (BOTH(3)) GRID_BAR(); }
    if (IN(4)) {
        pg8::Gemm g{WSP(bf16, WS_XB), WSP(bf16, WS_WO), D, D, D, 0, 0}; pg8::RowOrder S; S.init(D / 256, c);
        pg8::EpiResid<false> E{WSP(bf16, WS_XA), args.in[1], nullptr, WSP(bf16, WS_XA), args.in[10], WSP(float, WS_RSS), WSP(float, WS_RINV)};
        pg8::gemm_phase(F.lds + RING_OFF, g, S, E);
        if (BOTH(4)) GRID_BAR();
    }
    if (IN(5)) {
        pg8::Gemm g{WSP(bf16, WS_XA), WSP(bf16, WS_W1), D, D, D, 0, 0}; pg8::RowOrder S; S.init(FT - 2, c);
        rstd_to_lds(F, S.pm);
        float* part = WSP(float, WS_PART) + (size_t)(c & 127) * 65536; unsigned* sflag = (unsigned*)(ctl + CW_SPLIT + 64 * (c & 127));
        { pg8::EpiFfn1T<0> E{GATED, WSP(float, WS_CONVP), WSP(float, WS_HALO), F.lds, part, sflag, 1u};
          pg8::gemm_phase(F.lds + RING_OFF, g, S, E); }
        pg8::TailOrder T; T.init(c);
        if (T.pn0 < 2) { pg8::EpiFfn1T<1> E{GATED, WSP(float, WS_CONVP), WSP(float, WS_HALO), F.lds, part, sflag, 1u}; pg8::gemm_phase(F.lds + RING_OFF, g, T, E); }
        else { pg8::EpiFfn1T<2> E{GATED, WSP(float, WS_CONVP), WSP(float, WS_HALO), F.lds, part, sflag, 1u}; pg8::gemm_phase(F.lds + RING_OFF, g, T, E); }
        if (BOTH(5)) GRID_BAR();
    }
    if (IN(6)) { p6_fixup(F, 0, GATED); if (BOTH(6)) GRID_BAR(); }
    if (IN(7)) {
        pg8::Gemm g{GATED, WSP(bf16, WS_W2), KFF2, KFF2, KFF2, 0, 0}; pg8::WideOrder S; S.init(D / 256, c);
        pg8::EpiResid<false> E{WSP(bf16, WS_XA), args.in[10], nullptr, WSP(bf16, WS_XA), nullptr, WSP(float, WS_RSS), nullptr};
        pg8::gemm_phase(F.lds + RING_OFF, g, S, E);
        if (BOTH(7)) GRID_BAR();
    }
    if (IN(8)) { p8_pool(F, args); if (BOTH(8)) GRID_BAR(); }
    if (IN(9)) {
        pg8::Gemm g{WSP(bf16, WS_XB), WSP(bf16, WS_WPOOL), D, 1024, 1024, 2, 1024}; pg8::RowOrder S; S.init(D / 256, c);
        pg8::EpiResid<false> E{WSP(bf16, WS_XA), nullptr, args.in[9], WSP(bf16, WS_XA), args.in[10] + D, WSP(float, WS_RSS), nullptr};
        pg8::gemm_phase(F.lds + RING_OFF, g, S, E);
        if (BOTH(9)) GRID_BAR();
    }
    if (IN(10)) {
        pg8::Gemm g{WSP(bf16, WS_XA), WSP(bf16, WS_W1) + (size_t)NFF1 * D, D, D, D, 0, 0}; pg8::RowOrder S; S.init(FT - 2, c);
        rstd_to_lds(F, S.pm);
        float* part = WSP(float, WS_PART) + (size_t)(c & 127) * 65536; unsigned* sflag = (unsigned*)(ctl + CW_SPLIT + 64 * (c & 127));
        { pg8::EpiFfn1T<0> E{GATED, WSP(float, WS_CONVP) + (size_t)FT * 1024, WSP(float, WS_HALO), F.lds, part, sflag, 2u};
          pg8::gemm_phase(F.lds + RING_OFF, g, S, E); }
        pg8::TailOrder T; T.init(c);
        if (T.pn0 < 2) { pg8::EpiFfn1T<1> E{GATED, WSP(float, WS_CONVP) + (size_t)FT * 1024, WSP(float, WS_HALO), F.lds, part, sflag, 2u}; pg8::gemm_phase(F.lds + RING_OFF, g, T, E); }
        else { pg8::EpiFfn1T<2> E{GATED, WSP(float, WS_CONVP) + (size_t)FT * 1024, WSP(float, WS_HALO), F.lds, part, sflag, 2u}; pg8::gemm_phase(F.lds + RING_OFF, g, T, E); }
        if (BOTH(10)) GRID_BAR();
    }
    if (IN(11)) { p6_fixup(F, 1, GATED); if (BOTH(11)) GRID_BAR(); }
    if (IN(12)) {
        pg8::Gemm g{GATED, WSP(bf16, WS_W2) + (size_t)D * KFF2, KFF2, KFF2, KFF2, 0, 0}; pg8::WideOrder S; S.init(D / 256, c);
        pg8::EpiResid<false> E{WSP(bf16, WS_XA), args.in[10] + D, nullptr, WSP(bf16, WS_XA), nullptr, WSP(float, WS_RSS), nullptr};
        pg8::gemm_phase(F.lds + RING_OFF, g, S, E);
        if (BOTH(12)) GRID_BAR();
    }
    if (IN(13)) { p13_final(F, args); }
#undef IN
#undef BOTH
}

extern "C" void kernel_launch(void* const* d_in, const int* in_sizes, int n_in, void* d_out, int out_size, void* d_ws, size_t ws_size, hipStream_t stream) {
    static int grid = 0;
    if (grid == 0) {
        if (n_in != 16 || out_size != M * D || ws_size < WS_END3) { fprintf(stderr, "kernel_launch: unexpected shapes (n_in %d, out %d, ws %zu, need %zu)\n", n_in, out_size, ws_size, (size_t)WS_END3); grid = -1; return; }
        if (hipFuncSetAttribute((const void*)fwd, hipFuncAttributeMaxDynamicSharedMemorySize, LDS_BYTES) != hipSuccess) { fprintf(stderr, "kernel_launch: hipFuncSetAttribute failed\n"); grid = -1; return; }
        int per_cu = 0;
        if (hipOccupancyMaxActiveBlocksPerMultiprocessor(&per_cu, (const void*)fwd, NWAVES * 64, LDS_BYTES) != hipSuccess || per_cu < 1) fprintf(stderr, "kernel_launch: occupancy query reports %d\n", per_cu);
        (void)hipGetLastError();
        grid = 256;
    }
    if (grid < 0) return;
    (void)hipMemsetAsync((char*)d_ws + WS_CTL, 0, CTL_ZERO_BYTES, stream);
    Args a{};
    for (int i = 0; i < 16; ++i) a.in[i] = (const float*)d_in[i];
    a.out = (float*)d_out; a.ws = (unsigned char*)d_ws;
    if (MK_N_LAUNCHES == 1) { a.ph_lo = 0; a.ph_hi = NPHASE; a.li = 0; hipLaunchKernelGGL(fwd, dim3(grid), dim3(NWAVES * 64), LDS_BYTES, stream, a); }
    else for (int p = 0; p < NPHASE; ++p) { a.ph_lo = p; a.ph_hi = p + 1; a.li = p; hipLaunchKernelGGL(fwd, dim3(grid), dim3(NWAVES * 64), LDS_BYTES, stream, a); }
}
```
